# Optimizing an MI355X kernel written in HIP

```python
import math
import jax, jax.numpy as jnp
from jax import lax
import numpy as np

D_MODEL = 1024
BATCH = 4
SEQ = 4096
DEPTH = 2

N_MIXERS = 2
N_A_LAYERS = (DEPTH + 1) // 2
N_B_LAYERS = DEPTH // 2
HEAD_DIM = 64
ATTN_SCALE = HEAD_DIM ** -0.5
A_DILATED = ((128, 1), (512, 4), (2048, 16))
A_N_GROUPS = 3
A_HEADS_PER_GROUP = D_MODEL // HEAD_DIM
A_HEADS = A_N_GROUPS * A_HEADS_PER_GROUP
A_GROUP_WIDTH = A_HEADS_PER_GROUP * HEAD_DIM
A_IN_COLS = A_N_GROUPS * 3 * A_GROUP_WIDTH
B_HEADS = D_MODEL // HEAD_DIM
B_WIDTH = B_HEADS * HEAD_DIM
B_IN_COLS = 3 * B_WIDTH + B_HEADS
Q_BLOCK = 128
REL_BUCKETS = 32
REL_MAX_DIST = 2048
N_GROUPS = 4
EXPERTS_PER_GROUP = 4
N_EXPERTS = N_GROUPS * EXPERTS_PER_GROUP
EXPERT_FF = D_MODEL // 4
TOP_K_IN_GROUP = 2
EPS = 1e-6
NEG_INF = -1e30

kernel_name = "hybrid_dilated_fox_hmoe_adaln"


def rmsnorm(x, g):
    xf = x.astype(jnp.float32)
    y = xf * lax.rsqrt(jnp.mean(xf * xf, axis=-1, keepdims=True) + EPS)
    return (y * g.astype(jnp.float32)).astype(x.dtype)


def t5_bucket(dist):
    max_exact = REL_BUCKETS // 2
    d = jnp.maximum(dist, 0)
    large = max_exact + (jnp.log(jnp.maximum(d, 1).astype(jnp.float32) / max_exact)
                         / math.log(REL_MAX_DIST / max_exact)
                         * (REL_BUCKETS - max_exact)).astype(jnp.int32)
    large = jnp.minimum(large, REL_BUCKETS - 1)
    return jnp.where(d < max_exact, d, large)


def dilated_group_attention(q, k, v, bias_table, window, dilation):
    b, s, h, hd = q.shape
    r = dilation
    n = s // r
    n_pad = -(-n // Q_BLOCK) * Q_BLOCK
    nb = n_pad // Q_BLOCK
    w_sub = window // dilation

    def strided(t):
        t = t.reshape(b, n, r, h, hd).transpose(0, 2, 1, 3, 4).reshape(b * r, n, h, hd)
        t = jnp.pad(t, ((0, 0), (0, n_pad - n), (0, 0), (0, 0)))
        return t.reshape(b * r, nb, Q_BLOCK, h, hd)

    def with_prev(t):
        prev = jnp.pad(t[:, :-1], ((0, 0), (1, 0), (0, 0), (0, 0), (0, 0)))
        return jnp.concatenate([prev, t], axis=2)

    qs = strided(q)
    kc = with_prev(strided(k))
    vc = with_prev(strided(v))
    qi = jnp.arange(Q_BLOCK)[:, None]
    kj = jnp.arange(2 * Q_BLOCK)[None, :]
    dist = qi + Q_BLOCK - kj
    bias = bias_table[t5_bucket(dist * r)]
    blk = jnp.arange(nb)[:, None, None]
    valid = (dist >= 0) & (dist <= w_sub) & (blk * Q_BLOCK + qi - dist >= 0)
    logits = jnp.einsum('znqhd,znkhd->znhqk', qs, kc).astype(jnp.float32)
    logits = logits + bias.transpose(2, 0, 1).astype(jnp.float32)[None, None]
    logits = jnp.where(valid[None, :, None], logits, NEG_INF)
    m = jnp.max(logits, axis=-1, keepdims=True)
    p = jnp.exp(logits - m)
    denom = jnp.sum(p, axis=-1)
    out = jnp.einsum('znhqk,znkhd->znqhd', p, vc.astype(jnp.float32))
    out = out / denom.transpose(0, 1, 3, 2)[..., None]
    lse = m[..., 0] + jnp.log(denom)
    out = out.reshape(b, r, n_pad, h, hd)[:, :, :n].transpose(0, 2, 1, 3, 4).reshape(b, s, h, hd)
    lse = lse.transpose(0, 1, 3, 2).reshape(b, r, n_pad, h)[:, :, :n].transpose(0, 2, 1, 3).reshape(b, s, h)
    return out, lse


def dilated_mixer(h, w_in, w_out, q_gain, k_gain, rel_bias):
    b, s, _ = h.shape
    proj = (h @ w_in).reshape(b, s, A_N_GROUPS, 3, A_HEADS_PER_GROUP, HEAD_DIM)
    outs, lses = [], []
    for g, (window, dil) in enumerate(A_DILATED):
        q = rmsnorm(proj[:, :, g, 0], q_gain) * ATTN_SCALE
        k = rmsnorm(proj[:, :, g, 1], k_gain)
        v = proj[:, :, g, 2]
        tab = rel_bias[:, g * A_HEADS_PER_GROUP:(g + 1) * A_HEADS_PER_GROUP]
        o, l = dilated_group_attention(q, k, v, tab, window, dil)
        outs.append(o)
        lses.append(l)
    outs = jnp.stack(outs, axis=0)
    wts = jax.nn.softmax(jnp.stack(lses, axis=0), axis=0)
    o = jnp.sum(wts[..., None] * outs, axis=0).astype(h.dtype)
    return o.reshape(b, s, A_GROUP_WIDTH) @ w_out


def forgetting_mixer(h, w_in, f_bias, w_out, q_gain, k_gain):
    b, s, _ = h.shape
    proj = h @ w_in
    qkv = proj[..., :3 * B_WIDTH].reshape(b, s, 3, B_HEADS, HEAD_DIM)
    log_f = jax.nn.log_sigmoid((proj[..., 3 * B_WIDTH:] + f_bias).astype(jnp.float32))
    cum = jnp.cumsum(log_f, axis=1).transpose(0, 2, 1)
    q = rmsnorm(qkv[:, :, 0], q_gain) * ATTN_SCALE
    k = rmsnorm(qkv[:, :, 1], k_gain)
    v = qkv[:, :, 2].astype(jnp.float32)
    nb = s // Q_BLOCK
    qb = q.reshape(b, nb, Q_BLOCK, B_HEADS, HEAD_DIM).transpose(1, 0, 2, 3, 4)
    cb = cum.reshape(b, B_HEADS, nb, Q_BLOCK).transpose(2, 0, 1, 3)
    key_pos = jnp.arange(s)

    def block(args):
        i, q_i, c_i = args
        logits = jnp.einsum('bqhd,bkhd->bhqk', q_i, k).astype(jnp.float32)
        logits = logits + (c_i[..., None] - cum[:, :, None, :])
        q_pos = i * Q_BLOCK + jnp.arange(Q_BLOCK)
        mask = key_pos[None, :] <= q_pos[:, None]
        p = jax.nn.softmax(jnp.where(mask, logits, NEG_INF), axis=-1)
        return jnp.einsum('bhqk,bkhd->bqhd', p, v)

    o = lax.map(block, (jnp.arange(nb), qb, cb))
    o = o.transpose(1, 0, 2, 3, 4).reshape(b, s, B_WIDTH).astype(h.dtype)
    return o @ w_out


def hierarchical_moe(h, wg_r, bg_r, we_r, be_r, w_gate, w_up, w_down):
    b, s, d = h.shape
    t = h.reshape(-1, d)
    g_prob = jax.nn.softmax((t @ wg_r + bg_r).astype(jnp.float32), axis=-1)
    g_idx = jnp.argmax(g_prob, axis=-1)
    g_onehot = jax.nn.one_hot(g_idx, N_GROUPS, dtype=jnp.float32)
    g_w = jnp.max(g_prob, axis=-1, keepdims=True)
    e_logits = (t @ we_r + be_r).astype(jnp.float32).reshape(-1, N_GROUPS, EXPERTS_PER_GROUP)
    e_sel = jnp.einsum('nge,ng->ne', e_logits, g_onehot)
    top_v, top_i = lax.top_k(e_sel, TOP_K_IN_GROUP)
    top_w = jax.nn.softmax(top_v, axis=-1) * g_w
    in_group = jnp.sum(jax.nn.one_hot(top_i, EXPERTS_PER_GROUP, dtype=jnp.float32) * top_w[..., None], axis=1)
    gates = (g_onehot[:, :, None] * in_group[:, None, :]).reshape(-1, N_EXPERTS)
    hid = jax.nn.silu(jnp.einsum('nd,edf->nef', t, w_gate)) * jnp.einsum('nd,edf->nef', t, w_up)
    y = jnp.einsum('nef,efd->nd', hid * gates[..., None].astype(hid.dtype), w_down)
    return y.reshape(b, s, d)


def setup_inputs(seed: int = 0) -> dict:
    key = jax.random.key(seed)
    ks = jax.random.split(key, 24)
    nrm = jax.random.normal
    D = D_MODEL
    inp = {}
    inp["x"] = nrm(ks[0], (BATCH, SEQ, D), jnp.float32)
    inp["c"] = nrm(ks[1], (BATCH, D), jnp.float32)
    inp["w_ada"] = nrm(ks[2], (DEPTH, D, 6 * D), jnp.float32) * (0.5 * D ** -0.5)
    inp["b_ada"] = nrm(ks[3], (DEPTH, 6 * D), jnp.float32) * 0.02
    inp["norm_mix"] = 1.0 + 0.02 * nrm(ks[4], (DEPTH, D), jnp.float32)
    inp["norm_ffn"] = 1.0 + 0.02 * nrm(ks[5], (DEPTH, D), jnp.float32)
    inp["rel_bias"] = 0.2 * nrm(ks[6], (REL_BUCKETS, A_HEADS), jnp.float32)
    inp["a_w_in"] = nrm(ks[7], (N_A_LAYERS, D, A_IN_COLS), jnp.float32) * D ** -0.5
    inp["a_w_out"] = nrm(ks[8], (N_A_LAYERS, A_GROUP_WIDTH, D), jnp.float32) * A_GROUP_WIDTH ** -0.5
    inp["a_q_norm"] = 1.0 + 0.02 * nrm(ks[9], (N_A_LAYERS, HEAD_DIM), jnp.float32)
    inp["a_k_norm"] = 1.0 + 0.02 * nrm(ks[10], (N_A_LAYERS, HEAD_DIM), jnp.float32)
    inp["b_w_in"] = nrm(ks[11], (N_B_LAYERS, D, B_IN_COLS), jnp.float32) * D ** -0.5
    inp["b_f_bias"] = 3.0 + 0.1 * nrm(ks[12], (N_B_LAYERS, B_HEADS), jnp.float32)
    inp["b_w_out"] = nrm(ks[13], (N_B_LAYERS, B_WIDTH, D), jnp.float32) * B_WIDTH ** -0.5
    inp["b_q_norm"] = 1.0 + 0.02 * nrm(ks[14], (N_B_LAYERS, HEAD_DIM), jnp.float32)
    inp["b_k_norm"] = 1.0 + 0.02 * nrm(ks[15], (N_B_LAYERS, HEAD_DIM), jnp.float32)
    inp["router_group_w"] = nrm(ks[16], (DEPTH, D, N_GROUPS), jnp.float32) * D ** -0.5
    inp["router_group_b"] = 0.01 * nrm(ks[17], (DEPTH, N_GROUPS), jnp.float32)
    inp["router_expert_w"] = nrm(ks[18], (DEPTH, D, N_EXPERTS), jnp.float32) * D ** -0.5
    inp["router_expert_b"] = 0.01 * nrm(ks[19], (DEPTH, N_EXPERTS), jnp.float32)
    inp["w_gate"] = nrm(ks[20], (DEPTH, N_EXPERTS, D, EXPERT_FF), jnp.float32) * D ** -0.5
    inp["w_up"] = nrm(ks[21], (DEPTH, N_EXPERTS, D, EXPERT_FF), jnp.float32) * D ** -0.5
    inp["w_down"] = nrm(ks[22], (DEPTH, N_EXPERTS, EXPERT_FF, D), jnp.float32) * EXPERT_FF ** -0.5
    return inp


def reference(x, c, w_ada, b_ada, norm_mix, norm_ffn, rel_bias,
              a_w_in, a_w_out, a_q_norm, a_k_norm,
              b_w_in, b_f_bias, b_w_out, b_q_norm, b_k_norm,
              router_group_w, router_group_b, router_expert_w, router_expert_b,
              w_gate, w_up, w_down):
    b, s, d = x.shape
    ada_in = jax.nn.silu(c)
    for i in range(DEPTH):
        mod = (ada_in @ w_ada[i] + b_ada[i]).reshape(b, 6, d)
        sh_m, sc_m, g_m = mod[:, 0, None, :], mod[:, 1, None, :], mod[:, 2, None, :]
        sh_f, sc_f, g_f = mod[:, 3, None, :], mod[:, 4, None, :], mod[:, 5, None, :]
        hm = rmsnorm(x, norm_mix[i]) * (1 + sc_m) + sh_m
        j = i // N_MIXERS
        if i % N_MIXERS == 0:
            y = dilated_mixer(hm, a_w_in[j], a_w_out[j], a_q_norm[j], a_k_norm[j], rel_bias)
        else:
            y = forgetting_mixer(hm, b_w_in[j], b_f_bias[j], b_w_out[j], b_q_norm[j], b_k_norm[j])
        x = x + g_m * y
        hf = rmsnorm(x, norm_ffn[i]) * (1 + sc_f) + sh_f
        x = x + g_f * hierarchical_moe(hf, router_group_w[i], router_group_b[i],
                                       router_expert_w[i], router_expert_b[i],
                                       w_gate[i], w_up[i], w_down[i])
    return x
```

```cpp
#include <hip/hip_runtime.h>
#include <hip/hip_bf16.h>
#include <cstdio>
#include <cstdint>
#include <cmath>

#ifndef MK_MODE
#define MK_MODE 0
#endif
#ifndef NAIVE_MASK
#define NAIVE_MASK 0u
#endif

constexpr int BATCH = 4, SEQ = 4096, D = 1024, H = 16, HD = 64, M = BATCH * SEQ;
constexpr int NE = 16, FF = 256, NCOMBO = 24;
constexpr float EPS = 1e-6f, LOG2E = 1.4426950408889634f, LN2 = 0.6931471805599453f;
constexpr float C2 = 0.125f * LOG2E;
constexpr int BV_PITCH = 132;
constexpr int NPH = 20;
enum Phase { PH_PRO = 0, PH_ROW_A = 1, PH_QKV_A0 = 2, PH_ATT_A0 = 3, PH_QKV_A1 = 4, PH_ATT_A1 = 5, PH_QKV_A2 = 6, PH_ATT_A2 = 7, PH_OUT_A = 8, PH_ROW_F0 = 9, PH_MOE1_0 = 10, PH_MOE2_0 = 11,
             PH_ROW_B = 12, PH_CUM = 13, PH_QKV_B = 14, PH_ATT_B = 15, PH_OUT_B = 16, PH_ROW_F1 = 17, PH_MOE1_1 = 18, PH_MOE2_1 = 19 };

constexpr size_t MiB = 1u << 20;
constexpr size_t WS_CTL = 0, CTL_ZERO_BYTES = 1 * MiB;
constexpr size_t WS_MOD = 1 * MiB;
constexpr size_t WS_BIASV = 1 * MiB + 256 * 1024;
constexpr size_t WS_TOKREC = 1 * MiB + 512 * 1024;
constexpr size_t WS_CUM = 2 * MiB;
constexpr size_t WS_LOGF = 3 * MiB;
constexpr size_t WS_LSE = 4 * MiB;
constexpr size_t WS_ELIST = 5 * MiB;
constexpr size_t WS_CLIST = 6 * MiB;
constexpr size_t WS_WAIN = 8 * MiB;
constexpr size_t WS_WAOUT = 26 * MiB;
constexpr size_t WS_WBIN = 28 * MiB;
constexpr size_t WS_WBOUT = 34 * MiB;
constexpr size_t WS_MOE1 = 36 * MiB;
constexpr size_t WS_MOE2 = 68 * MiB;
constexpr size_t WS_HM = 84 * MiB;
constexpr size_t WS_Q = 116 * MiB, WS_K = 148 * MiB, WS_V = 180 * MiB;
constexpr size_t WS_ORUN = 212 * MiB;
constexpr size_t WS_HID2 = 116 * MiB;
constexpr size_t WS_END = 244 * MiB;
constexpr int CW_TMO = 0, CW_CODE = 1, CW_BAR = 4096, CW_CNT = 16384;

constexpr int RING_OFF = 0, RING_BYTES = 131072;
constexpr int LDSCTL_OFF = RING_BYTES, MISC_OFF = LDSCTL_OFF + 320;
constexpr int LDS_BYTES = 147456;

#define GAS __attribute__((address_space(1)))
#define LAS __attribute__((address_space(3)))
typedef unsigned short bf16;
typedef unsigned v4u __attribute__((ext_vector_type(4)));
typedef unsigned v2u __attribute__((ext_vector_type(2)));
typedef float f32x4 __attribute__((ext_vector_type(4)));
typedef short bf16x8 __attribute__((ext_vector_type(8)));
typedef GAS unsigned gu32;
#define RLX_AGENT __ATOMIC_RELAXED, __HIP_MEMORY_SCOPE_AGENT
#define LDS_WAIT() asm volatile("s_waitcnt lgkmcnt(0)" ::: "memory")
#define VM_WAIT() asm volatile("s_waitcnt vmcnt(0)" ::: "memory")
__device__ __forceinline__ unsigned f2bf(float f) { unsigned u = __builtin_bit_cast(unsigned, f); return (u + 0x7fffu + ((u >> 16) & 1u)) >> 16; }
__device__ __forceinline__ unsigned pk2(float lo, float hi) { return f2bf(lo) | (f2bf(hi) << 16); }
__device__ __forceinline__ float bf2f(unsigned u) { return __uint_as_float(u << 16); }
__device__ __forceinline__ float wave_sum(float v) {
#pragma unroll
    for (int o = 1; o < 64; o <<= 1) v += __shfl_xor(v, o);
    return v;
}
__device__ __forceinline__ float wave_max(float v) {
#pragma unroll
    for (int o = 1; o < 64; o <<= 1) v = fmaxf(v, __shfl_xor(v, o));
    return v;
}
__host__ __device__ __forceinline__ int dil_of(int g) { return g == 0 ? 1 : (g == 1 ? 4 : 16); }

#define XB_TMO      128
#define XB_XCNT(j)  (256  + 64 * (j))
#define XB_XSUB(j)  (1280 + 64 * (j))
#define XB_XGEN(j)  (2304 + 64 * (j))
#define XB_TOP      3328
#define XB_TOPGEN   3392
#define XCD_BAR_WORDS 3456
#define XB_SPIN_CAP (1u << 18)
__device__ __forceinline__ unsigned xb_ld(unsigned* p)              { return __hip_atomic_load(p, __ATOMIC_RELAXED, __HIP_MEMORY_SCOPE_AGENT); }
__device__ __forceinline__ unsigned xb_add(unsigned* p, unsigned v) { return __hip_atomic_fetch_add(p, v, __ATOMIC_RELAXED, __HIP_MEMORY_SCOPE_AGENT); }
__device__ __forceinline__ unsigned xb_xcc_id() { return (unsigned)__builtin_amdgcn_s_getreg((3 << 11) | 20) & 0xFu; }
#define XB_SPIN(cond, bar) do { unsigned _sp = 0; while (cond) { __builtin_amdgcn_s_sleep(1); \
    if ((++_sp & 255u) == 0u) { if (xb_ld(&(bar)[XB_TMO])) break; if (_sp > XB_SPIN_CAP) { atomicAdd(&(bar)[XB_TMO], 1u); break; } } } } while (0)
struct XcdBarrier { unsigned* bar; unsigned x; volatile LAS unsigned* st; };
__device__ __forceinline__ XcdBarrier xcd_barrier_post(unsigned* bar, volatile LAS unsigned* st) {
    XcdBarrier b; b.bar = bar; b.x = xb_xcc_id(); b.st = st;
    if (threadIdx.x == 0) (void)xb_add(&bar[XB_XCNT(b.x)], 1u);
    return b;
}
__device__ __forceinline__ void xcd_barrier_complete(unsigned* bar, unsigned x, unsigned& nloc, unsigned& nx) {
    const unsigned G = gridDim.x * gridDim.y * gridDim.z;
    unsigned sum, cnt, mine, sp = 0u;
    for (;;) {
        sum = 0u; cnt = 0u; mine = 0u;
#pragma unroll
        for (unsigned j = 0; j < 16; ++j) { const unsigned c = xb_ld(&bar[XB_XCNT(j)]); sum += c; cnt += (c > 0u) ? 1u : 0u; mine = (j == x) ? c : mine; }
        if (sum == G) break;
        __builtin_amdgcn_s_sleep(1);
        if ((++sp & 255u) == 0u) { if (xb_ld(&bar[XB_TMO])) break; if (sp > XB_SPIN_CAP) { atomicAdd(&bar[XB_TMO], 1u); break; } }
    }
    nloc = mine > 0u ? mine : 1u; nx = cnt > 0u ? cnt : 1u;
}
__device__ __forceinline__ void xcd_barrier(const XcdBarrier& b) {
    asm volatile("s_waitcnt vmcnt(0)" ::: "memory");
    __syncthreads();
    if (threadIdx.x == 0) {
        unsigned* bar = b.bar;
        __builtin_amdgcn_s_waitcnt(0);
        unsigned nloc = b.st[0], nx = b.st[1];
        if (nloc == 0u) { xcd_barrier_complete(bar, b.x, nloc, nx); b.st[0] = nloc; b.st[1] = nx; }
        const unsigned old = xb_add(&bar[XB_XSUB(b.x)], 1u);
        const unsigned gen = old / nloc;
        if (old + 1u == (gen + 1u) * nloc) {
            __builtin_amdgcn_fence(__ATOMIC_RELEASE, "agent");
            asm volatile("s_waitcnt vmcnt(0)" ::: "memory");
            const unsigned og = xb_add(&bar[XB_TOP], 1u);
            const unsigned tg = og / nx;
            if (og + 1u == (tg + 1u) * nx) xb_add(&bar[XB_TOPGEN], 1u);
            else XB_SPIN(xb_ld(&bar[XB_TOPGEN]) == tg, bar);
            __builtin_amdgcn_fence(__ATOMIC_ACQUIRE, "agent");
            xb_add(&bar[XB_XGEN(b.x)], 1u);
            asm volatile("s_waitcnt vmcnt(0)" ::: "memory");
        } else {
            XB_SPIN(xb_ld(&bar[XB_XGEN(b.x)]) == gen, bar);
            __builtin_amdgcn_fence(__ATOMIC_ACQUIRE, "agent");
            asm volatile("s_waitcnt vmcnt(0)" ::: "memory");
        }
    }
    __syncthreads();
}

constexpr int NWAVES = 8;
struct Args { const float* in[23]; float* out; unsigned char* ws; int ph_lo, ph_hi; };
__device__ __forceinline__ bool frame_refresh(struct Frame& F);
struct Frame {
    LAS unsigned char* lds;
    volatile LAS unsigned* MISC;
    gu32* ctl;
    int tid, lane, wave, vcu, G;
    unsigned char* ws;
    const float* const* in;
    float* out;
};
__device__ __forceinline__ bool frame_refresh(Frame& F) { int t = threadIdx.x; asm volatile("" : "+v"(t)); F.tid = t; F.lane = t & 63; F.wave = __builtin_amdgcn_readfirstlane(t >> 6); return true; }
enum In { I_X = 0, I_C, I_WADA, I_BADA, I_NMIX, I_NFFN, I_RELB, I_AWIN, I_AWOUT, I_AQN, I_AKN, I_BWIN, I_BFB, I_BWOUT, I_BQN, I_BKN, I_RGW, I_RGB, I_REW, I_REB, I_WG, I_WU, I_WD };

__device__ __forceinline__ void pro_mod_item(Frame& F, int item) {
    LAS float* s = (LAS float*)(F.lds + RING_OFF);
    LAS float* part = (LAS float*)(F.lds + RING_OFF + 16384);
    const float* c = F.in[I_C];
    for (int i = F.tid; i < 4 * D; i += NWAVES * 64) { const float v = c[i]; s[i] = v / (1.f + __expf(-v)); }
    __syncthreads();
    const int layer = item / 96, cc = item % 96, col = cc * 64 + F.lane;
    const float* W = F.in[I_WADA] + (size_t)layer * D * 6144 + col;
    float a0 = 0.f, a1 = 0.f, a2 = 0.f, a3 = 0.f;
    const int k0 = F.wave * 128;
#pragma unroll 8
    for (int k = k0; k < k0 + 128; ++k) { const float w = W[(size_t)k * 6144]; a0 += s[k] * w; a1 += s[D + k] * w; a2 += s[2 * D + k] * w; a3 += s[3 * D + k] * w; }
    part[(F.wave * 4 + 0) * 64 + F.lane] = a0; part[(F.wave * 4 + 1) * 64 + F.lane] = a1; part[(F.wave * 4 + 2) * 64 + F.lane] = a2; part[(F.wave * 4 + 3) * 64 + F.lane] = a3;
    __syncthreads();
    if (F.wave < 4) {
        float t = 0.f;
#pragma unroll
        for (int w = 0; w < 8; ++w) t += part[(w * 4 + F.wave) * 64 + F.lane];
        float* MOD = (float*)(F.ws + WS_MOD);
        MOD[(size_t)(layer * 4 + F.wave) * 6144 + col] = t + F.in[I_BADA][layer * 6144 + col];
    }
    __syncthreads();
}
__device__ __forceinline__ void pro_biasv(Frame& F) {
    float* BV = (float*)(F.ws + WS_BIASV);
    for (int i = F.tid; i < 48 * 129; i += NWAVES * 64) {
        const int gh = i / 129, dist = i % 129, g = gh / 16, d = dist * dil_of(g);
        int bucket;
        if (d < 16) bucket = d;
        else { const float v = logf((float)d / 16.0f) / 4.852030263919617f * 16.0f; bucket = 16 + (int)v; if (bucket > 31) bucket = 31; }
        BV[gh * BV_PITCH + dist] = F.in[I_RELB][bucket * 48 + gh] * LOG2E;
    }
}
__device__ __forceinline__ int rowmap(int mode, int n) {
    if (mode == 0) return n;
    if (mode == 1) return (n & ~255) + 128 * ((n >> 5) & 1) + 32 * ((n >> 6) & 3) + (n & 31);
    return 256 * (n >> 7) + (n & 127) + (mode == 3 ? 128 : 0);
}
__device__ __forceinline__ void transpose_item(const float* W, int ldw, bf16* WT, int ldt, int k0, int n0, int mode, LAS float* scr, int lane) {
#pragma unroll 8
    for (int i = 0; i < 32; ++i) { const int kk = 2 * i + (lane >> 5); scr[kk * 33 + (lane & 31)] = W[(size_t)(k0 + kk) * ldw + n0 + (lane & 31)]; }
    LDS_WAIT(); asm volatile("" ::: "memory");
    const int c = lane & 7;
#pragma unroll
    for (int j = 0; j < 4; ++j) { const int n = (lane >> 3) + 8 * j; const LAS float* s = scr + (8 * c) * 33 + n;
        v4u o; o.x = pk2(s[0 * 33], s[1 * 33]); o.y = pk2(s[2 * 33], s[3 * 33]); o.z = pk2(s[4 * 33], s[5 * 33]); o.w = pk2(s[6 * 33], s[7 * 33]);
        *(GAS v4u*)(WT + (size_t)rowmap(mode, n0 + n) * ldt + k0 + 8 * c) = o; }
    LDS_WAIT(); asm volatile("" ::: "memory");
}
__device__ __forceinline__ void p0_prologue(Frame& F) {
    if (blockIdx.x < 192) pro_mod_item(F, blockIdx.x);
    if (blockIdx.x == F.G - 1) pro_biasv(F);
    __syncthreads();
    LAS float* scr = (LAS float*)(F.lds + RING_OFF + F.wave * 16384);
    const int gw = F.vcu * NWAVES + F.wave, NGW = F.G * NWAVES;
    constexpr int I_A = 16 * 288, I_AO = 16 * 32, I_B = 16 * 96, I_BO = 16 * 32, I_E = 32 * 128;
    constexpr int NITEMS = I_A + I_AO + I_B + I_BO + 3 * I_E;
    for (int it = gw; it < NITEMS; it += NGW) {
        int r = it;
        if (r < I_A) { transpose_item(F.in[I_AWIN], 9216, (bf16*)(F.ws + WS_WAIN), 1024, 64 * (r / 288), 32 * (r % 288), 1, scr, F.lane); continue; } r -= I_A;
        if (r < I_AO) { transpose_item(F.in[I_AWOUT], 1024, (bf16*)(F.ws + WS_WAOUT), 1024, 64 * (r / 32), 32 * (r % 32), 0, scr, F.lane); continue; } r -= I_AO;
        if (r < I_B) { transpose_item(F.in[I_BWIN], 3088, (bf16*)(F.ws + WS_WBIN), 1024, 64 * (r / 96), 32 * (r % 96), 1, scr, F.lane); continue; } r -= I_B;
        if (r < I_BO) { transpose_item(F.in[I_BWOUT], 1024, (bf16*)(F.ws + WS_WBOUT), 1024, 64 * (r / 32), 32 * (r % 32), 0, scr, F.lane); continue; } r -= I_BO;
        if (r < I_E) { const int le = r / 128, q = r % 128;
            transpose_item(F.in[I_WG] + (size_t)le * D * FF, FF, (bf16*)(F.ws + WS_MOE1) + (size_t)le * 512 * D, 1024, 64 * (q / 8), 32 * (q % 8), 2, scr, F.lane); continue; } r -= I_E;
        if (r < I_E) { const int le = r / 128, q = r % 128;
            transpose_item(F.in[I_WU] + (size_t)le * D * FF, FF, (bf16*)(F.ws + WS_MOE1) + (size_t)le * 512 * D, 1024, 64 * (q / 8), 32 * (q % 8), 3, scr, F.lane); continue; } r -= I_E;
        { const int le = r / 128, q = r % 128;
            transpose_item(F.in[I_WD] + (size_t)le * FF * D, D, (bf16*)(F.ws + WS_MOE2) + (size_t)le * D * FF, 256, 64 * (q / 32), 32 * (q % 32), 0, scr, F.lane); }
    }
}

template <int MODE> __device__ __forceinline__ void rowpass(Frame& F, const float* xin, const float* gain, int layer, int sh_idx, int sc_idx) {
    constexpr int NW = MODE == 1 ? 16 : (MODE == 2 ? 20 : 0);
    LAS float* Wl = (LAS float*)(F.lds + RING_OFF);
    LAS int* rowinfo = (LAS int*)(F.lds + RING_OFF + 98304);
    const float* MOD = (const float*)(F.ws + WS_MOD) + (size_t)layer * 4 * 6144;
    bf16* HM = (bf16*)(F.ws + WS_HM);
    if (MODE == 1) { const float* W = F.in[I_BWIN];
        for (int i = F.tid; i < D * 16; i += NWAVES * 64) { const int c = i >> 4, j = i & 15; Wl[j * D + c] = W[(size_t)c * 3088 + 3072 + j]; } }
    if (MODE == 2) { const float* Wg = F.in[I_RGW] + (size_t)layer * D * 4; const float* We = F.in[I_REW] + (size_t)layer * D * 16;
        for (int i = F.tid; i < D * 4; i += NWAVES * 64) { const int c = i >> 2, j = i & 3; Wl[j * D + c] = Wg[i]; }
        for (int i = F.tid; i < D * 16; i += NWAVES * 64) { const int c = i >> 4, j = i & 15; Wl[(4 + j) * D + c] = We[i]; } }
    __syncthreads();
    for (int rb = blockIdx.x; rb < M / 64; rb += F.G) {
        const int b = (rb * 64) / SEQ;
        f32x4 Gv[4], Sv[4];
#pragma unroll
        for (int j = 0; j < 4; ++j) { const int c = 4 * F.lane + 256 * j;
            const f32x4 gv = *(const f32x4*)(gain + c), sc = *(const f32x4*)(MOD + (size_t)b * 6144 + sc_idx * D + c), sh = *(const f32x4*)(MOD + (size_t)b * 6144 + sh_idx * D + c);
            Gv[j] = gv * (sc + 1.0f); Sv[j] = sh; }
#pragma unroll 1
        for (int grp = 0; grp < 4; ++grp) {
            const int m0 = rb * 64 + F.wave * 8 + grp * 2;
            f32x4 v[2][4];
#pragma unroll
            for (int r = 0; r < 2; ++r) { const GAS f32x4* xr = (const GAS f32x4*)(xin + (size_t)(m0 + r) * D) + F.lane;
#pragma unroll
                for (int j = 0; j < 4; ++j) v[r][j] = xr[64 * j]; }
#pragma unroll
            for (int r = 0; r < 2; ++r) { float ss = 0.f;
#pragma unroll
                for (int j = 0; j < 4; ++j) ss += (v[r][j].x * v[r][j].x + v[r][j].y * v[r][j].y) + (v[r][j].z * v[r][j].z + v[r][j].w * v[r][j].w);
                const float rstd = 1.0f / sqrtf(wave_sum(ss) * (1.f / D) + EPS);
                GAS unsigned long long* o8 = (GAS unsigned long long*)(HM + (size_t)(m0 + r) * D) + F.lane;
#pragma unroll
                for (int j = 0; j < 4; ++j) { v[r][j] = v[r][j] * rstd * Gv[j] + Sv[j];
                    o8[64 * j] = (unsigned long long)pk2(v[r][j].x, v[r][j].y) | ((unsigned long long)pk2(v[r][j].z, v[r][j].w) << 32); } }
            if constexpr (NW > 0) {
                float dots[2][NW > 0 ? NW : 1];
#pragma unroll
                for (int jj = 0; jj < NW; ++jj) {
                    asm volatile("" ::: "memory");
                    float a0 = 0.f, a1 = 0.f;
#pragma unroll
                    for (int j = 0; j < 4; ++j) { const f32x4 w = *(const LAS f32x4*)(Wl + jj * D + 4 * F.lane + 256 * j);
                        a0 += (v[0][j].x * w.x + v[0][j].y * w.y) + (v[0][j].z * w.z + v[0][j].w * w.w);
                        a1 += (v[1][j].x * w.x + v[1][j].y * w.y) + (v[1][j].z * w.z + v[1][j].w * w.w); }
                    dots[0][jj] = wave_sum(a0); dots[1][jj] = wave_sum(a1);
                }
                if constexpr (MODE == 1) {
                    float* LOGF = (float*)(F.ws + WS_LOGF);
#pragma unroll
                    for (int r = 0; r < 2; ++r) { float z = dots[r][0];
#pragma unroll
                        for (int jj = 1; jj < 16; ++jj) z = (F.lane == jj) ? dots[r][jj] : z;
                        if (F.lane < 16) { z += F.in[I_BFB][F.lane]; const float ls = fminf(z, 0.f) - log1pf(expf(-fabsf(z))); LOGF[(size_t)(m0 + r) * 16 + F.lane] = ls; } }
                }
                if constexpr (MODE == 2) {
                    const float* bg = F.in[I_RGB] + layer * 4; const float* be = F.in[I_REB] + layer * 16;
                    v4u* TOKREC = (v4u*)(F.ws + WS_TOKREC);
#pragma unroll
                    for (int r = 0; r < 2; ++r) {
                        const float g0 = dots[r][0] + bg[0], g1 = dots[r][1] + bg[1], g2 = dots[r][2] + bg[2], g3 = dots[r][3] + bg[3];
                        int gi = 0; float gm = g0; if (g1 > gm) { gm = g1; gi = 1; } if (g2 > gm) { gm = g2; gi = 2; } if (g3 > gm) { gm = g3; gi = 3; }
                        const float gw = 1.0f / (expf(g0 - gm) + expf(g1 - gm) + expf(g2 - gm) + expf(g3 - gm));
                        float es[4];
#pragma unroll
                        for (int i = 0; i < 4; ++i) { const float e0 = dots[r][4 + i] + be[i], e1 = dots[r][8 + i] + be[4 + i], e2 = dots[r][12 + i] + be[8 + i], e3 = dots[r][16 + i] + be[12 + i];
                            es[i] = gi == 0 ? e0 : (gi == 1 ? e1 : (gi == 2 ? e2 : e3)); }
                        int i1 = 0; float v1 = es[0];
#pragma unroll
                        for (int i = 1; i < 4; ++i) if (es[i] > v1) { v1 = es[i]; i1 = i; }
                        int i2 = -1; float v2 = -INFINITY;
#pragma unroll
                        for (int i = 0; i < 4; ++i) if (i != i1 && es[i] > v2) { v2 = es[i]; i2 = i; }
                        const float ex = expf(v2 - v1), w1 = gw / (1.0f + ex), w2 = gw * ex / (1.0f + ex);
                        const int a = i1 < i2 ? i1 : i2, bb = i1 < i2 ? i2 : i1;
                        const float wlo = i1 < i2 ? w1 : w2, whi = i1 < i2 ? w2 : w1;
                        const int pidx = a == 0 ? bb - 1 : (a == 1 ? bb + 1 : 5);
                        const int lo = gi * 4 + a, hi = gi * 4 + bb, combo = gi * 6 + pidx;
                        if (F.lane == 0) { v4u rec; rec.x = (unsigned)(lo | (hi << 8) | (combo << 16)); rec.y = __float_as_uint(wlo); rec.z = __float_as_uint(whi); rec.w = 0u;
                            TOKREC[m0 + r] = rec; rowinfo[F.wave * 8 + grp * 2 + r] = lo | (hi << 8) | (combo << 16); }
                    }
                }
            }
        }
        if (MODE == 2) {
            __syncthreads();
            if (F.tid < 40) {
                const int t = F.tid; int n = 0;
#pragma unroll 8
                for (int r = 0; r < 64; ++r) { const int ri = rowinfo[r]; const bool mem = t < 16 ? ((ri & 0xff) == t || ((ri >> 8) & 0xff) == t) : ((ri >> 16) == t - 16); n += mem ? 1 : 0; }
                gu32* cnt = F.ctl + CW_CNT + layer * 64 + (t < 16 ? t : 128 + (t - 16));
                const int base = (int)__hip_atomic_fetch_add(cnt, (unsigned)n, RLX_AGENT);
                int* list = t < 16 ? (int*)(F.ws + WS_ELIST) + t * M : (int*)(F.ws + WS_CLIST) + (t - 16) * M;
                int k = 0;
                for (int r = 0; r < 64; ++r) { const int ri = rowinfo[r]; const bool mem = t < 16 ? ((ri & 0xff) == t || ((ri >> 8) & 0xff) == t) : ((ri >> 16) == t - 16);
                    if (mem) { list[base + k] = rb * 64 + r; ++k; } }
            }
            __syncthreads();
        }
    }
}

__device__ __forceinline__ void cumsum_phase(Frame& F) {
    LAS float* wt = (LAS float*)(F.lds + RING_OFF);
    for (int bh = blockIdx.x; bh < BATCH * H; bh += F.G) {
        const int b = bh / H, h = bh % H;
        const float* LOGF = (const float*)(F.ws + WS_LOGF) + (size_t)b * SEQ * 16 + h;
        float v[8]; float run = 0.f;
#pragma unroll
        for (int i = 0; i < 8; ++i) { run += LOGF[(size_t)(F.tid * 8 + i) * 16]; v[i] = run; }
        float inc = run;
#pragma unroll
        for (int o = 1; o < 64; o <<= 1) { const float n = __shfl_up(inc, o); if (F.lane >= o) inc += n; }
        if (F.lane == 63) wt[F.wave] = inc;
        __syncthreads();
        float base = inc - run;
        for (int w = 0; w < F.wave; ++w) base += wt[w];
        float* CUM = (float*)(F.ws + WS_CUM) + (size_t)bh * SEQ + F.tid * 8;
#pragma unroll
        for (int i = 0; i < 8; ++i) CUM[i] = -(base + v[i]) * LOG2E;
        __syncthreads();
    }
}

namespace pg8 {
typedef unsigned short bf16_t;
typedef unsigned u32x4 __attribute__((ext_vector_type(4)));
constexpr int BM = 256, BK = 64, HALF = 128, HTB = HALF * BK * 2, STAGE_BYTES = 8 * HTB, NXCD = 8, WGM = 8;
__host__ __device__ __forceinline__ int lds_byte(int r, int c) { const int st = (r >> 4) * 2 + (c >> 5), rr = r & 15, cc = c & 31, ob = rr * 64 + cc * 2; return st * 1024 + (ob ^ (((ob >> 9) & 1) << 5)); }
__host__ __device__ __forceinline__ void stage_rc(int b, int& R, int& C) { const int st = b / 1024, sb = b % 1024, swz = sb ^ (((sb >> 9) & 1) << 5); R = (st >> 1) * 16 + swz / 64; C = (st & 1) * 32 + (swz % 64) / 2; }
__host__ __device__ __forceinline__ int perm32(int rho) { const int n = rho >> 4, i = rho & 15; return 8 * (i >> 2) + 4 * n + (i & 3); }
struct Unit { int pm, pn, e, cnt; };
__device__ __forceinline__ unsigned cvt_pk_bf16(float lo, float hi) { unsigned r; asm volatile("v_cvt_pk_bf16_f32 %0, %1, %2" : "=v"(r) : "v"(lo), "v"(hi)); return r; }

struct StaticOrder {
    int nM, nN, nwg, G, c; const char* A; const char* Bt; size_t tstepA, tstepB; int ks;
    __device__ void init(int M_, int N_, int G_, int c_, const void* A_, int lda, const void* Bt_, int ldb, int nt) { nM = M_ / BM; nN = N_ / BM; nwg = nM * nN; G = G_; c = c_; A = (const char*)A_; Bt = (const char*)Bt_; tstepA = (size_t)BM * lda * 2; tstepB = (size_t)BM * ldb * 2; ks = nt; }
    __device__ bool next(int i, Unit& u) const {
        const long L = (long)i * G + c; if (L >= nwg) return false;
        int wgid = (int)L; { const int q = nwg / NXCD, r = nwg % NXCD, xcd = wgid % NXCD, off = wgid / NXCD; wgid = (xcd < r ? xcd * (q + 1) : r * (q + 1) + (xcd - r) * q) + off; }
        const int nig = WGM * nN, gid = wgid / nig, fm = gid * WGM, gsz = (nM - fm) < WGM ? (nM - fm) : WGM;
        u.pm = fm + ((wgid % nig) % gsz); u.pn = (wgid % nig) / gsz; u.e = 0; u.cnt = 0; return true;
    }
    __device__ __forceinline__ const char* a_base(const Unit& u) const { return A + (size_t)u.pm * tstepA; }
    __device__ __forceinline__ const char* b_lo(const Unit& u) const { return Bt + (size_t)u.pn * tstepB; }
    __device__ __forceinline__ const char* b_hi(const Unit& u) const { return Bt + (size_t)u.pn * tstepB; }
    __device__ __forceinline__ int row(const Unit&, int) const { return 0; }
};
struct MoeOrder {
    int G, c, nl, ntn, ks, mode; const char* A; const char* B; const int* lists; const LAS int* tab;
    __device__ bool next(int i, Unit& u) const {
        const int L = i * G + c, total = __builtin_amdgcn_readfirstlane(tab[nl]) * ntn; if (L >= total) return false;
        const int rt = L / ntn; int e = 0;
        for (int k = 1; k < nl; ++k) e = (tab[k] <= rt) ? k : e;
        u.e = __builtin_amdgcn_readfirstlane(e); u.pm = __builtin_amdgcn_readfirstlane(rt - tab[e]); u.pn = L % ntn; u.cnt = __builtin_amdgcn_readfirstlane(tab[32 + e]); return true;
    }
    __device__ __forceinline__ const char* a_base(const Unit&) const { return A; }
    __device__ __forceinline__ const char* b_lo(const Unit& u) const {
        if (mode == 1) return B + ((size_t)u.e * 512 + (size_t)u.pn * 256) * 1024 * 2;
        const int g = u.e / 6, p = u.e % 6, a = p < 3 ? 0 : (p < 5 ? 1 : 2);
        return B + ((size_t)(g * 4 + a) * 1024 + (size_t)u.pn * 256) * 256 * 2; }
    __device__ __forceinline__ const char* b_hi(const Unit& u) const {
        if (mode == 1) return b_lo(u);
        const int g = u.e / 6, p = u.e % 6, b = p < 3 ? p + 1 : (p < 5 ? p - 1 : 3);
        return B + ((size_t)(g * 4 + b) * 1024 + (size_t)u.pn * 256) * 256 * 2; }
    __device__ __forceinline__ int row(const Unit& u, int r) const { int idx = u.pm * 256 + r; idx = idx < u.cnt ? idx : u.cnt - 1; return lists[(size_t)u.e * 16384 + idx]; }
};

struct EpiQKV {
    static constexpr bool PERM = true;
    bf16_t* Qo; const float* qg; const float* kg;
    __device__ __forceinline__ void operator()(const f32x4 (&acc)[2][2][4][2], const Unit& u, int wr, int wc, int fr, int fq) const {
        const int t = u.pn >> 2, hcol = (u.pn & 3) * 256 + wc * 64;
        bf16_t* base = Qo + (size_t)t * ((WS_K - WS_Q) / 2) + hcol + 8 * fq;
        f32x4 gv[2][2];
        const float* gp = qg + (t == 1 ? (kg - qg) : 0) + 8 * fq;
#pragma unroll
        for (int bj = 0; bj < 2; ++bj)
#pragma unroll
            for (int n = 0; n < 2; ++n) gv[bj][n] = (t < 2) ? *(const f32x4*)(gp + 32 * bj + 4 * n) : (f32x4){1.f, 1.f, 1.f, 1.f};
        const float sc = (t == 0) ? C2 : 1.0f;
#pragma unroll
        for (int ai = 0; ai < 2; ++ai)
#pragma unroll
            for (int m = 0; m < 4; ++m) {
                float rs = sc;
                if (t < 2) { float ss = 0.f;
#pragma unroll
                    for (int bj = 0; bj < 2; ++bj)
#pragma unroll
                        for (int n = 0; n < 2; ++n) { const f32x4 x = acc[ai][bj][m][n]; ss += (x[0] * x[0] + x[1] * x[1]) + (x[2] * x[2] + x[3] * x[3]); }
                    ss += __shfl_xor(ss, 16); ss += __shfl_xor(ss, 32);
                    rs = sc / sqrtf(ss * (1.0f / 64.0f) + EPS); }
                bf16_t* rowp = base + (size_t)(u.pm * BM + ai * HALF + wr * 64 + m * 16 + fr) * 1024;
#pragma unroll
                for (int bj = 0; bj < 2; ++bj) { const f32x4 v0 = acc[ai][bj][m][0] * rs * gv[bj][0], v1 = acc[ai][bj][m][1] * rs * gv[bj][1];
                    u32x4 w; w.x = cvt_pk_bf16(v0[0], v0[1]); w.y = cvt_pk_bf16(v0[2], v0[3]); w.z = cvt_pk_bf16(v1[0], v1[1]); w.w = cvt_pk_bf16(v1[2], v1[3]);
                    *(u32x4*)(rowp + 32 * bj) = w; } }
    }
};
struct EpiOut {
    static constexpr bool PERM = false;
    const float* xin; float* xout; const float* gvec;
    __device__ __forceinline__ void operator()(const f32x4 (&acc)[2][2][4][2], const Unit& u, int wr, int wc, int fr, int fq) const {
        const int col0 = u.pn * BM + wc * 32 + 4 * fq, b = (u.pm * BM) / SEQ;
        f32x4 g[2][2];
#pragma unroll
        for (int bj = 0; bj < 2; ++bj)
#pragma unroll
            for (int n = 0; n < 2; ++n) g[bj][n] = *(const f32x4*)(gvec + (size_t)b * 6144 + col0 + bj * HALF + n * 16);
#pragma unroll
        for (int ai = 0; ai < 2; ++ai)
#pragma unroll
            for (int m = 0; m < 4; ++m) { const size_t off = (size_t)(u.pm * BM + ai * HALF + wr * 64 + m * 16 + fr) * D + col0;
#pragma unroll
                for (int bj = 0; bj < 2; ++bj)
#pragma unroll
                    for (int n = 0; n < 2; ++n) { const f32x4 xi = *(const f32x4*)(xin + off + bj * HALF + n * 16); *(f32x4*)(xout + off + bj * HALF + n * 16) = xi + g[bj][n] * acc[ai][bj][m][n]; }
                if (m & 1) asm volatile("" ::: "memory"); }
    }
};
struct EpiMoe1 {
    static constexpr bool PERM = true;
    const int* lists; const v4u* tokrec; bf16_t* HID2;
    __device__ __forceinline__ void operator()(const f32x4 (&acc)[2][2][4][2], const Unit& u, int wr, int wc, int fr, int fq) const {
        const int f = u.pn * 128 + wc * 32 + 8 * fq;
#pragma unroll
        for (int ai = 0; ai < 2; ++ai)
#pragma unroll
            for (int m = 0; m < 4; ++m) { const int idx = u.pm * BM + ai * HALF + wr * 64 + m * 16 + fr;
                if (idx < u.cnt) { const int tok = lists[(size_t)u.e * 16384 + idx]; const v4u rec = tokrec[tok];
                    const int slot = ((int)(rec.x & 0xffu) == u.e) ? 0 : 1; const float w = __uint_as_float(slot ? rec.z : rec.y);
                    float h[8];
#pragma unroll
                    for (int n = 0; n < 2; ++n)
#pragma unroll
                        for (int j = 0; j < 4; ++j) { const float g = acc[ai][0][m][n][j], up = acc[ai][1][m][n][j]; h[n * 4 + j] = g / (1.0f + __expf(-g)) * up * w; }
                    u32x4 o; o.x = cvt_pk_bf16(h[0], h[1]); o.y = cvt_pk_bf16(h[2], h[3]); o.z = cvt_pk_bf16(h[4], h[5]); o.w = cvt_pk_bf16(h[6], h[7]);
                    *(u32x4*)(HID2 + (size_t)tok * 512 + slot * 256 + f) = o; } }
    }
};
struct EpiMoe2 {
    static constexpr bool PERM = false;
    const int* lists; float* x; const float* gvec;
    __device__ __forceinline__ void operator()(const f32x4 (&acc)[2][2][4][2], const Unit& u, int wr, int wc, int fr, int fq) const {
        const int col0 = u.pn * BM + wc * 32 + 4 * fq;
#pragma unroll
        for (int ai = 0; ai < 2; ++ai)
#pragma unroll
            for (int m = 0; m < 4; ++m) { const int idx = u.pm * BM + ai * HALF + wr * 64 + m * 16 + fr;
                if (idx < u.cnt) { const int tok = lists[(size_t)u.e * 16384 + idx]; const int b = tok / SEQ; const size_t off = (size_t)tok * D + col0;
#pragma unroll
                    for (int bj = 0; bj < 2; ++bj)
#pragma unroll
                        for (int n = 0; n < 2; ++n) { const f32x4 g = *(const f32x4*)(gvec + (size_t)b * 6144 + col0 + bj * HALF + n * 16);
                            const f32x4 xi = *(const f32x4*)(x + off + bj * HALF + n * 16); *(f32x4*)(x + off + bj * HALF + n * 16) = xi + g * acc[ai][bj][m][n]; } }
                if (m & 1) asm volatile("" ::: "memory"); }
    }
};

template <class Epi, class Sched, bool GATHER, bool ALIGN_EPI>
__device__ __forceinline__ void gemm_phase(LAS unsigned char* lds, const int lda, const int ldb, const int K, const Sched& S, const Epi& E) {
    int tid_ = threadIdx.x; asm volatile("" : "+v"(tid_));
    const int tid = tid_, wid = __builtin_amdgcn_readfirstlane(tid >> 6), lane = tid & 63, wr = wid >> 2, wc = wid & 3, fr = lane & 15, fq = lane >> 4;
    const int nt = K / BK, ks = S.ks;
    unsigned voffA[2][2], voffB[2], nvA[2][2];
#pragma unroll
    for (int i = 0; i < 2; ++i) { int R, C; stage_rc(tid * 16 + i * 8192, R, C); const int Rb = Epi::PERM ? ((R & ~31) + perm32(R & 31)) : R;
        voffB[i] = (unsigned)(Rb * ldb + C) * 2u; voffA[0][i] = (unsigned)(R * lda + C) * 2u; voffA[1][i] = 0u; nvA[0][i] = 0u; nvA[1][i] = 0u; }
    const size_t kstep = (size_t)(BK * 2);
    const size_t hstepA = GATHER ? (size_t)0 : (size_t)HALF * lda * 2, hstepB = (size_t)HALF * ldb * 2;
    const unsigned ldsw = (unsigned)wid * 1024u;
    const int aoff = lds_byte(wr * 64 + fr, fq * 8), boff = lds_byte(wc * 32 + fr, fq * 8);
#define PG8_SA(b, h) (((b) * 2 + (h)) * HTB)
#define PG8_SB(b, h) ((4 + (b) * 2 + (h)) * HTB)
#define PG8_STAGE(bufoff, gbase, voff) do { _Pragma("unroll") for (int _i = 0; _i < 2; ++_i) \
        __builtin_amdgcn_global_load_lds((const unsigned*)((const char*)(gbase) + (voff)[_i]), (LAS unsigned*)(lds + (bufoff) + ldsw + _i * 8192), 16, 0, 0); } while (0)
#define PG8_STAGE_A(bufoff, gbase, h) do { if constexpr (GATHER) { PG8_STAGE(bufoff, gbase, voffA[h]); } else { PG8_STAGE(bufoff, (gbase) + (h) * hstepA, voffA[0]); } } while (0)
#define PG8_STAGE_B(bufoff, gbase, h) PG8_STAGE(bufoff, (gbase) + (h) * hstepB, voffB)
#define PG8_GATHER_OFFS(dst, u) do { _Pragma("unroll") for (int _h = 0; _h < 2; ++_h) _Pragma("unroll") for (int _i = 0; _i < 2; ++_i) { int _R, _C; stage_rc(tid * 16 + _i * 8192, _R, _C); \
        dst[_h][_i] = (unsigned)(S.row(u, _h * HALF + _R) * lda + _C) * 2u; } } while (0)
#define PG8_LDA(dst, b, h) do { _Pragma("unroll") for (int m = 0; m < 4; ++m) _Pragma("unroll") for (int k = 0; k < 2; ++k) dst[m][k] = *(const LAS bf16x8*)(lds + PG8_SA(b, h) + aoff + m * 2048 + k * 1024); } while (0)
#define PG8_LDB(dst, b, h) do { _Pragma("unroll") for (int n = 0; n < 2; ++n) _Pragma("unroll") for (int k = 0; k < 2; ++k) dst[n][k] = *(const LAS bf16x8*)(lds + PG8_SB(b, h) + boff + n * 2048 + k * 1024); } while (0)
#define PG8_MMA(ai, bj, At, Bt) do { __builtin_amdgcn_s_setprio(1); _Pragma("unroll") for (int m = 0; m < 4; ++m) _Pragma("unroll") for (int n = 0; n < 2; ++n) _Pragma("unroll") for (int k = 0; k < 2; ++k) \
        acc[ai][bj][m][n] = __builtin_amdgcn_mfma_f32_16x16x32_bf16(Bt[n][k], At[m][k], acc[ai][bj][m][n], 0, 0, 0); __builtin_amdgcn_s_setprio(0); } while (0)
#define PG8_WAIT_V(n) asm volatile("s_waitcnt vmcnt(" #n ")" ::: "memory")
#define PG8_WAIT_L(n) asm volatile("s_waitcnt lgkmcnt(" #n ")" ::: "memory")
#define PG8_BAR __builtin_amdgcn_s_barrier()
#define PG8_SCHED __builtin_amdgcn_sched_barrier(0)
#define PG8_BPTR(blo, bhi, t) (((t) < ks) ? (blo) + (size_t)(t) * kstep : (bhi) + (size_t)((t) - ks) * kstep)
    Unit cur, nxt; int ui = 0;
    if (!S.next(0, cur)) return;
    f32x4 acc[2][2][4][2];
#pragma unroll
    for (int a = 0; a < 2; ++a)
#pragma unroll
        for (int b = 0; b < 2; ++b)
#pragma unroll
            for (int m = 0; m < 4; ++m)
#pragma unroll
                for (int n = 0; n < 2; ++n) acc[a][b][m][n] = (f32x4){0.f, 0.f, 0.f, 0.f};
    bf16x8 At[4][2], B0[2][2], B1[2][2];
    const char* cA = S.a_base(cur); const char* cBlo = S.b_lo(cur); const char* cBhi = S.b_hi(cur);
    if constexpr (GATHER) { PG8_GATHER_OFFS(voffA, cur); }
    PG8_STAGE_B(PG8_SB(0, 0), cBlo, 0); PG8_STAGE_B(PG8_SB(0, 1), cBlo, 1); PG8_STAGE_A(PG8_SA(0, 0), cA, 0); PG8_STAGE_A(PG8_SA(0, 1), cA, 1);
    if (wr == 1) PG8_BAR;
    PG8_WAIT_V(2); PG8_BAR;
    PG8_STAGE_B(PG8_SB(1, 0), cBlo + kstep, 0); PG8_STAGE_A(PG8_SA(1, 0), cA + kstep, 0); PG8_STAGE_B(PG8_SB(1, 1), cBlo + kstep, 1);
    PG8_WAIT_V(6); PG8_BAR;
    for (;;) {
        const bool has_next = S.next(ui + 1, nxt);
        const char* nA = has_next ? S.a_base(nxt) : cA; const char* nBlo = has_next ? S.b_lo(nxt) : cBlo; const char* nBhi = has_next ? S.b_hi(nxt) : cBhi;
        if constexpr (GATHER) { if (has_next) { PG8_GATHER_OFFS(nvA, nxt); } else {
#pragma unroll
            for (int h = 0; h < 2; ++h)
#pragma unroll
                for (int i = 0; i < 2; ++i) nvA[h][i] = voffA[h][i]; } }
#pragma unroll 1
        for (int t = 0; t < nt; t += 2) {
            const bool last = (t == nt - 2);
            const char* a1 = cA + (size_t)(t + 1) * kstep;
            const char* a2 = last ? nA : cA + (size_t)(t + 2) * kstep; const char* b2 = last ? nBlo : PG8_BPTR(cBlo, cBhi, t + 2);
            const char* a3 = a2 + kstep; const char* b3 = b2 + kstep;
            PG8_LDB(B0, 0, 0); PG8_LDB(B1, 0, 1); PG8_SCHED; PG8_LDA(At, 0, 0); PG8_STAGE_A(PG8_SA(1, 1), a1, 1);
            if constexpr (GATHER) { if (last) {
#pragma unroll
                for (int h = 0; h < 2; ++h)
#pragma unroll
                    for (int i = 0; i < 2; ++i) voffA[h][i] = nvA[h][i]; } }
            PG8_WAIT_V(8); PG8_WAIT_L(0); PG8_BAR; PG8_MMA(0, 0, At, B0); PG8_MMA(0, 1, At, B1); PG8_BAR; PG8_SCHED;
            PG8_LDA(At, 0, 1); PG8_STAGE_B(PG8_SB(0, 0), b2, 0); PG8_STAGE_B(PG8_SB(0, 1), b2, 1); PG8_STAGE_A(PG8_SA(0, 0), a2, 0);
            PG8_WAIT_V(8); PG8_WAIT_L(0); PG8_BAR; PG8_MMA(1, 0, At, B0); PG8_MMA(1, 1, At, B1); PG8_BAR; PG8_SCHED;
            PG8_LDB(B0, 1, 0); PG8_LDB(B1, 1, 1); PG8_SCHED; PG8_LDA(At, 1, 0); PG8_STAGE_A(PG8_SA(0, 1), a2, 1);
            PG8_WAIT_V(8); PG8_WAIT_L(0); PG8_BAR; PG8_MMA(0, 0, At, B0); PG8_MMA(0, 1, At, B1); PG8_BAR; PG8_SCHED;
            PG8_LDA(At, 1, 1); PG8_STAGE_B(PG8_SB(1, 0), b3, 0); PG8_STAGE_B(PG8_SB(1, 1), b3, 1); PG8_STAGE_A(PG8_SA(1, 0), a3, 0);
            PG8_WAIT_V(8); PG8_WAIT_L(0); PG8_BAR; PG8_MMA(1, 0, At, B0); PG8_MMA(1, 1, At, B1); PG8_BAR; PG8_SCHED;
        }
        if constexpr (ALIGN_EPI) { if (wr == 0) PG8_BAR; }
        E(acc, cur, wr, wc, fr, fq);
        if (!has_next) break;
#pragma unroll
        for (int a = 0; a < 2; ++a)
#pragma unroll
            for (int b = 0; b < 2; ++b)
#pragma unroll
                for (int m = 0; m < 4; ++m)
#pragma unroll
                    for (int n = 0; n < 2; ++n) acc[a][b][m][n] = (f32x4){0.f, 0.f, 0.f, 0.f};
        cur = nxt; cA = nA; cBlo = nBlo; cBhi = nBhi; ++ui;
        if constexpr (ALIGN_EPI) { if (wr == 1) PG8_BAR; }
    }
    PG8_WAIT_V(0);
    if constexpr (!ALIGN_EPI) { if (wr == 0) PG8_BAR; }
    PG8_BAR;
#undef PG8_SA
#undef PG8_SB
#undef PG8_STAGE
#undef PG8_STAGE_A
#undef PG8_STAGE_B
#undef PG8_GATHER_OFFS
#undef PG8_LDA
#undef PG8_LDB
#undef PG8_MMA
#undef PG8_WAIT_V
#undef PG8_WAIT_L
#undef PG8_BAR
#undef PG8_SCHED
#undef PG8_BPTR
}
}

namespace attn_body {
using bf16=__hip_bfloat16;
using bf16x8=__attribute__((ext_vector_type(8)))short;
using s16x4=__attribute__((ext_vector_type(4)))short;
using f32x16=__attribute__((ext_vector_type(16)))float;
using u32x4=__attribute__((ext_vector_type(4)))unsigned;
constexpr int BATCH=4,NHEAD=16,SEQ=4096,D=64,DM=NHEAD*D;
constexpr int NW=8,QBLK=32,QB=QBLK*NW,KVBLK=64,NQB=SEQ/QB;
constexpr int ATTN_PITCH=DM, ATTN_UNIT_ROWS=QB;
__device__ __forceinline__ int crow(int r,int hi){return (r&3)+8*(r>>2)+4*hi;}
#define SBAR() __builtin_amdgcn_sched_barrier(0)
__device__ __forceinline__ void cmask(f32x16&p0,f32x16&p1,int jb,int qrel,int hi){
  const float NEG=-INFINITY; int kb=64*jb+4*hi;
  #pragma unroll
  for(int r=0;r<16;++r){int kv=kb+(r&3)+8*(r>>2); if(kv>qrel)p0[r]=NEG; if(kv+32>qrel)p1[r]=NEG;}
}

constexpr int NSLOT=3, SLOTB=8192;
constexpr int LDS_K=0, LDS_V=NSLOT*SLOTB, LDS_WS=2*NSLOT*SLOTB, LDS_OST=LDS_WS+NW*64*4, LDS_BYTES=LDS_OST+NW*4096;
constexpr float C2=0.125f*1.4426950408889634f;
__device__ __forceinline__ void glds16(const void*gsrc,unsigned lds_dst){unsigned keep;
  asm volatile("s_mov_b32 %0, m0\n\ts_mov_b32 m0, %2\n\ts_nop 0\n\tglobal_load_lds_dwordx4 %1, off\n\ts_mov_b32 m0, %0":"=&s"(keep):"v"(gsrc),"s"(lds_dst):"memory");}
__device__ __forceinline__ float max3f(float a,float b,float c){float r;asm("v_max3_f32 %0, %1, %2, %3":"=v"(r):"v"(a),"v"(b),"v"(c));return r;}
__device__ __forceinline__ float max2f(float a,float b){float r;asm("v_max_f32_e32 %0, %1, %2":"=v"(r):"v"(a),"v"(b));return r;}
__device__ __forceinline__ float fadd_s(float a,float b){float r;asm("v_add_f32_e32 %0, %1, %2":"=v"(r):"v"(a),"v"(b));return r;}
__device__ __forceinline__ float fsub_s(float a,float b){float r;asm("v_sub_f32_e32 %0, %1, %2":"=v"(r):"v"(a),"v"(b));return r;}
typedef float f32x2_t __attribute__((ext_vector_type(2))); typedef float f32x4_t __attribute__((ext_vector_type(4))); typedef __bf16 bf16x2_t __attribute__((ext_vector_type(2)));
__device__ __forceinline__ unsigned cvtpk_s(float lo,float hi){f32x2_t v={lo,hi};bf16x2_t b=__builtin_convertvector(v,bf16x2_t);return __builtin_bit_cast(unsigned,b);}
#define WAIT_BAR(N) asm volatile("s_waitcnt vmcnt(" #N ") lgkmcnt(0)\n\ts_barrier":::"memory")

__device__ __forceinline__ void qkt(f32x16&p0,f32x16&p1,const char*Kslot,const bf16x8*qr,const f32x16&negm,int r32,int hi){
  const char*kb=Kslot+hi*1024+r32*16;
  #pragma unroll
  for(int d0=0;d0<4;++d0){
    const bf16x8 b0=*reinterpret_cast<const bf16x8*>(kb+d0*2048);
    const bf16x8 b1=*reinterpret_cast<const bf16x8*>(kb+d0*2048+512);
    if(d0==0){p0=__builtin_amdgcn_mfma_f32_32x32x16_bf16(b0,qr[0],negm,0,0,0);p1=__builtin_amdgcn_mfma_f32_32x32x16_bf16(b1,qr[0],negm,0,0,0);}
    else{p0=__builtin_amdgcn_mfma_f32_32x32x16_bf16(b0,qr[d0],p0,0,0,0);p1=__builtin_amdgcn_mfma_f32_32x32x16_bf16(b1,qr[d0],p1,0,0,0);}}
}
typedef __attribute__((address_space(3))) const char* lds_cptr;
typedef short v4i16_t __attribute__((ext_vector_type(4)));
__device__ __forceinline__ void kload8(bf16x8*kf,lds_cptr kp){
  kf[0]=*(const __attribute__((address_space(3))) bf16x8*)(kp);      kf[1]=*(const __attribute__((address_space(3))) bf16x8*)(kp+512);
  kf[2]=*(const __attribute__((address_space(3))) bf16x8*)(kp+2048); kf[3]=*(const __attribute__((address_space(3))) bf16x8*)(kp+2560);
  kf[4]=*(const __attribute__((address_space(3))) bf16x8*)(kp+4096); kf[5]=*(const __attribute__((address_space(3))) bf16x8*)(kp+4608);
  kf[6]=*(const __attribute__((address_space(3))) bf16x8*)(kp+6144); kf[7]=*(const __attribute__((address_space(3))) bf16x8*)(kp+6656);
}
__device__ __forceinline__ void kload2(bf16x8*kf,lds_cptr kp,int j){ kf[2*j]=*(const __attribute__((address_space(3))) bf16x8*)(kp+j*2048); kf[2*j+1]=*(const __attribute__((address_space(3))) bf16x8*)(kp+j*2048+512); }
__device__ __forceinline__ s16x4 vtr(lds_cptr p){ return __builtin_bit_cast(s16x4,__builtin_amdgcn_ds_read_tr16_b64_v4i16((__attribute__((address_space(3))) v4i16_t*)p)); }
__device__ __forceinline__ float rowmax(const f32x16&p0,const f32x16&p1){
  float a=max3f(p0[0],p0[1],p1[0]),b=max3f(p0[2],p0[3],p1[1]);a=max3f(a,p1[2],p1[3]);
  #pragma unroll
  for(int r=4;r<16;r+=4){a=max3f(a,p0[r],p0[r+1]);b=max3f(b,p0[r+2],p0[r+3]);a=max3f(a,p1[r],p1[r+1]);b=max3f(b,p1[r+2],p1[r+3]);}
  const float m=max2f(a,b);
  auto rr=__builtin_amdgcn_permlane32_swap(__float_as_uint(m),__float_as_uint(m),false,false);
  return max2f(__uint_as_float(rr[0]),__uint_as_float(rr[1]));
}
__device__ __forceinline__ void pv(f32x16*o,int vb,bf16x8 pa0,bf16x8 pa1,bf16x8 pa2,bf16x8 pa3){
  #pragma unroll
  for(int d0=0;d0<2;++d0){s16x4 lo[4],hi[4];
    #pragma unroll
    for(int ks=0;ks<4;++ks){
      asm volatile("ds_read_b64_tr_b16 %0,%1 offset:%c2":"=&v"(lo[ks]):"v"(vb),"i"(d0*4096+ks*1024):"memory");
      asm volatile("ds_read_b64_tr_b16 %0,%1 offset:%c2":"=&v"(hi[ks]):"v"(vb),"i"(d0*4096+ks*1024+512):"memory");}
    asm volatile("s_waitcnt lgkmcnt(0)":::"memory");SBAR();
    #define PK(k) (bf16x8){lo[k][0],lo[k][1],lo[k][2],lo[k][3],hi[k][0],hi[k][1],hi[k][2],hi[k][3]}
    o[d0]=__builtin_amdgcn_mfma_f32_32x32x16_bf16(pa0,PK(0),o[d0],0,0,0);
    o[d0]=__builtin_amdgcn_mfma_f32_32x32x16_bf16(pa1,PK(1),o[d0],0,0,0);
    o[d0]=__builtin_amdgcn_mfma_f32_32x32x16_bf16(pa2,PK(2),o[d0],0,0,0);
    o[d0]=__builtin_amdgcn_mfma_f32_32x32x16_bf16(pa3,PK(3),o[d0],0,0,0);
    #undef PK
  }
}

#ifndef ATTN_STORE16
#define ATTN_STORE16(p,v) (*(u32x4*)(p)=(v))
#endif
template<int THRL> __device__ __forceinline__ void attn_unit(int b,int h,int qb,const bf16*Q,const bf16*__restrict__ K,const bf16*__restrict__ V,bf16*O,char*shm,const __attribute__((address_space(3))) float*ncum){
  int tid_=threadIdx.x; asm volatile("":"+v"(tid_)); const int tid=tid_,lane=tid&63,r32=lane&31,hi=lane>>5; const int wid=__builtin_amdgcn_readfirstlane(tid>>6);
  const long rowbase=(long)b*SEQ; const int q0=qb*QB;
  const bf16*Qw=Q+(rowbase+q0+wid*QBLK)*DM+h*D;
  const bf16*Kh=K+rowbase*DM+h*D,*Vh=V+rowbase*DM+h*D;
  const unsigned lds0=(unsigned)(uintptr_t)shm;
  float*wsf=(float*)(shm+LDS_WS)+wid*64;
  const bf16*ksrc=Kh+(long)lane*DM+wid*8;
  const bf16*vsrc=Vh+(long)(16*(wid&3)+(lane>>2))*DM+(wid>>2)*32+(lane&3)*8;
  const unsigned kdst=lds0+LDS_K+wid*1024, vdst=lds0+LDS_V+wid*1024;
  #define DMA_K(t,slot) glds16(ksrc+(long)(t)*KVBLK*DM,(unsigned)__builtin_amdgcn_readfirstlane(kdst+(slot)))
  #define DMA_V(t,slot) glds16(vsrc+(long)(t)*KVBLK*DM,(unsigned)__builtin_amdgcn_readfirstlane(vdst+(slot)))
  const int vb0=(int)(lds0+LDS_V)+((lane>>4)&1)*32+(lane&3)*8+(4*hi+((lane&15)>>2))*64;
  const char*Kbase=shm+LDS_K; bf16x8 kf[8];
  const lds_cptr shm3=(lds_cptr)shm; const lds_cptr kp0=shm3+LDS_K+hi*1024+r32*16; const lds_cptr vp0=shm3+LDS_V+((lane>>4)&1)*32+(lane&3)*8+(4*hi+((lane&15)>>2))*64;
  const int NT=(q0+QB)/KVBLK;
  DMA_K(0,0);DMA_V(0,0);DMA_K(1,SLOTB);
  bf16x8 qr[4];
  #pragma unroll
  for(int d0=0;d0<4;++d0)qr[d0]=*reinterpret_cast<const bf16x8*>(&Qw[(long)r32*DM+d0*16+hi*8]);
  float mhat=0.f,l_reg=0.f;f32x16 o[2];o[0]=f32x16{};o[1]=f32x16{};f32x16 negm; { float z_=0.f; asm volatile("":"+v"(z_)); _Pragma("unroll") for(int r=0;r<16;++r)negm[r]=z_; } asm volatile("":"+v"(negm));
  const int qrel=wid*QBLK+r32;
  #define CMASK(P0,P1,t) do{int jb_=(t)-(NT-4); if(jb_>=0)cmask(P0,P1,jb_,qrel,hi);}while(0)
  #define CBIAS(P0,P1,t) do{ const __attribute__((address_space(3))) float*cb_=ncum+64*(t)+4*hi; \
    _Pragma("unroll") for(int g4=0;g4<4;++g4){ const f32x4_t b0_=*(const __attribute__((address_space(3))) f32x4_t*)(cb_+8*g4); const f32x4_t b1_=*(const __attribute__((address_space(3))) f32x4_t*)(cb_+32+8*g4); \
      P0[4*g4]+=b0_[0];P0[4*g4+1]+=b0_[1];P0[4*g4+2]+=b0_[2];P0[4*g4+3]+=b0_[3]; P1[4*g4]+=b1_[0];P1[4*g4+1]+=b1_[1];P1[4*g4+2]+=b1_[2];P1[4*g4+3]+=b1_[3]; } }while(0)
  bool resc=false;
  #define START(P0,P1) do{ const float rm=rowmax(P0,P1); resc=false; \
    { const float dl=rm; mhat=fadd_s(mhat,dl); \
      _Pragma("unroll") for(int r=0;r<16;++r){P0[r]=fsub_s(P0[r],dl);P1[r]=fsub_s(P1[r],dl);} \
      _Pragma("unroll") for(int r=0;r<16;++r)negm[r]=-mhat; asm volatile("":"+v"(negm)); } \
    _Pragma("unroll") for(int r=0;r<16;++r)P0[r]=__builtin_amdgcn_exp2f(P0[r]); }while(0)
  #define RESC() do{ if(resc){ asm volatile("s_waitcnt lgkmcnt(0)":::"memory"); \
      _Pragma("unroll") for(int d_=0;d_<2;++d_) _Pragma("unroll") for(int r=0;r<16;++r)o[d_][r]*=wsf[crow(r,hi)]; } }while(0)
  f32x16 pA0,pA1,pB0,pB1;
  int sl_prev=0,sl_cur=0,sl_next=SLOTB;
  #define ROT() do{sl_prev=sl_cur;sl_cur=sl_next;sl_next=(sl_next==(NSLOT-1)*SLOTB)?0:sl_next+SLOTB;}while(0)
  DMA_K(2,2*SLOTB);
  WAIT_BAR(3);
  qkt(pA0,pA1,Kbase,qr,negm,r32,hi);asm volatile("s_nop 15\n\ts_nop 7":"+v"(pA0),"+v"(pA1));CBIAS(pA0,pA1,0);CMASK(pA0,pA1,0);
  START(pA0,pA1);
  _Pragma("unroll") for(int r=0;r<16;++r)pA1[r]=__builtin_amdgcn_exp2f(pA1[r]);
  WAIT_BAR(0);
  DMA_K(3,0);DMA_V(1,SLOTB);
  ROT();
  kload8(kf,kp0+sl_cur);
  WAIT_BAR(2);
  s16x4 vlo[8],vhi[8]; u32x4 pw0,pw1,pw2,pw3;
  #define PKW(P,B) cvtpk_s(P[B],P[B+1])
  #define PAF(k) __builtin_bit_cast(bf16x8,pw##k)
  #define VFR(i) (bf16x8){vlo[i][0],vlo[i][1],vlo[i][2],vlo[i][3],vhi[i][0],vhi[i][1],vhi[i][2],vhi[i][3]}
  #define PIN(x) asm volatile("":"+v"(x))
  #define MX3(a,b,c) __builtin_fmaxf(__builtin_fmaxf((a),(b)),(c))
  #define GAPA(MF,A0,A1,A2,A3,W0,W1,PW) do{ MF; sacc+=A0; sacc+=A1; sacc+=A2; sacc+=A3; PIN(sacc); W0; W1; PIN(PW); SBAR(); }while(0)
  #define EX(v) __builtin_amdgcn_exp2f(v)
  #define GAPB(MF,X,B) do{ MF; X[B]=EX(X[B]); X[B+1]=EX(X[B+1]); X[B+2]=EX(X[B+2]); X[B+3]=EX(X[B+3]); PIN(X); SBAR(); }while(0)
  #define VRD(i) do{ vlo[i]=vtr(vp_+(((i)>>2)*4096+((i)&3)*1024)); vhi[i]=vtr(vp_+(((i)>>2)*4096+((i)&3)*1024+512)); }while(0)
  #define KRD(G,j) do{ if(G){ kload2(kf,kp0+sl_next,j); SBAR(); } }while(0)
  #define STEP(C0,C1,P0,P1,t,GK,GV,GL) do{ SBAR(); \
    const lds_cptr vp_=vp0+sl_prev; \
    VRD(0); SBAR(); float sacc=(P0[0]+P0[1]); \
    GAPA(C0=__builtin_amdgcn_mfma_f32_32x32x16_bf16(kf[0],qr[0],negm,0,0,0), P0[2],P0[3],P0[4],P0[5],     pw0[0]=PKW(P0,0), pw0[1]=PKW(P0,2), pw0); \
    VRD(4); SBAR(); GAPA(C1=__builtin_amdgcn_mfma_f32_32x32x16_bf16(kf[1],qr[0],negm,0,0,0), P0[6],P0[7],P0[8],P0[9],     pw0[2]=PKW(P0,4), pw0[3]=PKW(P0,6), pw0); \
    VRD(1); SBAR(); GAPA(C0=__builtin_amdgcn_mfma_f32_32x32x16_bf16(kf[2],qr[1],C0,0,0,0),   P0[10],P0[11],P0[12],P0[13], pw1[0]=PKW(P0,8), pw1[1]=PKW(P0,10), pw1); \
    VRD(5); SBAR(); GAPA(C1=__builtin_amdgcn_mfma_f32_32x32x16_bf16(kf[3],qr[1],C1,0,0,0),   P0[14],P0[15],P1[0],P1[1],   pw1[2]=PKW(P0,12),pw1[3]=PKW(P0,14), pw1); \
    VRD(2); SBAR(); GAPA(C0=__builtin_amdgcn_mfma_f32_32x32x16_bf16(kf[4],qr[2],C0,0,0,0),   P1[2],P1[3],P1[4],P1[5],     pw2[0]=PKW(P1,0), pw2[1]=PKW(P1,2), pw2); \
    VRD(6); SBAR(); GAPA(C1=__builtin_amdgcn_mfma_f32_32x32x16_bf16(kf[5],qr[2],C1,0,0,0),   P1[6],P1[7],P1[8],P1[9],     pw2[2]=PKW(P1,4), pw2[3]=PKW(P1,6), pw2); \
    VRD(3); SBAR(); GAPA(C0=__builtin_amdgcn_mfma_f32_32x32x16_bf16(kf[6],qr[3],C0,0,0,0),   P1[10],P1[11],P1[12],P1[13], pw3[0]=PKW(P1,8), pw3[1]=PKW(P1,10), pw3); \
    VRD(7); SBAR(); GAPA(C1=__builtin_amdgcn_mfma_f32_32x32x16_bf16(kf[7],qr[3],C1,0,0,0),   P1[14],P1[15],0.f,0.f,       pw3[2]=PKW(P1,12),pw3[3]=PKW(P1,14), pw3); \
    l_reg+=sacc; \
    if(GK){DMA_K((t)+3,sl_cur);} if(GV){DMA_V((t)+1,sl_next);} \
    CBIAS(C0,C1,t); CMASK(C0,C1,t); \
    { float a=MX3(C0[0],C0[1],C1[0]),b=MX3(C0[2],C0[3],C1[1]); a=MX3(a,C1[2],C1[3]); \
      _Pragma("unroll") for(int r=4;r<16;r+=4){a=MX3(a,C0[r],C0[r+1]);b=MX3(b,C0[r+2],C0[r+3]);a=MX3(a,C1[r],C1[r+1]);b=MX3(b,C1[r+2],C1[r+3]);} \
      float rm=__builtin_fmaxf(a,b); { auto rr=__builtin_amdgcn_permlane32_swap(__float_as_uint(rm),__float_as_uint(rm),false,false); rm=__builtin_fmaxf(__uint_as_float(rr[0]),__uint_as_float(rr[1])); } \
      resc=false; \
      if(__builtin_expect(__any(rm>(float)THRL),0)){ const float dl=__builtin_fmaxf(rm,0.f); mhat+=dl; \
        _Pragma("unroll") for(int r=0;r<16;++r){C0[r]-=dl;C1[r]-=dl;} \
        _Pragma("unroll") for(int r=0;r<16;++r)negm[r]=-mhat; asm volatile("":"+v"(negm)); \
        const float f=__builtin_amdgcn_exp2f(-dl); l_reg*=f; if(hi==0)wsf[r32]=f; resc=true; } } \
    SBAR(); \
    GAPB(o[0]=__builtin_amdgcn_mfma_f32_32x32x16_bf16(PAF(0),VFR(0),o[0],0,0,0), C0,0); \
    GAPB(o[1]=__builtin_amdgcn_mfma_f32_32x32x16_bf16(PAF(0),VFR(4),o[1],0,0,0), C0,4); \
    KRD(GL,0); GAPB(o[0]=__builtin_amdgcn_mfma_f32_32x32x16_bf16(PAF(1),VFR(1),o[0],0,0,0), C0,8); \
    KRD(GL,1); GAPB(o[1]=__builtin_amdgcn_mfma_f32_32x32x16_bf16(PAF(1),VFR(5),o[1],0,0,0), C0,12); \
    KRD(GL,2); GAPB(o[0]=__builtin_amdgcn_mfma_f32_32x32x16_bf16(PAF(2),VFR(2),o[0],0,0,0), C1,0); \
    KRD(GL,3); GAPB(o[1]=__builtin_amdgcn_mfma_f32_32x32x16_bf16(PAF(2),VFR(6),o[1],0,0,0), C1,4); \
    GAPB(o[0]=__builtin_amdgcn_mfma_f32_32x32x16_bf16(PAF(3),VFR(3),o[0],0,0,0), C1,8); \
    GAPB(o[1]=__builtin_amdgcn_mfma_f32_32x32x16_bf16(PAF(3),VFR(7),o[1],0,0,0), C1,12); \
    }while(0)
  int t=1;
  #undef CMASK
  #define CMASK(P0,P1,t) do{}while(0)
  for(;t+5<NT;t+=2){
    STEP(pB0,pB1,pA0,pA1,t,true,true,true);     WAIT_BAR(2); RESC(); ROT();
    STEP(pA0,pA1,pB0,pB1,t+1,true,true,true);   WAIT_BAR(2); RESC(); ROT();
  }
  #undef CMASK
  #define CMASK(P0,P1,t) do{int jb_=(t)-(NT-4); if(jb_>=0)cmask(P0,P1,jb_,qrel,hi);}while(0)
  #define ENDW(tt) do{ if((tt)+3<NT){WAIT_BAR(2);} else if((tt)+2<NT){WAIT_BAR(1);} else {WAIT_BAR(0);} }while(0)
  for(;t+1<NT;t+=2){
    STEP(pB0,pB1,pA0,pA1,t,(t+3<NT),(t+1<NT),(t+1<NT));       ENDW(t);   RESC(); ROT();
    STEP(pA0,pA1,pB0,pB1,t+1,(t+4<NT),(t+2<NT),(t+2<NT));     ENDW(t+1); RESC(); ROT();
  }
  STEP(pB0,pB1,pA0,pA1,NT-1,false,false,false); RESC();
  { float sacc=pB0[0]+pB0[1]; _Pragma("unroll") for(int r=2;r<16;++r)sacc+=pB0[r]; _Pragma("unroll") for(int r=0;r<16;++r)sacc+=pB1[r]; l_reg+=sacc;
    pw0=(u32x4){PKW(pB0,0),PKW(pB0,2),PKW(pB0,4),PKW(pB0,6)};pw1=(u32x4){PKW(pB0,8),PKW(pB0,10),PKW(pB0,12),PKW(pB0,14)};pw2=(u32x4){PKW(pB1,0),PKW(pB1,2),PKW(pB1,4),PKW(pB1,6)};pw3=(u32x4){PKW(pB1,8),PKW(pB1,10),PKW(pB1,12),PKW(pB1,14)};
    SBAR(); pv(o,vb0+sl_cur,PAF(0),PAF(1),PAF(2),PAF(3)); }
  #undef PKW
  #undef PAF
  #undef VFR
  #undef PIN
  #undef MX3
  #undef GAPA
  #undef GAPB
  #undef EX
  #undef VRD
  #undef KRD
  #undef STEP
  #undef ENDW
  {auto rr=__builtin_amdgcn_permlane32_swap(__float_as_uint(l_reg),__float_as_uint(l_reg),false,false);l_reg=__uint_as_float(rr[0])+__uint_as_float(rr[1]);}
  if(hi==0)wsf[32+r32]=l_reg;asm volatile("s_waitcnt lgkmcnt(0)":::"memory");
  float rli[16];
  #pragma unroll
  for(int r=0;r<16;++r)rli[r]=__builtin_amdgcn_rcpf(wsf[32+crow(r,hi)]);
  bf16*Ow=O+(rowbase+q0+wid*QBLK)*DM+h*D;
  { bf16*stg=(bf16*)(shm+LDS_OST)+wid*2048;
    #pragma unroll
    for(int r=0;r<16;++r){const int orow=crow(r,hi);
      #pragma unroll
      for(int d0=0;d0<2;++d0)stg[orow*64+d0*32+r32]=__float2bfloat16(o[d0][r]*rli[r]);}
    asm volatile("s_waitcnt lgkmcnt(0)":::"memory");
    #pragma unroll
    for(int i=0;i<4;++i){const int row=i*8+(lane>>3),ch=lane&7; const u32x4 v=*(const u32x4*)(stg+row*64+ch*8); ATTN_STORE16(Ow+(long)row*DM+ch*8,v);} }
  asm volatile("s_waitcnt lgkmcnt(0)\n\ts_barrier":::"memory");
  #undef DMA_K
  #undef DMA_V
  #undef CMASK
  #undef CBIAS
  #undef START
  #undef RESC
  #undef ROT
}
constexpr int ATTN_LDS_BYTES=LDS_BYTES;
struct AttnTensors { const bf16* Q; const bf16* K; const bf16* V; bf16* O; };
__device__ __forceinline__ void fox_phase(char*lds,const bf16*Q,const bf16*K,const bf16*V,bf16*O,const float*CUM,int grid,int block){
  const int vcu=(grid%8==0)?(block%8)*(grid/8)+block/8:block; const int bh=vcu>>2, s=vcu&3;
  if(bh>=BATCH*NHEAD)return;
  float*nc=(float*)(lds+98304);
  for(int i=threadIdx.x;i<SEQ;i+=512)nc[i]=CUM[(size_t)bh*SEQ+i];
  __syncthreads();
  const __attribute__((address_space(3))) float*ncum=(const __attribute__((address_space(3))) float*)(nc);
  for(int i=0;i<4;++i){ const int qb=(i==0)?s:(i==1)?7-s:(i==2)?8+s:15-s; attn_unit<8>(bh/NHEAD,bh%NHEAD,qb,Q,K,V,O,lds,ncum); }
}
template<int R> __device__ __forceinline__ void dil_unit(int g,int b,int j,int nb,int hp,const bf16*Q,const bf16*__restrict__ K,const bf16*__restrict__ V,const float*__restrict__ BIASV,bf16*ORUN,float*LSE,char*shm,char*aux){
  typedef __attribute__((address_space(3))) char* lptr;
  int tid_=threadIdx.x; asm volatile("":"+v"(tid_)); const int tid=tid_,lane=tid&63,r32=lane&31,hi=lane>>5; const int wid=__builtin_amdgcn_readfirstlane(tid>>6);
  const int hl=wid>>2,qs=wid&3,h=2*hp+hl;
  const unsigned lds0=(unsigned)(uintptr_t)shm;
  float*bvl=(float*)aux;
  float*wsf=(float*)(aux+1280)+wid*64;
  const long rowbase=(long)b*SEQ;
  { const int row=tid>>3,ch=tid&7;
    #pragma unroll
    for(int half=0;half<2;++half){ u32x4 val[8];
      #pragma unroll
      for(int q=0;q<8;++q){ const int it=half*8+q,kt=it&3,kv=(it>>2)&1,hh=it>>3; int kp=nb*128-128+kt*64+row; kp=kp<0?0:kp;
        const bf16*src=(kv?V:K)+(rowbase+(long)kp*R+j)*DM+(2*hp+hh)*D+ch*8; val[q]=*reinterpret_cast<const u32x4*>(src); }
      #pragma unroll
      for(int q=0;q<8;++q){ const int it=half*8+q,kt=it&3,kv=(it>>2)&1,hh=it>>3;
        const int off=hh*65536+kv*32768+kt*8192+(kv?((ch>>2)*4096+row*64+(ch&3)*16):(ch*1024+row*16));
        *reinterpret_cast<__attribute__((address_space(3))) u32x4*>((lptr)shm+off)=val[q]; } }
    if(tid<2*129){ const int hh=tid/129,dd=tid%129; bvl[hh*132+dd]=BIASV[(g*16+2*hp+hh)*132+dd]; }
  }
  const int p0q=nb*128+32*qs;
  const bf16*Qw=Q+(rowbase+(long)(p0q+r32)*R+j)*DM+h*D;
  bf16x8 qr[4];
  #pragma unroll
  for(int d0=0;d0<4;++d0)qr[d0]=*reinterpret_cast<const bf16x8*>(&Qw[d0*16+hi*8]);
  asm volatile("s_waitcnt vmcnt(0) lgkmcnt(0)\n\ts_barrier":::"memory");
  const int ktlo=(qs>=2)?1:0;
  const char*Kh=shm+hl*65536; const float*bv=bvl+hl*132;
  f32x16 s0[3],s1[3];
  #pragma unroll
  for(int i=0;i<3;++i){ const int kt=ktlo+i; f32x16 z=f32x16{};
    qkt(s0[i],s1[i],Kh+kt*8192,qr,z,r32,hi);
    #pragma unroll
    for(int r=0;r<16;++r){ const int kj=64*kt+crow(r,hi), qi=32*qs+r32; const int d0_=qi+128-kj, d1_=d0_-32;
      const bool v0=(d0_>=0)&&(d0_<=128)&&(nb*128+qi-d0_>=0), v1=(d1_>=0)&&(d1_<=128)&&(nb*128+qi-d1_>=0);
      const float b0=bv[v0?d0_:0], b1=bv[v1?d1_:0];
      s0[i][r]=v0?s0[i][r]+b0:-1e30f; s1[i][r]=v1?s1[i][r]+b1:-1e30f; } }
  float mx=-1e30f;
  #pragma unroll
  for(int i=0;i<3;++i)
    #pragma unroll
    for(int r=0;r<16;++r)mx=fmaxf(mx,fmaxf(s0[i][r],s1[i][r]));
  { auto rr=__builtin_amdgcn_permlane32_swap(__float_as_uint(mx),__float_as_uint(mx),false,false); mx=fmaxf(__uint_as_float(rr[0]),__uint_as_float(rr[1])); }
  float l=0.f;
  #pragma unroll
  for(int i=0;i<3;++i)
    #pragma unroll
    for(int r=0;r<16;++r){ s0[i][r]=__builtin_amdgcn_exp2f(s0[i][r]-mx); s1[i][r]=__builtin_amdgcn_exp2f(s1[i][r]-mx); l+=s0[i][r]+s1[i][r]; }
  { auto rr=__builtin_amdgcn_permlane32_swap(__float_as_uint(l),__float_as_uint(l),false,false); l=__uint_as_float(rr[0])+__uint_as_float(rr[1]); }
  f32x16 o[2]; o[0]=f32x16{}; o[1]=f32x16{};
  const int vb0=(int)lds0+hl*65536+32768+((lane>>4)&1)*32+(lane&3)*8+(4*hi+((lane&15)>>2))*64;
  #define PKW(P,B) cvtpk_s(P[B],P[B+1])
  #pragma unroll
  for(int i=0;i<3;++i){ const int kt=ktlo+i;
    const u32x4 pw0=(u32x4){PKW(s0[i],0),PKW(s0[i],2),PKW(s0[i],4),PKW(s0[i],6)},pw1=(u32x4){PKW(s0[i],8),PKW(s0[i],10),PKW(s0[i],12),PKW(s0[i],14)};
    const u32x4 pw2=(u32x4){PKW(s1[i],0),PKW(s1[i],2),PKW(s1[i],4),PKW(s1[i],6)},pw3=(u32x4){PKW(s1[i],8),PKW(s1[i],10),PKW(s1[i],12),PKW(s1[i],14)};
    pv(o,vb0+kt*8192,__builtin_bit_cast(bf16x8,pw0),__builtin_bit_cast(bf16x8,pw1),__builtin_bit_cast(bf16x8,pw2),__builtin_bit_cast(bf16x8,pw3)); }
  #undef PKW
  const long orow=rowbase+(long)(p0q+r32)*R+j;
  float lse=mx*0.6931471805599453f+__logf(l), a=1.0f/l, bco=0.f;
  if(g>0){ const float lr=LSE[orow*16+h]; const float mxl=fmaxf(lr,lse), nl=mxl+__logf(__expf(lr-mxl)+__expf(lse-mxl)); a=__expf(lse-nl)/l; bco=__expf(lr-nl); lse=nl; }
  if(hi==0){ wsf[r32]=a; wsf[32+r32]=bco; LSE[orow*16+h]=lse; }
  asm volatile("s_waitcnt lgkmcnt(0)\n\ts_barrier":::"memory");
  float av[16];
  #pragma unroll
  for(int r=0;r<16;++r)av[r]=wsf[crow(r,hi)];
  { bf16*stg=(bf16*)(shm)+wid*2048;
    #pragma unroll
    for(int r=0;r<16;++r){const int orw=crow(r,hi);
      #pragma unroll
      for(int d0=0;d0<2;++d0)stg[orw*64+d0*32+r32]=__float2bfloat16(o[d0][r]*av[r]);}
    asm volatile("s_waitcnt lgkmcnt(0)":::"memory");
    #pragma unroll
    for(int i=0;i<4;++i){const int row=i*8+(lane>>3),ch=lane&7; u32x4 v=*(const u32x4*)(stg+row*64+ch*8);
      bf16*dst=ORUN+(rowbase+(long)(p0q+row)*R+j)*DM+h*D+ch*8;
      if(g>0){ const float bc=wsf[32+row]; const u32x4 ov=*(const u32x4*)dst; u32x4 w;
        #pragma unroll
        for(int q=0;q<4;++q){ const float n0=__uint_as_float(v[q]<<16)+bc*__uint_as_float(ov[q]<<16), n1=__uint_as_float(v[q]&0xffff0000u)+bc*__uint_as_float(ov[q]&0xffff0000u); w[q]=cvtpk_s(n0,n1); }
        v=w; }
      *(u32x4*)dst=v; } }
  asm volatile("s_waitcnt lgkmcnt(0)\n\ts_barrier":::"memory");
}
template<int R> __device__ __forceinline__ void dil_phase(int g,char*lds,char*aux,const bf16*Q,const bf16*K,const bf16*V,const float*BIASV,bf16*ORUN,float*LSE,int grid,int block){
  constexpr int NBK=32/R;
  for(int L=block;L<1024;L+=grid){ const int hp=L&7,rest=L>>3,nb=rest%NBK,z=rest/NBK; dil_unit<R>(g,z/R,z%R,nb,hp,Q,K,V,BIASV,ORUN,LSE,lds,aux); }
}
#undef SBAR
#undef WAIT_BAR
}

__device__ __forceinline__ LAS int* moe_tables(Frame& F, int layer, bool combo) {
    LAS int* tab = (LAS int*)(F.lds + LDSCTL_OFF + 1024);
    if (F.tid == 0) { const int nl = combo ? 24 : 16; int run = 0;
        for (int k = 0; k < nl; ++k) { const int c = (int)__hip_atomic_load(F.ctl + CW_CNT + layer * 64 + (combo ? 128 : 0) + k, RLX_AGENT); tab[k] = run; tab[32 + k] = c; run += (c + 255) >> 8; }
        tab[nl] = run; }
    __syncthreads();
    return tab;
}

#define MOE_PHASES(layer, P1, P2) \
    if (IN(P1)) { LAS int* tab = moe_tables(F, layer, false); \
        pg8::MoeOrder S{F.G, (int)blockIdx.x, 16, 2, 16, 1, (const char*)(F.ws + WS_HM), (const char*)(F.ws + WS_MOE1 + (size_t)(layer) * 16 * 512 * 1024 * 2), (const int*)(F.ws + WS_ELIST), tab}; \
        pg8::EpiMoe1 E{(const int*)(F.ws + WS_ELIST), (const v4u*)(F.ws + WS_TOKREC), (bf16*)(F.ws + WS_HID2)}; \
        pg8::gemm_phase<pg8::EpiMoe1, pg8::MoeOrder, true, true>(F.lds + RING_OFF, 1024, 1024, 1024, S, E); SEAM(P1); } \
    if (IN(P2)) { LAS int* tab = moe_tables(F, layer, true); \
        pg8::MoeOrder S{F.G, (int)blockIdx.x, 24, 4, 4, 2, (const char*)(F.ws + WS_HID2), (const char*)(F.ws + WS_MOE2 + (size_t)(layer) * 16 * 1024 * 256 * 2), (const int*)(F.ws + WS_CLIST), tab}; \
        pg8::EpiMoe2 E{(const int*)(F.ws + WS_CLIST), F.out, (const float*)(F.ws + WS_MOD) + (size_t)(layer) * 4 * 6144 + 5 * D}; \
        pg8::gemm_phase<pg8::EpiMoe2, pg8::MoeOrder, true, true>(F.lds + RING_OFF, 512, 256, 512, S, E); SEAM(P2); }

__global__ void __launch_bounds__(NWAVES * 64, 2) mk_fwd(Args args) {
    extern __shared__ __attribute__((aligned(16))) unsigned char lds[];
    Frame F;
    F.lds = (LAS unsigned char*)lds;
    F.MISC = (volatile LAS unsigned*)(F.lds + MISC_OFF);
    F.tid = threadIdx.x; F.lane = F.tid & 63; F.wave = __builtin_amdgcn_readfirstlane(F.tid >> 6);
    F.G = gridDim.x; { const int bx = blockIdx.x; F.vcu = (F.G % 8 == 0) ? (bx % 8) * (F.G / 8) + bx / 8 : bx; }
    F.ws = args.ws; F.ctl = (gu32*)(args.ws + WS_CTL); F.in = args.in; F.out = args.out;
    for (int u = F.tid; u < (LDS_BYTES - LDSCTL_OFF) / 4; u += NWAVES * 64) ((LAS unsigned*)(F.lds + LDSCTL_OFF))[u] = 0u;
    __syncthreads();
    XcdBarrier bar; bar.bar = (unsigned*)(F.ctl + CW_BAR); bar.x = 0; bar.st = nullptr;
    if (MK_MODE == 0) bar = xcd_barrier_post((unsigned*)(F.ctl + CW_BAR), F.MISC + 8);
    const int lo = args.ph_lo, hi = args.ph_hi;
#define IN(k) (lo <= (k) && (k) < hi && frame_refresh(F))
#define SEAM(k) do { if (MK_MODE == 0 && lo <= (k) + 1 && (k) + 1 < hi) xcd_barrier(bar); } while (0)

    if (IN(PH_PRO)) { p0_prologue(F); SEAM(PH_PRO); }
    if (IN(PH_ROW_A)) { rowpass<0>(F, F.in[I_X], F.in[I_NMIX], 0, 0, 1); SEAM(PH_ROW_A); }
    {
#pragma unroll
        for (int g = 0; g < 3; ++g) {
            if (IN(PH_QKV_A0 + 2 * g)) {
                pg8::StaticOrder S; S.init(M, 3072, F.G, (int)blockIdx.x, F.ws + WS_HM, 1024, F.ws + WS_WAIN + (size_t)g * 3072 * 1024 * 2, 1024, 16);
                pg8::EpiQKV E{(bf16*)(F.ws + WS_Q), F.in[I_AQN], F.in[I_AKN]};
                pg8::gemm_phase<pg8::EpiQKV, pg8::StaticOrder, false, true>(F.lds + RING_OFF, 1024, 1024, 1024, S, E);
                SEAM(PH_QKV_A0 + 2 * g);
            }
            if (IN(PH_ATT_A0 + 2 * g)) {
                typedef attn_body::bf16 ab16;
                if (g == 0) attn_body::dil_phase<1>(0, (char*)lds + RING_OFF, (char*)lds + LDSCTL_OFF + 2048, (const ab16*)(F.ws + WS_Q), (const ab16*)(F.ws + WS_K), (const ab16*)(F.ws + WS_V), (const float*)(F.ws + WS_BIASV), (ab16*)(F.ws + WS_ORUN), (float*)(F.ws + WS_LSE), F.G, (int)blockIdx.x);
                if (g == 1) attn_body::dil_phase<4>(1, (char*)lds + RING_OFF, (char*)lds + LDSCTL_OFF + 2048, (const ab16*)(F.ws + WS_Q), (const ab16*)(F.ws + WS_K), (const ab16*)(F.ws + WS_V), (const float*)(F.ws + WS_BIASV), (ab16*)(F.ws + WS_ORUN), (float*)(F.ws + WS_LSE), F.G, (int)blockIdx.x);
                if (g == 2) attn_body::dil_phase<16>(2, (char*)lds + RING_OFF, (char*)lds + LDSCTL_OFF + 2048, (const ab16*)(F.ws + WS_Q), (const ab16*)(F.ws + WS_K), (const ab16*)(F.ws + WS_V), (const float*)(F.ws + WS_BIASV), (ab16*)(F.ws + WS_ORUN), (float*)(F.ws + WS_LSE), F.G, (int)blockIdx.x);
                SEAM(PH_ATT_A0 + 2 * g);
            }
        }
    }
    if (IN(PH_OUT_A)) {
        pg8::StaticOrder S; S.init(M, 1024, F.G, (int)blockIdx.x, F.ws + WS_ORUN, 1024, F.ws + WS_WAOUT, 1024, 16);
        pg8::EpiOut E{F.in[I_X], F.out, (const float*)(F.ws + WS_MOD) + 2 * D};
        pg8::gemm_phase<pg8::EpiOut, pg8::StaticOrder, false, false>(F.lds + RING_OFF, 1024, 1024, 1024, S, E);
        SEAM(PH_OUT_A);
    }
    if (IN(PH_ROW_F0)) { rowpass<2>(F, F.out, F.in[I_NFFN], 0, 3, 4); SEAM(PH_ROW_F0); }
    MOE_PHASES(0, PH_MOE1_0, PH_MOE2_0)
    if (IN(PH_ROW_B)) { rowpass<1>(F, F.out, F.in[I_NMIX] + D, 1, 0, 1); SEAM(PH_ROW_B); }
    if (IN(PH_CUM)) { cumsum_phase(F); }
    if (IN(PH_QKV_B)) {
        pg8::StaticOrder S; S.init(M, 3072, F.G, (int)blockIdx.x, F.ws + WS_HM, 1024, F.ws + WS_WBIN, 1024, 16);
        pg8::EpiQKV E{(bf16*)(F.ws + WS_Q), F.in[I_BQN], F.in[I_BKN]};
        pg8::gemm_phase<pg8::EpiQKV, pg8::StaticOrder, false, true>(F.lds + RING_OFF, 1024, 1024, 1024, S, E);
        SEAM(PH_QKV_B);
    }
    if (IN(PH_ATT_B)) {
        typedef attn_body::bf16 ab16;
        attn_body::fox_phase((char*)lds + RING_OFF, (const ab16*)(F.ws + WS_Q), (const ab16*)(F.ws + WS_K), (const ab16*)(F.ws + WS_V), (ab16*)(F.ws + WS_Q), (const float*)(F.ws + WS_CUM), F.G, (int)blockIdx.x);
        SEAM(PH_ATT_B);
    }
    if (IN(PH_OUT_B)) {
        pg8::StaticOrder S; S.init(M, 1024, F.G, (int)blockIdx.x, F.ws + WS_Q, 1024, F.ws + WS_WBOUT, 1024, 16);
        pg8::EpiOut E{F.out, F.out, (const float*)(F.ws + WS_MOD) + (size_t)4 * 6144 + 2 * D};
        pg8::gemm_phase<pg8::EpiOut, pg8::StaticOrder, false, false>(F.lds + RING_OFF, 1024, 1024, 1024, S, E);
        SEAM(PH_OUT_B);
    }
    if (IN(PH_ROW_F1)) { rowpass<2>(F, F.out, F.in[I_NFFN] + D, 1, 3, 4); SEAM(PH_ROW_F1); }
    MOE_PHASES(1, PH_MOE1_1, PH_MOE2_1)
#undef IN
#undef SEAM
}

__global__ void __launch_bounds__(256) nk_qkv(const bf16* __restrict__ A, const float* __restrict__ W, int ldw, int col0, const float* __restrict__ qg, const float* __restrict__ kg,
                                              bf16* Qo, bf16* Ko, bf16* Vo) {
    const long gw = ((long)blockIdx.x * blockDim.x + threadIdx.x) >> 6; const int lane = threadIdx.x & 63;
    if (gw >= (long)M * 48) return;
    const int m = (int)(gw / 48), ch = (int)(gw % 48), t = ch / 16, h = ch % 16;
    const bf16* a = A + (size_t)m * D; const float* w = W + col0 + ch * 64 + lane;
    float acc = 0.f;
    for (int k = 0; k < D; ++k) acc += bf2f(a[k]) * w[(size_t)k * ldw];
    if (t < 2) { const float ss = wave_sum(acc * acc) * (1.f / 64.f); const float g = (t == 0 ? qg : kg)[lane]; acc = acc * (1.0f / sqrtf(ss + EPS)) * g; if (t == 0) acc *= C2; }
    bf16* o = (t == 0 ? Qo : (t == 1 ? Ko : Vo)); o[(size_t)m * D + h * 64 + lane] = (bf16)f2bf(acc);
}
__global__ void __launch_bounds__(256) nk_out(const bf16* __restrict__ A, const float* __restrict__ W, const float* xin, const float* __restrict__ gvec, float* xout) {
    const long gw = ((long)blockIdx.x * blockDim.x + threadIdx.x) >> 6; const int lane = threadIdx.x & 63;
    if (gw >= (long)M * 16) return;
    const int m = (int)(gw / 16), c = (int)(gw % 16) * 64 + lane, b = m / SEQ;
    const bf16* a = A + (size_t)m * D; float acc = 0.f;
    for (int k = 0; k < D; ++k) acc += bf2f(a[k]) * W[(size_t)k * D + c];
    xout[(size_t)m * D + c] = xin[(size_t)m * D + c] + gvec[(size_t)b * 6144 + c] * acc;
}
__global__ void __launch_bounds__(256) nk_moe1(const bf16* __restrict__ HF, const v4u* __restrict__ tokrec, const float* __restrict__ Wg, const float* __restrict__ Wu, bf16* HID2) {
    const long gw = ((long)blockIdx.x * blockDim.x + threadIdx.x) >> 6; const int lane = threadIdx.x & 63;
    if (gw >= (long)M * 8) return;
    const int m = (int)(gw / 8), rest = (int)(gw % 8), slot = rest / 4, f = (rest % 4) * 64 + lane;
    const v4u rec = tokrec[m]; const int e = slot ? (rec.x >> 8) & 0xff : rec.x & 0xff; const float w = __uint_as_float(slot ? rec.z : rec.y);
    const bf16* a = HF + (size_t)m * D; const float* wg = Wg + (size_t)e * D * FF + f; const float* wu = Wu + (size_t)e * D * FF + f;
    float g = 0.f, u = 0.f;
    for (int k = 0; k < D; ++k) { const float av = bf2f(a[k]); g += av * wg[(size_t)k * FF]; u += av * wu[(size_t)k * FF]; }
    HID2[(size_t)m * 512 + slot * 256 + f] = (bf16)f2bf(g / (1.0f + expf(-g)) * u * w);
}
__global__ void __launch_bounds__(256) nk_moe2(const bf16* __restrict__ HID2, const v4u* __restrict__ tokrec, const float* __restrict__ Wd, const float* __restrict__ gvec, float* x) {
    const long gw = ((long)blockIdx.x * blockDim.x + threadIdx.x) >> 6; const int lane = threadIdx.x & 63;
    if (gw >= (long)M * 16) return;
    const int m = (int)(gw / 16), c = (int)(gw % 16) * 64 + lane, b = m / SEQ;
    const v4u rec = tokrec[m]; float y = 0.f;
    for (int slot = 0; slot < 2; ++slot) { const int e = slot ? (rec.x >> 8) & 0xff : rec.x & 0xff;
        const bf16* a = HID2 + (size_t)m * 512 + slot * 256; const float* wd = Wd + (size_t)e * FF * D + c;
        for (int f = 0; f < FF; ++f) y += bf2f(a[f]) * wd[(size_t)f * D]; }
    x[(size_t)m * D + c] += gvec[(size_t)b * 6144 + c] * y;
}
__global__ void __launch_bounds__(256) nk_attnA(int g, const bf16* __restrict__ Q, const bf16* __restrict__ K, const bf16* __restrict__ V, const float* __restrict__ biasv, bf16* ORUN, float* LSE) {
    const long gw = ((long)blockIdx.x * blockDim.x + threadIdx.x) >> 6; const int lane = threadIdx.x & 63;
    if (gw >= (long)M * 16) return;
    const int m = (int)(gw / 16), h = (int)(gw % 16), b = m / SEQ, t = m % SEQ, r = dil_of(g);
    const bf16* q = Q + (size_t)m * D + h * 64;
    float s[3]; bool ok[3];
#pragma unroll
    for (int i = 0; i < 3; ++i) { const int mm = lane + 64 * i; ok[i] = (mm <= 128) && (t - mm * r >= 0); s[i] = -1e30f;
        if (ok[i]) { const bf16* k = K + ((size_t)b * SEQ + (t - mm * r)) * D + h * 64; float d = 0.f;
            for (int dd = 0; dd < 64; ++dd) d += bf2f(q[dd]) * bf2f(k[dd]);
            s[i] = d + biasv[(g * 16 + h) * BV_PITCH + mm]; } }
    const float mx = wave_max(fmaxf(s[0], fmaxf(s[1], s[2])));
    float p[3]; float l = 0.f;
#pragma unroll
    for (int i = 0; i < 3; ++i) { p[i] = ok[i] ? exp2f(s[i] - mx) : 0.f; l += p[i]; }
    l = wave_sum(l);
    float o = 0.f;
#pragma unroll
    for (int i = 0; i < 3; ++i) for (int j = 0; j < 64; ++j) { const int mm = j + 64 * i; const float pj = __shfl(p[i], j);
        if (mm <= 128 && t - mm * r >= 0) o += pj * bf2f(V[((size_t)b * SEQ + (t - mm * r)) * D + h * 64 + lane]); }
    o /= l; float lse = mx * LN2 + logf(l);
    if (g > 0) { const float lr = LSE[(size_t)m * 16 + h], orun = bf2f(ORUN[(size_t)m * D + h * 64 + lane]);
        const float mxl = fmaxf(lr, lse), nl = mxl + logf(expf(lr - mxl) + expf(lse - mxl));
        o = expf(lr - nl) * orun + expf(lse - nl) * o; lse = nl; }
    ORUN[(size_t)m * D + h * 64 + lane] = (bf16)f2bf(o);
    if (lane == 0) LSE[(size_t)m * 16 + h] = lse;
}
__global__ void __launch_bounds__(256) nk_attnB(const bf16* __restrict__ Q, const bf16* __restrict__ K, const bf16* __restrict__ V, const float* __restrict__ CUM, bf16* O) {
    const long gw = ((long)blockIdx.x * blockDim.x + threadIdx.x) >> 6; const int lane = threadIdx.x & 63;
    if (gw >= (long)M * 16) return;
    const int m = (int)(gw / 16), h = (int)(gw % 16), b = m / SEQ, t = m % SEQ;
    const bf16* q = Q + (size_t)m * D + h * 64; const float* cum = CUM + (size_t)(b * 16 + h) * SEQ;
    float qv[64];
#pragma unroll
    for (int dd = 0; dd < 64; ++dd) qv[dd] = bf2f(q[dd]);
    const int nch = t / 64 + 1;
    float mx = -1e30f;
    for (int ch = 0; ch < nch; ++ch) { const int sidx = ch * 64 + lane;
        if (sidx <= t) { const bf16* k = K + ((size_t)b * SEQ + sidx) * D + h * 64; float d = 0.f;
#pragma unroll
            for (int dd = 0; dd < 64; ++dd) d += qv[dd] * bf2f(k[dd]);
            mx = fmaxf(mx, d + cum[sidx]); } }
    mx = wave_max(mx);
    float l = 0.f, o = 0.f;
    for (int ch = 0; ch < nch; ++ch) { const int sidx = ch * 64 + lane; float p = 0.f;
        if (sidx <= t) { const bf16* k = K + ((size_t)b * SEQ + sidx) * D + h * 64; float d = 0.f;
#pragma unroll
            for (int dd = 0; dd < 64; ++dd) d += qv[dd] * bf2f(k[dd]);
            p = exp2f(d + cum[sidx] - mx); }
        l += p;
        const int jn = (t - ch * 64 + 1) < 64 ? (t - ch * 64 + 1) : 64;
        for (int j = 0; j < jn; ++j) o += __shfl(p, j) * bf2f(V[((size_t)b * SEQ + ch * 64 + j) * D + h * 64 + lane]); }
    l = wave_sum(l);
    O[(size_t)m * D + h * 64 + lane] = (bf16)f2bf(o / l);
}

static void launch_mk(const Args& a0, int lo, int hi, int grid, hipStream_t stream) {
    Args a = a0; a.ph_lo = lo; a.ph_hi = hi;
    hipLaunchKernelGGL(mk_fwd, dim3(grid), dim3(NWAVES * 64), LDS_BYTES, stream, a);
}
extern "C" void kernel_launch(void* const* d_in, const int* in_sizes, int n_in, void* d_out, int out_size, void* d_ws, size_t ws_size, hipStream_t stream) {
    static int grid = 0;
    if (grid == 0) {
        if (n_in != 23 || in_sizes[0] != M * D || out_size != M * D || ws_size < WS_END) { fprintf(stderr, "kernel_launch: unexpected shapes (n_in %d, in0 %d, out %d, ws %zu)\n", n_in, n_in > 0 ? in_sizes[0] : -1, out_size, ws_size); grid = -1; return; }
        int dev = 0, cus = 0;
        if (hipGetDevice(&dev) != hipSuccess || hipDeviceGetAttribute(&cus, hipDeviceAttributeMultiprocessorCount, dev) != hipSuccess) { grid = -1; return; }
        if (hipFuncSetAttribute((const void*)mk_fwd, hipFuncAttributeMaxDynamicSharedMemorySize, LDS_BYTES) != hipSuccess) { fprintf(stderr, "kernel_launch: hipFuncSetAttribute failed\n"); grid = -1; return; }
        int per_cu = 0;
        if (hipOccupancyMaxActiveBlocksPerMultiprocessor(&per_cu, (const void*)mk_fwd, NWAVES * 64, LDS_BYTES) != hipSuccess || per_cu < 1) fprintf(stderr, "kernel_launch: occupancy query reports %d\n", per_cu);
        (void)hipGetLastError();
        grid = cus;
    }
    if (grid < 0) return;
    if (hipMemsetAsync((char*)d_ws + WS_CTL, 0, CTL_ZERO_BYTES, stream) != hipSuccess) return;
    Args a{};
    for (int i = 0; i < 23; ++i) a.in[i] = (const float*)d_in[i];
    a.out = (float*)d_out; a.ws = (unsigned char*)d_ws;
#if MK_MODE == 0
    launch_mk(a, 0, NPH, grid, stream);
#else
    unsigned char* ws = (unsigned char*)d_ws;
    const float* const* in = a.in;
    bf16 *HM = (bf16*)(ws + WS_HM), *Qb = (bf16*)(ws + WS_Q), *Kb = (bf16*)(ws + WS_K), *Vb = (bf16*)(ws + WS_V), *OR = (bf16*)(ws + WS_ORUN), *HID2 = (bf16*)(ws + WS_HID2);
    float *MOD = (float*)(ws + WS_MOD), *LSE = (float*)(ws + WS_LSE), *BV = (float*)(ws + WS_BIASV), *CUM = (float*)(ws + WS_CUM);
    const v4u* TR = (const v4u*)(ws + WS_TOKREC);
    float* out = (float*)d_out;
    for (int ph = 0; ph < NPH; ++ph) {
        if (!((NAIVE_MASK >> ph) & 1u)) { launch_mk(a, ph, ph + 1, grid, stream); continue; }
        switch (ph) {
            case PH_QKV_A0: case PH_QKV_A1: case PH_QKV_A2: { const int g = (ph - PH_QKV_A0) / 2;
                hipLaunchKernelGGL(nk_qkv, dim3(M * 48 / 4), dim3(256), 0, stream, HM, in[I_AWIN], 9216, g * 3072, in[I_AQN], in[I_AKN], Qb, Kb, Vb); break; }
            case PH_ATT_A0: case PH_ATT_A1: case PH_ATT_A2: { const int g = (ph - PH_ATT_A0) / 2;
                hipLaunchKernelGGL(nk_attnA, dim3(M * 16 / 4), dim3(256), 0, stream, g, Qb, Kb, Vb, BV, OR, LSE); break; }
            case PH_OUT_A: hipLaunchKernelGGL(nk_out, dim3(M * 16 / 4), dim3(256), 0, stream, OR, in[I_AWOUT], in[I_X], MOD + 2 * D, out); break;
            case PH_MOE1_0: hipLaunchKernelGGL(nk_moe1, dim3(M * 8 / 4), dim3(256), 0, stream, HM, TR, in[I_WG], in[I_WU], HID2); break;
            case PH_MOE2_0: hipLaunchKernelGGL(nk_moe2, dim3(M * 16 / 4), dim3(256), 0, stream, HID2, TR, in[I_WD], MOD + 5 * D, out); break;
            case PH_QKV_B: hipLaunchKernelGGL(nk_qkv, dim3(M * 48 / 4), dim3(256), 0, stream, HM, in[I_BWIN], 3088, 0, in[I_BQN], in[I_BKN], Qb, Kb, Vb); break;
            case PH_ATT_B: hipLaunchKernelGGL(nk_attnB, dim3(M * 16 / 4), dim3(256), 0, stream, Qb, Kb, Vb, CUM, Qb); break;
            case PH_OUT_B: hipLaunchKernelGGL(nk_out, dim3(M * 16 / 4), dim3(256), 0, stream, Qb, in[I_BWOUT], out, MOD + 4 * 6144 + 2 * D, out); break;
            case PH_MOE1_1: hipLaunchKernelGGL(nk_moe1, dim3(M * 8 / 4), dim3(256), 0, stream, HM, TR, in[I_WG] + (size_t)NE * D * FF, in[I_WU] + (size_t)NE * D * FF, HID2); break;
            case PH_MOE2_1: hipLaunchKernelGGL(nk_moe2, dim3(M * 16 / 4), dim3(256), 0, stream, HID2, TR, in[I_WD] + (size_t)NE * FF * D, MOD + 4 * 6144 + 5 * D, out); break;
            default: launch_mk(a, ph, ph + 1, grid, stream); break;
        }
    }
#endif
}
```

```cpp
#include <hip/hip_runtime.h>
#include <hip/hip_bf16.h>
#include <cstdio>
#include <cstdint>
#include <cmath>

#ifndef MK_MODE
#define MK_MODE 0
#endif
#ifndef DUP_MASK
#define DUP_MASK 0u
#endif
#ifndef HOST_DUP_MASK
#define HOST_DUP_MASK 0u
#endif
#ifndef NAIVE_MASK
#define NAIVE_MASK 0u
#endif

constexpr int BATCH = 4, SEQ = 4096, D = 1024, H = 16, HD = 64, M = BATCH * SEQ;
constexpr int NE = 16, FF = 256, NCOMBO = 24;
constexpr float EPS = 1e-6f, LOG2E = 1.4426950408889634f, LN2 = 0.6931471805599453f;
constexpr float C2 = 0.125f * LOG2E;
constexpr int BV_PITCH = 132;
constexpr int NPH = 20;
enum Phase { PH_PRO = 0, PH_ROW_A = 1, PH_QKV_A0 = 2, PH_ATT_A0 = 3, PH_QKV_A1 = 4, PH_ATT_A1 = 5, PH_QKV_A2 = 6, PH_ATT_A2 = 7, PH_OUT_A = 8, PH_ROW_F0 = 9, PH_MOE1_0 = 10, PH_MOE2_0 = 11,
             PH_ROW_B = 12, PH_CUM = 13, PH_QKV_B = 14, PH_ATT_B = 15, PH_OUT_B = 16, PH_ROW_F1 = 17, PH_MOE1_1 = 18, PH_MOE2_1 = 19 };

constexpr size_t MiB = 1u << 20;
constexpr size_t WS_CTL = 0, CTL_ZERO_BYTES = 1 * MiB;
constexpr size_t WS_MOD = 1 * MiB;
constexpr size_t WS_BIASV = 1 * MiB + 256 * 1024;
constexpr size_t WS_TOKREC = 1 * MiB + 512 * 1024;
constexpr size_t WS_CUM = 2 * MiB;
constexpr size_t WS_LOGF = 3 * MiB;
constexpr size_t WS_LSE = 4 * MiB;
constexpr size_t WS_ELIST = 5 * MiB;
constexpr size_t WS_CLIST = 6 * MiB;
constexpr size_t WS_WAIN = 8 * MiB;
constexpr size_t WS_WAOUT = 26 * MiB;
constexpr size_t WS_WBIN = 28 * MiB;
constexpr size_t WS_WBOUT = 34 * MiB;
constexpr size_t WS_MOE1 = 36 * MiB;
constexpr size_t WS_MOE2 = 68 * MiB;
constexpr size_t WS_HM = 84 * MiB;
constexpr size_t WS_Q = 116 * MiB, WS_K = 148 * MiB, WS_V = 180 * MiB;
constexpr size_t WS_ORUN = 212 * MiB;
constexpr size_t WS_HID2 = 116 * MiB;
constexpr size_t WS_END = 244 * MiB;
constexpr int CW_TMO = 0, CW_CODE = 1, CW_BAR = 4096, CW_CNT = 16384;

constexpr int RING_OFF = 0, RING_BYTES = 131072;
constexpr int LDSCTL_OFF = RING_BYTES, MISC_OFF = LDSCTL_OFF + 320;
constexpr int LDS_BYTES = 147456;

#define GAS __attribute__((address_space(1)))
#define LAS __attribute__((address_space(3)))
typedef unsigned short bf16;
typedef unsigned v4u __attribute__((ext_vector_type(4)));
typedef unsigned v2u __attribute__((ext_vector_type(2)));
typedef float f32x4 __attribute__((ext_vector_type(4)));
typedef short bf16x8 __attribute__((ext_vector_type(8)));
typedef GAS unsigned gu32;
#define RLX_AGENT __ATOMIC_RELAXED, __HIP_MEMORY_SCOPE_AGENT
#define LDS_WAIT() asm volatile("s_waitcnt lgkmcnt(0)" ::: "memory")
#define VM_WAIT() asm volatile("s_waitcnt vmcnt(0)" ::: "memory")
__device__ __forceinline__ unsigned f2bf(float f) { unsigned u = __builtin_bit_cast(unsigned, f); return (u + 0x7fffu + ((u >> 16) & 1u)) >> 16; }
__device__ __forceinline__ unsigned pk2(float lo, float hi) { return f2bf(lo) | (f2bf(hi) << 16); }
__device__ __forceinline__ float bf2f(unsigned u) { return __uint_as_float(u << 16); }
__device__ __forceinline__ float wave_sum(float v) {
#pragma unroll
    for (int o = 1; o < 64; o <<= 1) v += __shfl_xor(v, o);
    return v;
}
__device__ __forceinline__ float wave_max(float v) {
#pragma unroll
    for (int o = 1; o < 64; o <<= 1) v = fmaxf(v, __shfl_xor(v, o));
    return v;
}
__host__ __device__ __forceinline__ int dil_of(int g) { return g == 0 ? 1 : (g == 1 ? 4 : 16); }

#define XB_TMO      128
#define XB_XCNT(j)  (256  + 64 * (j))
#define XB_XSUB(j)  (1280 + 64 * (j))
#define XB_XGEN(j)  (2304 + 64 * (j))
#define XB_TOP      3328
#define XB_TOPGEN   3392
#define XCD_BAR_WORDS 3456
#define XB_SPIN_CAP (1u << 18)
__device__ __forceinline__ unsigned xb_ld(unsigned* p)              { return __hip_atomic_load(p, __ATOMIC_RELAXED, __HIP_MEMORY_SCOPE_AGENT); }
__device__ __forceinline__ unsigned xb_add(unsigned* p, unsigned v) { return __hip_atomic_fetch_add(p, v, __ATOMIC_RELAXED, __HIP_MEMORY_SCOPE_AGENT); }
__device__ __forceinline__ unsigned xb_xcc_id() { return (unsigned)__builtin_amdgcn_s_getreg((3 << 11) | 20) & 0xFu; }
#define XB_SPIN(cond, bar) do { unsigned _sp = 0; while (cond) { __builtin_amdgcn_s_sleep(1); \
    if ((++_sp & 255u) == 0u) { if (xb_ld(&(bar)[XB_TMO])) break; if (_sp > XB_SPIN_CAP) { atomicAdd(&(bar)[XB_TMO], 1u); break; } } } } while (0)
struct XcdBarrier { unsigned* bar; unsigned x; volatile LAS unsigned* st; };
__device__ __forceinline__ XcdBarrier xcd_barrier_post(unsigned* bar, volatile LAS unsigned* st) {
    XcdBarrier b; b.bar = bar; b.x = xb_xcc_id(); b.st = st;
    if (threadIdx.x == 0) (void)xb_add(&bar[XB_XCNT(b.x)], 1u);
    return b;
}
__device__ __forceinline__ void xcd_barrier_complete(unsigned* bar, unsigned x, unsigned& nloc, unsigned& nx) {
    const unsigned G = gridDim.x * gridDim.y * gridDim.z;
    unsigned sum, cnt, mine, sp = 0u;
    for (;;) {
        sum = 0u; cnt = 0u; mine = 0u;
#pragma unroll
        for (unsigned j = 0; j < 16; ++j) { const unsigned c = xb_ld(&bar[XB_XCNT(j)]); sum += c; cnt += (c > 0u) ? 1u : 0u; mine = (j == x) ? c : mine; }
        if (sum == G) break;
        __builtin_amdgcn_s_sleep(1);
        if ((++sp & 255u) == 0u) { if (xb_ld(&bar[XB_TMO])) break; if (sp > XB_SPIN_CAP) { atomicAdd(&bar[XB_TMO], 1u); break; } }
    }
    nloc = mine > 0u ? mine : 1u; nx = cnt > 0u ? cnt : 1u;
}
__device__ __forceinline__ void xcd_barrier(const XcdBarrier& b) {
    asm volatile("s_waitcnt vmcnt(0)" ::: "memory");
    __syncthreads();
    if (threadIdx.x == 0) {
        unsigned* bar = b.bar;
        __builtin_amdgcn_s_waitcnt(0);
        unsigned nloc = b.st[0], nx = b.st[1];
        if (nloc == 0u) { xcd_barrier_complete(bar, b.x, nloc, nx); b.st[0] = nloc; b.st[1] = nx; }
        const unsigned old = xb_add(&bar[XB_XSUB(b.x)], 1u);
        const unsigned gen = old / nloc;
        if (old + 1u == (gen + 1u) * nloc) {
            __builtin_amdgcn_fence(__ATOMIC_RELEASE, "agent");
            asm volatile("s_waitcnt vmcnt(0)" ::: "memory");
            const unsigned og = xb_add(&bar[XB_TOP], 1u);
            const unsigned tg = og / nx;
            if (og + 1u == (tg + 1u) * nx) xb_add(&bar[XB_TOPGEN], 1u);
            else XB_SPIN(xb_ld(&bar[XB_TOPGEN]) == tg, bar);
            __builtin_amdgcn_fence(__ATOMIC_ACQUIRE, "agent");
            xb_add(&bar[XB_XGEN(b.x)], 1u);
            asm volatile("s_waitcnt vmcnt(0)" ::: "memory");
        } else {
            XB_SPIN(xb_ld(&bar[XB_XGEN(b.x)]) == gen, bar);
            __builtin_amdgcn_fence(__ATOMIC_ACQUIRE, "agent");
            asm volatile("s_waitcnt vmcnt(0)" ::: "memory");
        }
    }
    __syncthreads();
}

constexpr int NWAVES = 8;
struct Args { const float* in[23]; float* out; unsigned char* ws; int ph_lo, ph_hi, flags, pad; };
__device__ __forceinline__ bool frame_refresh(struct Frame& F);
struct Frame {
    LAS unsigned char* lds;
    volatile LAS unsigned* MISC;
    gu32* ctl;
    int tid, lane, wave, vcu, G;
    unsigned char* ws;
    const float* const* in;
    float* out;
    int flags;
};
__device__ __forceinline__ bool frame_refresh(Frame& F) { int t = threadIdx.x; asm volatile("" : "+v"(t)); F.tid = t; F.lane = t & 63; F.wave = __builtin_amdgcn_readfirstlane(t >> 6); return true; }
enum In { I_X = 0, I_C, I_WADA, I_BADA, I_NMIX, I_NFFN, I_RELB, I_AWIN, I_AWOUT, I_AQN, I_AKN, I_BWIN, I_BFB, I_BWOUT, I_BQN, I_BKN, I_RGW, I_RGB, I_REW, I_REB, I_WG, I_WU, I_WD };

__device__ __forceinline__ void pro_mod_item(Frame& F, int item) {
    LAS float* s = (LAS float*)(F.lds + RING_OFF);
    LAS float* part = (LAS float*)(F.lds + RING_OFF + 16384);
    const float* c = F.in[I_C];
    for (int i = F.tid; i < 4 * D; i += NWAVES * 64) { const float v = c[i]; s[i] = v / (1.f + __expf(-v)); }
    __syncthreads();
    const int layer = item / 96, cc = item % 96, col = cc * 64 + F.lane;
    const float* W = F.in[I_WADA] + (size_t)layer * D * 6144 + col;
    float a0 = 0.f, a1 = 0.f, a2 = 0.f, a3 = 0.f;
    const int k0 = F.wave * 128;
#pragma unroll 8
    for (int k = k0; k < k0 + 128; ++k) { const float w = W[(size_t)k * 6144]; a0 += s[k] * w; a1 += s[D + k] * w; a2 += s[2 * D + k] * w; a3 += s[3 * D + k] * w; }
    part[(F.wave * 4 + 0) * 64 + F.lane] = a0; part[(F.wave * 4 + 1) * 64 + F.lane] = a1; part[(F.wave * 4 + 2) * 64 + F.lane] = a2; part[(F.wave * 4 + 3) * 64 + F.lane] = a3;
    __syncthreads();
    if (F.wave < 4) {
        float t = 0.f;
#pragma unroll
        for (int w = 0; w < 8; ++w) t += part[(w * 4 + F.wave) * 64 + F.lane];
        float* MOD = (float*)(F.ws + WS_MOD);
        MOD[(size_t)(layer * 4 + F.wave) * 6144 + col] = t + F.in[I_BADA][layer * 6144 + col];
    }
    __syncthreads();
}
__device__ __forceinline__ void pro_biasv(Frame& F) {
    float* BV = (float*)(F.ws + WS_BIASV);
    for (int i = F.tid; i < 48 * 129; i += NWAVES * 64) {
        const int gh = i / 129, dist = i % 129, g = gh / 16, d = dist * dil_of(g);
        int bucket;
        if (d < 16) bucket = d;
        else { const float v = logf((float)d / 16.0f) / 4.852030263919617f * 16.0f; bucket = 16 + (int)v; if (bucket > 31) bucket = 31; }
        BV[gh * BV_PITCH + dist] = F.in[I_RELB][bucket * 48 + gh] * LOG2E;
    }
}
__device__ __forceinline__ int rowmap(int mode, int n) {
    if (mode == 0) return n;
    if (mode == 1) return (n & ~255) + 128 * ((n >> 5) & 1) + 32 * ((n >> 6) & 3) + (n & 31);
    return 256 * (n >> 7) + (n & 127) + (mode == 3 ? 128 : 0);
}
__device__ __forceinline__ void transpose_item(const float* W, int ldw, bf16* WT, int ldt, int k0, int n0, int mode, LAS float* scr, int lane) {
#pragma unroll 8
    for (int i = 0; i < 32; ++i) { const int kk = 2 * i + (lane >> 5); scr[kk * 33 + (lane & 31)] = W[(size_t)(k0 + kk) * ldw + n0 + (lane & 31)]; }
    LDS_WAIT(); asm volatile("" ::: "memory");
    const int c = lane & 7;
#pragma unroll
    for (int j = 0; j < 4; ++j) { const int n = (lane >> 3) + 8 * j; const LAS float* s = scr + (8 * c) * 33 + n;
        v4u o; o.x = pk2(s[0 * 33], s[1 * 33]); o.y = pk2(s[2 * 33], s[3 * 33]); o.z = pk2(s[4 * 33], s[5 * 33]); o.w = pk2(s[6 * 33], s[7 * 33]);
        *(GAS v4u*)(WT + (size_t)rowmap(mode, n0 + n) * ldt + k0 + 8 * c) = o; }
    LDS_WAIT(); asm volatile("" ::: "memory");
}
__device__ __forceinline__ void p0_prologue(Frame& F) {
    if (blockIdx.x < 192) pro_mod_item(F, blockIdx.x);
    if (blockIdx.x == F.G - 1) pro_biasv(F);
    __syncthreads();
    LAS float* scr = (LAS float*)(F.lds + RING_OFF + F.wave * 16384);
    const int gw = F.vcu * NWAVES + F.wave, NGW = F.G * NWAVES;
    constexpr int I_A = 16 * 288, I_AO = 16 * 32, I_B = 16 * 96, I_BO = 16 * 32, I_E = 32 * 128;
    constexpr int NITEMS = I_A + I_AO + I_B + I_BO + 3 * I_E;
    for (int it = gw; it < NITEMS; it += NGW) {
        int r = it;
        if (r < I_A) { transpose_item(F.in[I_AWIN], 9216, (bf16*)(F.ws + WS_WAIN), 1024, 64 * (r / 288), 32 * (r % 288), 1, scr, F.lane); continue; } r -= I_A;
        if (r < I_AO) { transpose_item(F.in[I_AWOUT], 1024, (bf16*)(F.ws + WS_WAOUT), 1024, 64 * (r / 32), 32 * (r % 32), 0, scr, F.lane); continue; } r -= I_AO;
        if (r < I_B) { transpose_item(F.in[I_BWIN], 3088, (bf16*)(F.ws + WS_WBIN), 1024, 64 * (r / 96), 32 * (r % 96), 1, scr, F.lane); continue; } r -= I_B;
        if (r < I_BO) { transpose_item(F.in[I_BWOUT], 1024, (bf16*)(F.ws + WS_WBOUT), 1024, 64 * (r / 32), 32 * (r % 32), 0, scr, F.lane); continue; } r -= I_BO;
        if (r < I_E) { const int le = r / 128, q = r % 128;
            transpose_item(F.in[I_WG] + (size_t)le * D * FF, FF, (bf16*)(F.ws + WS_MOE1) + (size_t)le * 512 * D, 1024, 64 * (q / 8), 32 * (q % 8), 2, scr, F.lane); continue; } r -= I_E;
        if (r < I_E) { const int le = r / 128, q = r % 128;
            transpose_item(F.in[I_WU] + (size_t)le * D * FF, FF, (bf16*)(F.ws + WS_MOE1) + (size_t)le * 512 * D, 1024, 64 * (q / 8), 32 * (q % 8), 3, scr, F.lane); continue; } r -= I_E;
        { const int le = r / 128, q = r % 128;
            transpose_item(F.in[I_WD] + (size_t)le * FF * D, D, (bf16*)(F.ws + WS_MOE2) + (size_t)le * D * FF, 256, 64 * (q / 32), 32 * (q % 32), 0, scr, F.lane); }
    }
}

template <int N> __device__ __forceinline__ void reduce_scatter(float (&a)[64], int lane) {
    if constexpr (N >= 1) {
        const bool up = (lane & N) != 0;
#pragma unroll
        for (int i = 0; i < N; ++i) { const float keep = up ? a[i + N] : a[i], send = up ? a[i] : a[i + N]; a[i] = keep + __shfl_xor(send, N); }
        reduce_scatter<N / 2>(a, lane);
    }
}
template <int MODE> __device__ __forceinline__ void rowpass(Frame& F, const float* xin, const float* gain, int layer, int sh_idx, int sc_idx) {
    constexpr int NW = MODE == 1 ? 16 : (MODE == 2 ? 20 : 0), NWP = MODE == 1 ? 16 : 32, RPG = MODE == 1 ? 4 : 2;
    LAS float* Wl = (LAS float*)(F.lds + RING_OFF);
    LAS int* rowinfo = (LAS int*)(F.lds + RING_OFF + 98304);
    LAS float* wsum = (LAS float*)(F.lds + RING_OFF + 98304 + 1024) + F.wave * 64;
    const float* MOD = (const float*)(F.ws + WS_MOD) + (size_t)layer * 4 * 6144;
    bf16* HM = (bf16*)(F.ws + WS_HM);
    if constexpr (MODE == 1) { const float* W = F.in[I_BWIN] + 3072; f32x4 t[8];
#pragma unroll
        for (int q = 0; q < 8; ++q) { const int i = F.tid + q * 512, c = i >> 2, j4 = i & 3; t[q] = *(const f32x4*)(W + (size_t)c * 3088 + 4 * j4); }
#pragma unroll
        for (int q = 0; q < 8; ++q) { const int i = F.tid + q * 512, c = i >> 2, j4 = i & 3; Wl[(4 * j4 + 0) * D + c] = t[q].x; Wl[(4 * j4 + 1) * D + c] = t[q].y; Wl[(4 * j4 + 2) * D + c] = t[q].z; Wl[(4 * j4 + 3) * D + c] = t[q].w; } }
    if constexpr (MODE == 2) { const float* Wg = F.in[I_RGW] + (size_t)layer * D * 4; const float* We = F.in[I_REW] + (size_t)layer * D * 16; f32x4 t[10];
#pragma unroll
        for (int q = 0; q < 8; ++q) { const int i = F.tid + q * 512; t[q] = *(const f32x4*)(We + 4 * (size_t)i); }
#pragma unroll
        for (int q = 0; q < 2; ++q) { const int i = F.tid + q * 512; t[8 + q] = *(const f32x4*)(Wg + 4 * (size_t)i); }
#pragma unroll
        for (int q = 0; q < 8; ++q) { const int i = F.tid + q * 512, c = i >> 2, j4 = i & 3; Wl[(4 + 4 * j4 + 0) * D + c] = t[q].x; Wl[(4 + 4 * j4 + 1) * D + c] = t[q].y; Wl[(4 + 4 * j4 + 2) * D + c] = t[q].z; Wl[(4 + 4 * j4 + 3) * D + c] = t[q].w; }
#pragma unroll
        for (int q = 0; q < 2; ++q) { const int c = F.tid + q * 512; Wl[0 * D + c] = t[8 + q].x; Wl[1 * D + c] = t[8 + q].y; Wl[2 * D + c] = t[8 + q].z; Wl[3 * D + c] = t[8 + q].w; } }
    __syncthreads();
    for (int rb = blockIdx.x; rb < M / 64; rb += F.G) {
        const int b = (rb * 64) / SEQ;
        f32x4 Gv[4], Sv[4];
#pragma unroll
        for (int j = 0; j < 4; ++j) { const int c = 4 * F.lane + 256 * j;
            const f32x4 gv = *(const f32x4*)(gain + c), sc = *(const f32x4*)(MOD + (size_t)b * 6144 + sc_idx * D + c), sh = *(const f32x4*)(MOD + (size_t)b * 6144 + sh_idx * D + c);
            Gv[j] = gv * (sc + 1.0f); Sv[j] = sh; }
#pragma unroll 1
        for (int grp = 0; grp < 8 / RPG; ++grp) {
            const int m0 = rb * 64 + F.wave * 8 + grp * RPG;
            f32x4 v[RPG][4];
#pragma unroll
            for (int r = 0; r < RPG; ++r) { const GAS f32x4* xr = (const GAS f32x4*)(xin + (size_t)(m0 + r) * D) + F.lane;
#pragma unroll
                for (int j = 0; j < 4; ++j) v[r][j] = xr[64 * j]; }
#pragma unroll
            for (int r = 0; r < RPG; ++r) { float ss = 0.f;
#pragma unroll
                for (int j = 0; j < 4; ++j) ss += (v[r][j].x * v[r][j].x + v[r][j].y * v[r][j].y) + (v[r][j].z * v[r][j].z + v[r][j].w * v[r][j].w);
                const float rstd = 1.0f / sqrtf(wave_sum(ss) * (1.f / D) + EPS);
                GAS unsigned long long* o8 = (GAS unsigned long long*)(HM + (size_t)(m0 + r) * D) + F.lane;
#pragma unroll
                for (int j = 0; j < 4; ++j) { v[r][j] = v[r][j] * rstd * Gv[j] + Sv[j];
                    o8[64 * j] = (unsigned long long)pk2(v[r][j].x, v[r][j].y) | ((unsigned long long)pk2(v[r][j].z, v[r][j].w) << 32); } }
            if constexpr (NW > 0) {
                float a[64];
#pragma unroll
                for (int i = 0; i < 64; ++i) a[i] = 0.f;
#pragma unroll
                for (int jj = 0; jj < NW; ++jj) {
                    asm volatile("" ::: "memory");
#pragma unroll
                    for (int j = 0; j < 4; ++j) { const f32x4 w = *(const LAS f32x4*)(Wl + jj * D + 4 * F.lane + 256 * j);
#pragma unroll
                        for (int r = 0; r < RPG; ++r) a[r * NWP + jj] += (v[r][j].x * w.x + v[r][j].y * w.y) + (v[r][j].z * w.z + v[r][j].w * w.w); }
                }
                reduce_scatter<32>(a, F.lane);
                const float tot = a[0];
                if constexpr (MODE == 1) {
                    float* LOGF = (float*)(F.ws + WS_LOGF);
                    const float z = tot + F.in[I_BFB][F.lane & 15];
                    LOGF[(size_t)m0 * 16 + F.lane] = fminf(z, 0.f) - log1pf(expf(-fabsf(z)));
                }
                if constexpr (MODE == 2) {
                    wsum[F.lane] = tot; LDS_WAIT();
                    if (F.lane < RPG) {
                        const float* bg = F.in[I_RGB] + layer * 4; const float* be = F.in[I_REB] + layer * 16;
                        v4u* TOKREC = (v4u*)(F.ws + ((F.flags & 2) ? WS_END : WS_TOKREC));
                        const LAS float* dr = wsum + F.lane * NWP;
                        const float g0 = dr[0] + bg[0], g1 = dr[1] + bg[1], g2 = dr[2] + bg[2], g3 = dr[3] + bg[3];
                        int gi = 0; float gm = g0; if (g1 > gm) { gm = g1; gi = 1; } if (g2 > gm) { gm = g2; gi = 2; } if (g3 > gm) { gm = g3; gi = 3; }
                        const float gw = 1.0f / (expf(g0 - gm) + expf(g1 - gm) + expf(g2 - gm) + expf(g3 - gm));
                        float es[4];
#pragma unroll
                        for (int i = 0; i < 4; ++i) es[i] = dr[4 + gi * 4 + i] + be[gi * 4 + i];
                        int i1 = 0; float v1 = es[0];
#pragma unroll
                        for (int i = 1; i < 4; ++i) if (es[i] > v1) { v1 = es[i]; i1 = i; }
                        int i2 = -1; float v2 = -INFINITY;
#pragma unroll
                        for (int i = 0; i < 4; ++i) if (i != i1 && es[i] > v2) { v2 = es[i]; i2 = i; }
                        const float ex = expf(v2 - v1), w1 = gw / (1.0f + ex), w2 = gw * ex / (1.0f + ex);
                        const int aa = i1 < i2 ? i1 : i2, bb = i1 < i2 ? i2 : i1;
                        const float wlo = i1 < i2 ? w1 : w2, whi = i1 < i2 ? w2 : w1;
                        const int pidx = aa == 0 ? bb - 1 : (aa == 1 ? bb + 1 : 5);
                        const int lo = gi * 4 + aa, hi = gi * 4 + bb, combo = gi * 6 + pidx;
                        v4u rec; rec.x = (unsigned)(lo | (hi << 8) | (combo << 16)); rec.y = __float_as_uint(wlo); rec.z = __float_as_uint(whi); rec.w = 0u;
                        TOKREC[m0 + F.lane] = rec; rowinfo[F.wave * 8 + grp * RPG + F.lane] = lo | (hi << 8) | (combo << 16);
                    }
                    LDS_WAIT();
                }
            }
        }
        if (MODE == 2) {
            __syncthreads();
            if (F.tid < 40) {
                const int t = F.tid; int n = 0;
#pragma unroll 8
                for (int r = 0; r < 64; ++r) { const int ri = rowinfo[r]; const bool mem = t < 16 ? ((ri & 0xff) == t || ((ri >> 8) & 0xff) == t) : ((ri >> 16) == t - 16); n += mem ? 1 : 0; }
                gu32* cnt = F.ctl + CW_CNT + (((F.flags & 2) ? 2 : layer) * 40 + t) * 64;
                const int base = (int)__hip_atomic_fetch_add(cnt, (unsigned)n, RLX_AGENT);
                int* list = (int*)(F.ws + ((F.flags & 2) ? WS_END + MiB : (t < 16 ? WS_ELIST : WS_CLIST))) + (t < 16 ? t : ((F.flags & 2) ? t : t - 16)) * M;
                int kk = 0;
                for (int r = 0; r < 64; ++r) { const int ri = rowinfo[r]; const bool mem = t < 16 ? ((ri & 0xff) == t || ((ri >> 8) & 0xff) == t) : ((ri >> 16) == t - 16);
                    if (mem) { list[base + kk] = rb * 64 + r; ++kk; } }
            }
            __syncthreads();
        }
    }
}

__device__ __forceinline__ void cumsum_phase(Frame& F) {
    LAS float* wt = (LAS float*)(F.lds + RING_OFF);
    for (int bh = blockIdx.x; bh < BATCH * H; bh += F.G) {
        const int b = bh / H, h = bh % H;
        const float* LOGF = (const float*)(F.ws + WS_LOGF) + (size_t)b * SEQ * 16 + h;
        float v[8]; float run = 0.f;
#pragma unroll
        for (int i = 0; i < 8; ++i) { run += LOGF[(size_t)(F.tid * 8 + i) * 16]; v[i] = run; }
        float inc = run;
#pragma unroll
        for (int o = 1; o < 64; o <<= 1) { const float n = __shfl_up(inc, o); if (F.lane >= o) inc += n; }
        if (F.lane == 63) wt[F.wave] = inc;
        __syncthreads();
        float base = inc - run;
        for (int w = 0; w < F.wave; ++w) base += wt[w];
        float* CUM = (float*)(F.ws + WS_CUM) + (size_t)bh * SEQ + F.tid * 8;
#pragma unroll
        for (int i = 0; i < 8; ++i) CUM[i] = -(base + v[i]) * LOG2E;
        __syncthreads();
    }
}

namespace pg8 {
typedef unsigned short bf16_t;
typedef unsigned u32x4 __attribute__((ext_vector_type(4)));
constexpr int BM = 256, BK = 64, HALF = 128, HTB = HALF * BK * 2, STAGE_BYTES = 8 * HTB, NXCD = 8, WGM = 8;
__host__ __device__ __forceinline__ int lds_byte(int r, int c) { const int st = (r >> 4) * 2 + (c >> 5), rr = r & 15, cc = c & 31, ob = rr * 64 + cc * 2; return st * 1024 + (ob ^ (((ob >> 9) & 1) << 5)); }
__host__ __device__ __forceinline__ void stage_rc(int b, int& R, int& C) { const int st = b / 1024, sb = b % 1024, swz = sb ^ (((sb >> 9) & 1) << 5); R = (st >> 1) * 16 + swz / 64; C = (st & 1) * 32 + (swz % 64) / 2; }
__host__ __device__ __forceinline__ int perm32(int rho) { const int n = rho >> 4, i = rho & 15; return 8 * (i >> 2) + 4 * n + (i & 3); }
struct Unit { int pm, pn, e, cnt; };
__device__ __forceinline__ unsigned cvt_pk_bf16(float lo, float hi) { unsigned r; asm volatile("v_cvt_pk_bf16_f32 %0, %1, %2" : "=v"(r) : "v"(lo), "v"(hi)); return r; }

struct StaticOrder {
    int nM, nN, nwg, G, c; const char* A; const char* Bt; size_t tstepA, tstepB; int ks;
    __device__ void init(int M_, int N_, int G_, int c_, const void* A_, int lda, const void* Bt_, int ldb, int nt) { nM = M_ / BM; nN = N_ / BM; nwg = nM * nN; G = G_; c = c_; A = (const char*)A_; Bt = (const char*)Bt_; tstepA = (size_t)BM * lda * 2; tstepB = (size_t)BM * ldb * 2; ks = nt; }
    __device__ bool next(int i, Unit& u) const {
        const long L = (long)i * G + c; if (L >= nwg) return false;
        int wgid = (int)L; { const int q = nwg / NXCD, r = nwg % NXCD, xcd = wgid % NXCD, off = wgid / NXCD; wgid = (xcd < r ? xcd * (q + 1) : r * (q + 1) + (xcd - r) * q) + off; }
        const int nig = WGM * nN, gid = wgid / nig, fm = gid * WGM, gsz = (nM - fm) < WGM ? (nM - fm) : WGM;
        u.pm = fm + ((wgid % nig) % gsz); u.pn = (wgid % nig) / gsz; u.e = 0; u.cnt = 0; return true;
    }
    __device__ __forceinline__ const char* a_base(const Unit& u) const { return A + (size_t)u.pm * tstepA; }
    __device__ __forceinline__ const char* b_lo(const Unit& u) const { return Bt + (size_t)u.pn * tstepB; }
    __device__ __forceinline__ const char* b_hi(const Unit& u) const { return Bt + (size_t)u.pn * tstepB; }
    __device__ __forceinline__ int row(const Unit&, int) const { return 0; }
};
struct MoeOrder {
    int G, c, nl, ntn, ks, mode; const char* A; const char* B; const int* lists; const LAS int* tab;
    __device__ bool next(int i, Unit& u) const {
        const int L = i * G + c, total = __builtin_amdgcn_readfirstlane(tab[nl]) * ntn; if (L >= total) return false;
        const int rt = L / ntn; int e = 0;
        for (int k = 1; k < nl; ++k) e = (tab[k] <= rt) ? k : e;
        u.e = __builtin_amdgcn_readfirstlane(e); u.pm = __builtin_amdgcn_readfirstlane(rt - tab[e]); u.pn = L % ntn; u.cnt = __builtin_amdgcn_readfirstlane(tab[32 + e]); return true;
    }
    __device__ __forceinline__ const char* a_base(const Unit&) const { return A; }
    __device__ __forceinline__ const char* b_lo(const Unit& u) const {
        if (mode == 1) return B + ((size_t)u.e * 512 + (size_t)u.pn * 256) * 1024 * 2;
        const int g = u.e / 6, p = u.e % 6, a = p < 3 ? 0 : (p < 5 ? 1 : 2);
        return B + ((size_t)(g * 4 + a) * 1024 + (size_t)u.pn * 256) * 256 * 2; }
    __device__ __forceinline__ const char* b_hi(const Unit& u) const {
        if (mode == 1) return b_lo(u);
        const int g = u.e / 6, p = u.e % 6, b = p < 3 ? p + 1 : (p < 5 ? p - 1 : 3);
        return B + ((size_t)(g * 4 + b) * 1024 + (size_t)u.pn * 256) * 256 * 2; }
    __device__ __forceinline__ int row(const Unit& u, int r) const { int idx = u.pm * 256 + r; idx = idx < u.cnt ? idx : u.cnt - 1; return lists[(size_t)u.e * 16384 + idx]; }
};

struct EpiQKV {
    static constexpr bool PERM = true;
    bf16_t* Qo; const float* qg; const float* kg;
    __device__ __forceinline__ void operator()(const f32x4 (&acc)[2][2][4][2], const Unit& u, int wr, int wc, int fr, int fq) const {
        const int t = u.pn >> 2, hcol = (u.pn & 3) * 256 + wc * 64;
        bf16_t* base = Qo + (size_t)t * ((WS_K - WS_Q) / 2) + hcol + 8 * fq;
        f32x4 gv[2][2];
        const float* gp = qg + (t == 1 ? (kg - qg) : 0) + 8 * fq;
#pragma unroll
        for (int bj = 0; bj < 2; ++bj)
#pragma unroll
            for (int n = 0; n < 2; ++n) gv[bj][n] = (t < 2) ? *(const f32x4*)(gp + 32 * bj + 4 * n) : (f32x4){1.f, 1.f, 1.f, 1.f};
        const float sc = (t == 0) ? C2 : 1.0f;
#pragma unroll
        for (int ai = 0; ai < 2; ++ai)
#pragma unroll
            for (int m = 0; m < 4; ++m) {
                float rs = sc;
                if (t < 2) { float ss = 0.f;
#pragma unroll
                    for (int bj = 0; bj < 2; ++bj)
#pragma unroll
                        for (int n = 0; n < 2; ++n) { const f32x4 x = acc[ai][bj][m][n]; ss += (x[0] * x[0] + x[1] * x[1]) + (x[2] * x[2] + x[3] * x[3]); }
                    ss += __shfl_xor(ss, 16); ss += __shfl_xor(ss, 32);
                    rs = sc / sqrtf(ss * (1.0f / 64.0f) + EPS); }
                bf16_t* rowp = base + (size_t)(u.pm * BM + ai * HALF + wr * 64 + m * 16 + fr) * 1024;
#pragma unroll
                for (int bj = 0; bj < 2; ++bj) { const f32x4 v0 = acc[ai][bj][m][0] * rs * gv[bj][0], v1 = acc[ai][bj][m][1] * rs * gv[bj][1];
                    u32x4 w; w.x = cvt_pk_bf16(v0[0], v0[1]); w.y = cvt_pk_bf16(v0[2], v0[3]); w.z = cvt_pk_bf16(v1[0], v1[1]); w.w = cvt_pk_bf16(v1[2], v1[3]);
                    *(u32x4*)(rowp + 32 * bj) = w; } }
    }
};
struct EpiOut {
    static constexpr bool PERM = false;
    const float* xin; float* xout; const float* gvec;
    __device__ __forceinline__ void operator()(const f32x4 (&acc)[2][2][4][2], const Unit& u, int wr, int wc, int fr, int fq) const {
        const int col0 = u.pn * BM + wc * 32 + 4 * fq, b = (u.pm * BM) / SEQ;
        f32x4 g[2][2];
#pragma unroll
        for (int bj = 0; bj < 2; ++bj)
#pragma unroll
            for (int n = 0; n < 2; ++n) g[bj][n] = *(const f32x4*)(gvec + (size_t)b * 6144 + col0 + bj * HALF + n * 16);
#pragma unroll
        for (int ai = 0; ai < 2; ++ai)
#pragma unroll
            for (int m = 0; m < 4; ++m) { const size_t off = (size_t)(u.pm * BM + ai * HALF + wr * 64 + m * 16 + fr) * D + col0;
#pragma unroll
                for (int bj = 0; bj < 2; ++bj)
#pragma unroll
                    for (int n = 0; n < 2; ++n) { const f32x4 xi = *(const f32x4*)(xin + off + bj * HALF + n * 16); *(f32x4*)(xout + off + bj * HALF + n * 16) = xi + g[bj][n] * acc[ai][bj][m][n]; }
                if (m & 1) asm volatile("" ::: "memory"); }
    }
};
struct EpiMoe1 {
    static constexpr bool PERM = true;
    const int* lists; const v4u* tokrec; bf16_t* HID2;
    __device__ __forceinline__ void operator()(const f32x4 (&acc)[2][2][4][2], const Unit& u, int wr, int wc, int fr, int fq) const {
        const int f = u.pn * 128 + wc * 32 + 8 * fq;
#pragma unroll
        for (int ai = 0; ai < 2; ++ai)
#pragma unroll
            for (int m = 0; m < 4; ++m) { const int idx = u.pm * BM + ai * HALF + wr * 64 + m * 16 + fr;
                if (idx < u.cnt) { const int tok = lists[(size_t)u.e * 16384 + idx]; const v4u rec = tokrec[tok];
                    const int slot = ((int)(rec.x & 0xffu) == u.e) ? 0 : 1; const float w = __uint_as_float(slot ? rec.z : rec.y);
                    float h[8];
#pragma unroll
                    for (int n = 0; n < 2; ++n)
#pragma unroll
                        for (int j = 0; j < 4; ++j) { const float g = acc[ai][0][m][n][j], up = acc[ai][1][m][n][j]; h[n * 4 + j] = g / (1.0f + __expf(-g)) * up * w; }
                    u32x4 o; o.x = cvt_pk_bf16(h[0], h[1]); o.y = cvt_pk_bf16(h[2], h[3]); o.z = cvt_pk_bf16(h[4], h[5]); o.w = cvt_pk_bf16(h[6], h[7]);
                    *(u32x4*)(HID2 + (size_t)tok * 512 + slot * 256 + f) = o; } }
    }
};
struct EpiMoe2 {
    static constexpr bool PERM = false;
    const int* lists; float* x; const float* gvec; float gs;
    __device__ __forceinline__ void operator()(const f32x4 (&acc)[2][2][4][2], const Unit& u, int wr, int wc, int fr, int fq) const {
        const int col0 = u.pn * BM + wc * 32 + 4 * fq;
#pragma unroll
        for (int ai = 0; ai < 2; ++ai)
#pragma unroll
            for (int m = 0; m < 4; ++m) { const int idx = u.pm * BM + ai * HALF + wr * 64 + m * 16 + fr;
                if (idx < u.cnt) { const int tok = lists[(size_t)u.e * 16384 + idx]; const int b = tok / SEQ; const size_t off = (size_t)tok * D + col0;
#pragma unroll
                    for (int bj = 0; bj < 2; ++bj)
#pragma unroll
                        for (int n = 0; n < 2; ++n) { const f32x4 g = *(const f32x4*)(gvec + (size_t)b * 6144 + col0 + bj * HALF + n * 16);
                            const f32x4 xi = *(const f32x4*)(x + off + bj * HALF + n * 16); *(f32x4*)(x + off + bj * HALF + n * 16) = xi + (g * gs) * acc[ai][bj][m][n]; } }
                if (m & 1) asm volatile("" ::: "memory"); }
    }
};

template <class Epi, class Sched, bool GATHER, bool ALIGN_EPI>
__device__ __forceinline__ void gemm_phase(LAS unsigned char* lds, const int lda, const int ldb, const int K, const Sched& S, const Epi& E) {
    int tid_ = threadIdx.x; asm volatile("" : "+v"(tid_));
    const int tid = tid_, wid = __builtin_amdgcn_readfirstlane(tid >> 6), lane = tid & 63, wr = wid >> 2, wc = wid & 3, fr = lane & 15, fq = lane >> 4;
    const int nt = K / BK, ks = S.ks;
    unsigned voffA[2][2], voffB[2], nvA[2][2];
#pragma unroll
    for (int i = 0; i < 2; ++i) { int R, C; stage_rc(tid * 16 + i * 8192, R, C); const int Rb = Epi::PERM ? ((R & ~31) + perm32(R & 31)) : R;
        voffB[i] = (unsigned)(Rb * ldb + C) * 2u; voffA[0][i] = (unsigned)(R * lda + C) * 2u; voffA[1][i] = 0u; nvA[0][i] = 0u; nvA[1][i] = 0u; }
    const size_t kstep = (size_t)(BK * 2);
    const size_t hstepA = GATHER ? (size_t)0 : (size_t)HALF * lda * 2, hstepB = (size_t)HALF * ldb * 2;
    const unsigned ldsw = (unsigned)wid * 1024u;
    const int aoff = lds_byte(wr * 64 + fr, fq * 8), boff = lds_byte(wc * 32 + fr, fq * 8);
#define PG8_SA(b, h) (((b) * 2 + (h)) * HTB)
#define PG8_SB(b, h) ((4 + (b) * 2 + (h)) * HTB)
#define PG8_STAGE(bufoff, gbase, voff) do { _Pragma("unroll") for (int _i = 0; _i < 2; ++_i) \
        __builtin_amdgcn_global_load_lds((const unsigned*)((const char*)(gbase) + (voff)[_i]), (LAS unsigned*)(lds + (bufoff) + ldsw + _i * 8192), 16, 0, 0); } while (0)
#define PG8_STAGE_A(bufoff, gbase, h) do { if constexpr (GATHER) { PG8_STAGE(bufoff, gbase, voffA[h]); } else { PG8_STAGE(bufoff, (gbase) + (h) * hstepA, voffA[0]); } } while (0)
#define PG8_STAGE_B(bufoff, gbase, h) PG8_STAGE(bufoff, (gbase) + (h) * hstepB, voffB)
#define PG8_GATHER_OFFS(dst, u) do { _Pragma("unroll") for (int _h = 0; _h < 2; ++_h) _Pragma("unroll") for (int _i = 0; _i < 2; ++_i) { int _R, _C; stage_rc(tid * 16 + _i * 8192, _R, _C); \
        dst[_h][_i] = (unsigned)(S.row(u, _h * HALF + _R) * lda + _C) * 2u; } } while (0)
#define PG8_LDA(dst, b, h) do { _Pragma("unroll") for (int m = 0; m < 4; ++m) _Pragma("unroll") for (int k = 0; k < 2; ++k) dst[m][k] = *(const LAS bf16x8*)(lds + PG8_SA(b, h) + aoff + m * 2048 + k * 1024); } while (0)
#define PG8_LDB(dst, b, h) do { _Pragma("unroll") for (int n = 0; n < 2; ++n) _Pragma("unroll") for (int k = 0; k < 2; ++k) dst[n][k] = *(const LAS bf16x8*)(lds + PG8_SB(b, h) + boff + n * 2048 + k * 1024); } while (0)
#define PG8_MMA(ai, bj, At, Bt) do { __builtin_amdgcn_s_setprio(1); _Pragma("unroll") for (int m = 0; m < 4; ++m) _Pragma("unroll") for (int n = 0; n < 2; ++n) _Pragma("unroll") for (int k = 0; k < 2; ++k) \
        acc[ai][bj][m][n] = __builtin_amdgcn_mfma_f32_16x16x32_bf16(Bt[n][k], At[m][k], acc[ai][bj][m][n], 0, 0, 0); __builtin_amdgcn_s_setprio(0); } while (0)
#define PG8_WAIT_V(n) asm volatile("s_waitcnt vmcnt(" #n ")" ::: "memory")
#define PG8_WAIT_L(n) asm volatile("s_waitcnt lgkmcnt(" #n ")" ::: "memory")
#define PG8_BAR __builtin_amdgcn_s_barrier()
#define PG8_SCHED __builtin_amdgcn_sched_barrier(0)
#define PG8_BPTR(blo, bhi, t) (((t) < ks) ? (blo) + (size_t)(t) * kstep : (bhi) + (size_t)((t) - ks) * kstep)
    Unit cur, nxt; int ui = 0;
    if (!S.next(0, cur)) return;
    f32x4 acc[2][2][4][2];
#pragma unroll
    for (int a = 0; a < 2; ++a)
#pragma unroll
        for (int b = 0; b < 2; ++b)
#pragma unroll
            for (int m = 0; m < 4; ++m)
#pragma unroll
                for (int n = 0; n < 2; ++n) acc[a][b][m][n] = (f32x4){0.f, 0.f, 0.f, 0.f};
    bf16x8 At[4][2], B0[2][2], B1[2][2];
    const char* cA = S.a_base(cur); const char* cBlo = S.b_lo(cur); const char* cBhi = S.b_hi(cur);
    if constexpr (GATHER) { PG8_GATHER_OFFS(voffA, cur); }
    PG8_STAGE_B(PG8_SB(0, 0), cBlo, 0); PG8_STAGE_B(PG8_SB(0, 1), cBlo, 1); PG8_STAGE_A(PG8_SA(0, 0), cA, 0); PG8_STAGE_A(PG8_SA(0, 1), cA, 1);
    if (wr == 1) PG8_BAR;
    PG8_WAIT_V(2); PG8_BAR;
    PG8_STAGE_B(PG8_SB(1, 0), cBlo + kstep, 0); PG8_STAGE_A(PG8_SA(1, 0), cA + kstep, 0); PG8_STAGE_B(PG8_SB(1, 1), cBlo + kstep, 1);
    PG8_WAIT_V(6); PG8_BAR;
    for (;;) {
        const bool has_next = S.next(ui + 1, nxt);
        const char* nA = has_next ? S.a_base(nxt) : cA; const char* nBlo = has_next ? S.b_lo(nxt) : cBlo; const char* nBhi = has_next ? S.b_hi(nxt) : cBhi;
        if constexpr (GATHER) { if (has_next) { PG8_GATHER_OFFS(nvA, nxt); } else {
#pragma unroll
            for (int h = 0; h < 2; ++h)
#pragma unroll
                for (int i = 0; i < 2; ++i) nvA[h][i] = voffA[h][i]; } }
#pragma unroll 1
        for (int t = 0; t < nt; t += 2) {
            const bool last = (t == nt - 2);
            const char* a1 = cA + (size_t)(t + 1) * kstep;
            const char* a2 = last ? nA : cA + (size_t)(t + 2) * kstep; const char* b2 = last ? nBlo : PG8_BPTR(cBlo, cBhi, t + 2);
            const char* a3 = a2 + kstep; const char* b3 = b2 + kstep;
            PG8_LDB(B0, 0, 0); PG8_LDB(B1, 0, 1); PG8_SCHED; PG8_LDA(At, 0, 0); PG8_STAGE_A(PG8_SA(1, 1), a1, 1);
            if constexpr (GATHER) { if (last) {
#pragma unroll
                for (int h = 0; h < 2; ++h)
#pragma unroll
                    for (int i = 0; i < 2; ++i) voffA[h][i] = nvA[h][i]; } }
            PG8_WAIT_V(8); PG8_WAIT_L(0); PG8_BAR; PG8_MMA(0, 0, At, B0); PG8_MMA(0, 1, At, B1); PG8_BAR; PG8_SCHED;
            PG8_LDA(At, 0, 1); PG8_STAGE_B(PG8_SB(0, 0), b2, 0); PG8_STAGE_B(PG8_SB(0, 1), b2, 1); PG8_STAGE_A(PG8_SA(0, 0), a2, 0);
            PG8_WAIT_V(8); PG8_WAIT_L(0); PG8_BAR; PG8_MMA(1, 0, At, B0); PG8_MMA(1, 1, At, B1); PG8_BAR; PG8_SCHED;
            PG8_LDB(B0, 1, 0); PG8_LDB(B1, 1, 1); PG8_SCHED; PG8_LDA(At, 1, 0); PG8_STAGE_A(PG8_SA(0, 1), a2, 1);
            PG8_WAIT_V(8); PG8_WAIT_L(0); PG8_BAR; PG8_MMA(0, 0, At, B0); PG8_MMA(0, 1, At, B1); PG8_BAR; PG8_SCHED;
            PG8_LDA(At, 1, 1); PG8_STAGE_B(PG8_SB(1, 0), b3, 0); PG8_STAGE_B(PG8_SB(1, 1), b3, 1); PG8_STAGE_A(PG8_SA(1, 0), a3, 0);
            PG8_WAIT_V(8); PG8_WAIT_L(0); PG8_BAR; PG8_MMA(1, 0, At, B0); PG8_MMA(1, 1, At, B1); PG8_BAR; PG8_SCHED;
        }
        if constexpr (ALIGN_EPI) { if (wr == 0) PG8_BAR; }
        E(acc, cur, wr, wc, fr, fq);
        if (!has_next) break;
#pragma unroll
        for (int a = 0; a < 2; ++a)
#pragma unroll
            for (int b = 0; b < 2; ++b)
#pragma unroll
                for (int m = 0; m < 4; ++m)
#pragma unroll
                    for (int n = 0; n < 2; ++n) acc[a][b][m][n] = (f32x4){0.f, 0.f, 0.f, 0.f};
        cur = nxt; cA = nA; cBlo = nBlo; cBhi = nBhi; ++ui;
        if constexpr (ALIGN_EPI) { if (wr == 1) PG8_BAR; }
    }
    PG8_WAIT_V(0);
    if constexpr (!ALIGN_EPI) { if (wr == 0) PG8_BAR; }
    PG8_BAR;
#undef PG8_SA
#undef PG8_SB
#undef PG8_STAGE
#undef PG8_STAGE_A
#undef PG8_STAGE_B
#undef PG8_GATHER_OFFS
#undef PG8_LDA
#undef PG8_LDB
#undef PG8_MMA
#undef PG8_WAIT_V
#undef PG8_WAIT_L
#undef PG8_BAR
#undef PG8_SCHED
#undef PG8_BPTR
}
}

namespace attn_body {
using bf16=__hip_bfloat16;
using bf16x8=__attribute__((ext_vector_type(8)))short;
using s16x4=__attribute__((ext_vector_type(4)))short;
using f32x16=__attribute__((ext_vector_type(16)))float;
using u32x4=__attribute__((ext_vector_type(4)))unsigned;
constexpr int BATCH=4,NHEAD=16,SEQ=4096,D=64,DM=NHEAD*D;
constexpr int NW=8,QBLK=32,QB=QBLK*NW,KVBLK=64,NQB=SEQ/QB;
constexpr int ATTN_PITCH=DM, ATTN_UNIT_ROWS=QB;
__device__ __forceinline__ int crow(int r,int hi){return (r&3)+8*(r>>2)+4*hi;}
#define SBAR() __builtin_amdgcn_sched_barrier(0)
__device__ __forceinline__ void cmask(f32x16&p0,f32x16&p1,int jb,int qrel,int hi){
  const float NEG=-INFINITY; int kb=64*jb+4*hi;
  #pragma unroll
  for(int r=0;r<16;++r){int kv=kb+(r&3)+8*(r>>2); if(kv>qrel)p0[r]=NEG; if(kv+32>qrel)p1[r]=NEG;}
}

constexpr int NSLOT=3, SLOTB=8192;
constexpr int LDS_K=0, LDS_V=NSLOT*SLOTB, LDS_WS=2*NSLOT*SLOTB, LDS_OST=LDS_WS+NW*64*4, LDS_BYTES=LDS_OST+NW*4096;
constexpr float C2=0.125f*1.4426950408889634f;
__device__ __forceinline__ void glds16(const void*gsrc,unsigned lds_dst){unsigned keep;
  asm volatile("s_mov_b32 %0, m0\n\ts_mov_b32 m0, %2\n\ts_nop 0\n\tglobal_load_lds_dwordx4 %1, off\n\ts_mov_b32 m0, %0":"=&s"(keep):"v"(gsrc),"s"(lds_dst):"memory");}
__device__ __forceinline__ float max3f(float a,float b,float c){float r;asm("v_max3_f32 %0, %1, %2, %3":"=v"(r):"v"(a),"v"(b),"v"(c));return r;}
__device__ __forceinline__ float max2f(float a,float b){float r;asm("v_max_f32_e32 %0, %1, %2":"=v"(r):"v"(a),"v"(b));return r;}
__device__ __forceinline__ float fadd_s(float a,float b){float r;asm("v_add_f32_e32 %0, %1, %2":"=v"(r):"v"(a),"v"(b));return r;}
__device__ __forceinline__ float fsub_s(float a,float b){float r;asm("v_sub_f32_e32 %0, %1, %2":"=v"(r):"v"(a),"v"(b));return r;}
typedef float f32x2_t __attribute__((ext_vector_type(2))); typedef float f32x4_t __attribute__((ext_vector_type(4))); typedef __bf16 bf16x2_t __attribute__((ext_vector_type(2)));
__device__ __forceinline__ unsigned cvtpk_s(float lo,float hi){f32x2_t v={lo,hi};bf16x2_t b=__builtin_convertvector(v,bf16x2_t);return __builtin_bit_cast(unsigned,b);}
#define WAIT_BAR(N) asm volatile("s_waitcnt vmcnt(" #N ") lgkmcnt(0)\n\ts_barrier":::"memory")

__device__ __forceinline__ void qkt(f32x16&p0,f32x16&p1,const char*Kslot,const bf16x8*qr,const f32x16&negm,int r32,int hi){
  const char*kb=Kslot+hi*1024+r32*16;
  #pragma unroll
  for(int d0=0;d0<4;++d0){
    const bf16x8 b0=*reinterpret_cast<const bf16x8*>(kb+d0*2048);
    const bf16x8 b1=*reinterpret_cast<const bf16x8*>(kb+d0*2048+512);
    if(d0==0){p0=__builtin_amdgcn_mfma_f32_32x32x16_bf16(b0,qr[0],negm,0,0,0);p1=__builtin_amdgcn_mfma_f32_32x32x16_bf16(b1,qr[0],negm,0,0,0);}
    else{p0=__builtin_amdgcn_mfma_f32_32x32x16_bf16(b0,qr[d0],p0,0,0,0);p1=__builtin_amdgcn_mfma_f32_32x32x16_bf16(b1,qr[d0],p1,0,0,0);}}
}
typedef __attribute__((address_space(3))) const char* lds_cptr;
typedef short v4i16_t __attribute__((ext_vector_type(4)));
__device__ __forceinline__ void kload8(bf16x8*kf,lds_cptr kp){
  kf[0]=*(const __attribute__((address_space(3))) bf16x8*)(kp);      kf[1]=*(const __attribute__((address_space(3))) bf16x8*)(kp+512);
  kf[2]=*(const __attribute__((address_space(3))) bf16x8*)(kp+2048); kf[3]=*(const __attribute__((address_space(3))) bf16x8*)(kp+2560);
  kf[4]=*(const __attribute__((address_space(3))) bf16x8*)(kp+4096); kf[5]=*(const __attribute__((address_space(3))) bf16x8*)(kp+4608);
  kf[6]=*(const __attribute__((address_space(3))) bf16x8*)(kp+6144); kf[7]=*(const __attribute__((address_space(3))) bf16x8*)(kp+6656);
}
__device__ __forceinline__ void kload2(bf16x8*kf,lds_cptr kp,int j){ kf[2*j]=*(const __attribute__((address_space(3))) bf16x8*)(kp+j*2048); kf[2*j+1]=*(const __attribute__((address_space(3))) bf16x8*)(kp+j*2048+512); }
__device__ __forceinline__ s16x4 vtr(lds_cptr p){ return __builtin_bit_cast(s16x4,__builtin_amdgcn_ds_read_tr16_b64_v4i16((__attribute__((address_space(3))) v4i16_t*)p)); }
__device__ __forceinline__ float rowmax(const f32x16&p0,const f32x16&p1){
  float a=max3f(p0[0],p0[1],p1[0]),b=max3f(p0[2],p0[3],p1[1]);a=max3f(a,p1[2],p1[3]);
  #pragma unroll
  for(int r=4;r<16;r+=4){a=max3f(a,p0[r],p0[r+1]);b=max3f(b,p0[r+2],p0[r+3]);a=max3f(a,p1[r],p1[r+1]);b=max3f(b,p1[r+2],p1[r+3]);}
  const float m=max2f(a,b);
  auto rr=__builtin_amdgcn_permlane32_swap(__float_as_uint(m),__float_as_uint(m),false,false);
  return max2f(__uint_as_float(rr[0]),__uint_as_float(rr[1]));
}
__device__ __forceinline__ void pv(f32x16*o,int vb,bf16x8 pa0,bf16x8 pa1,bf16x8 pa2,bf16x8 pa3){
  #pragma unroll
  for(int d0=0;d0<2;++d0){s16x4 lo[4],hi[4];
    #pragma unroll
    for(int ks=0;ks<4;++ks){
      asm volatile("ds_read_b64_tr_b16 %0,%1 offset:%c2":"=&v"(lo[ks]):"v"(vb),"i"(d0*4096+ks*1024):"memory");
      asm volatile("ds_read_b64_tr_b16 %0,%1 offset:%c2":"=&v"(hi[ks]):"v"(vb),"i"(d0*4096+ks*1024+512):"memory");}
    asm volatile("s_waitcnt lgkmcnt(0)":::"memory");SBAR();
    #define PK(k) (bf16x8){lo[k][0],lo[k][1],lo[k][2],lo[k][3],hi[k][0],hi[k][1],hi[k][2],hi[k][3]}
    o[d0]=__builtin_amdgcn_mfma_f32_32x32x16_bf16(pa0,PK(0),o[d0],0,0,0);
    o[d0]=__builtin_amdgcn_mfma_f32_32x32x16_bf16(pa1,PK(1),o[d0],0,0,0);
    o[d0]=__builtin_amdgcn_mfma_f32_32x32x16_bf16(pa2,PK(2),o[d0],0,0,0);
    o[d0]=__builtin_amdgcn_mfma_f32_32x32x16_bf16(pa3,PK(3),o[d0],0,0,0);
    #undef PK
  }
}

#ifndef ATTN_STORE16
#define ATTN_STORE16(p,v) (*(u32x4*)(p)=(v))
#endif
template<int THRL> __device__ __forceinline__ void attn_unit(int b,int h,int qb,int t0,const bf16*Q,const bf16*__restrict__ K,const bf16*__restrict__ V,bf16*O,char*shm,const __attribute__((address_space(3))) float*ncum){
  int tid_=threadIdx.x; asm volatile("":"+v"(tid_)); const int tid=tid_,lane=tid&63,r32=lane&31,hi=lane>>5; const int wid=__builtin_amdgcn_readfirstlane(tid>>6);
  const long rowbase=(long)b*SEQ; const int q0=qb*QB;
  const bf16*Qw=Q+(rowbase+q0+wid*QBLK)*DM+h*D;
  const bf16*Kh=K+(rowbase+(long)t0*KVBLK)*DM+h*D,*Vh=V+(rowbase+(long)t0*KVBLK)*DM+h*D;
  const unsigned lds0=(unsigned)(uintptr_t)shm;
  float*wsf=(float*)(shm+LDS_WS)+wid*64;
  const bf16*ksrc=Kh+(long)lane*DM+wid*8;
  const bf16*vsrc=Vh+(long)(16*(wid&3)+(lane>>2))*DM+(wid>>2)*32+(lane&3)*8;
  const unsigned kdst=lds0+LDS_K+wid*1024, vdst=lds0+LDS_V+wid*1024;
  #define DMA_K(t,slot) glds16(ksrc+(long)(t)*KVBLK*DM,(unsigned)__builtin_amdgcn_readfirstlane(kdst+(slot)))
  #define DMA_V(t,slot) glds16(vsrc+(long)(t)*KVBLK*DM,(unsigned)__builtin_amdgcn_readfirstlane(vdst+(slot)))
  const int vb0=(int)(lds0+LDS_V)+((lane>>4)&1)*32+(lane&3)*8+(4*hi+((lane&15)>>2))*64;
  const char*Kbase=shm+LDS_K; bf16x8 kf[8];
  const lds_cptr shm3=(lds_cptr)shm; const lds_cptr kp0=shm3+LDS_K+hi*1024+r32*16; const lds_cptr vp0=shm3+LDS_V+((lane>>4)&1)*32+(lane&3)*8+(4*hi+((lane&15)>>2))*64;
  const int NT=(q0+QB)/KVBLK-t0;
  DMA_K(0,0);DMA_V(0,0);DMA_K(1,SLOTB);
  bf16x8 qr[4];
  #pragma unroll
  for(int d0=0;d0<4;++d0)qr[d0]=*reinterpret_cast<const bf16x8*>(&Qw[(long)r32*DM+d0*16+hi*8]);
  float mhat=ncum[q0-t0*KVBLK+wid*QBLK+r32],l_reg=0.f;f32x16 o[2];o[0]=f32x16{};o[1]=f32x16{};f32x16 negm; { float z_=-mhat; asm volatile("":"+v"(z_)); _Pragma("unroll") for(int r=0;r<16;++r)negm[r]=z_; } asm volatile("":"+v"(negm));
  const int qrel=wid*QBLK+r32;
  #define CMASK(P0,P1,t) do{int jb_=(t)-(NT-4); if(jb_>=0)cmask(P0,P1,jb_,qrel,hi);}while(0)
  #define CBIAS(P0,P1,t) do{ const __attribute__((address_space(3))) float*cb_=ncum+64*(t)+4*hi; \
    _Pragma("unroll") for(int g4=0;g4<4;++g4){ const f32x4_t b0_=*(const __attribute__((address_space(3))) f32x4_t*)(cb_+8*g4); const f32x4_t b1_=*(const __attribute__((address_space(3))) f32x4_t*)(cb_+32+8*g4); \
      P0[4*g4]+=b0_[0];P0[4*g4+1]+=b0_[1];P0[4*g4+2]+=b0_[2];P0[4*g4+3]+=b0_[3]; P1[4*g4]+=b1_[0];P1[4*g4+1]+=b1_[1];P1[4*g4+2]+=b1_[2];P1[4*g4+3]+=b1_[3]; } }while(0)
  bool resc=false;
  #define START(P0,P1) do{ const float rm=rowmax(P0,P1); resc=false; \
    { const float dl=max2f(rm,0.f); mhat=fadd_s(mhat,dl); \
      _Pragma("unroll") for(int r=0;r<16;++r){P0[r]=fsub_s(P0[r],dl);P1[r]=fsub_s(P1[r],dl);} \
      _Pragma("unroll") for(int r=0;r<16;++r)negm[r]=-mhat; asm volatile("":"+v"(negm)); } \
    _Pragma("unroll") for(int r=0;r<16;++r)P0[r]=__builtin_amdgcn_exp2f(P0[r]); }while(0)
  #define RESC() do{ if(resc){ asm volatile("s_waitcnt lgkmcnt(0)":::"memory"); \
      _Pragma("unroll") for(int d_=0;d_<2;++d_) _Pragma("unroll") for(int r=0;r<16;++r)o[d_][r]*=wsf[crow(r,hi)]; } }while(0)
  f32x16 pA0,pA1,pB0,pB1;
  int sl_prev=0,sl_cur=0,sl_next=SLOTB;
  #define ROT() do{sl_prev=sl_cur;sl_cur=sl_next;sl_next=(sl_next==(NSLOT-1)*SLOTB)?0:sl_next+SLOTB;}while(0)
  DMA_K(2,2*SLOTB);
  WAIT_BAR(3);
  qkt(pA0,pA1,Kbase,qr,negm,r32,hi);asm volatile("s_nop 15\n\ts_nop 7":"+v"(pA0),"+v"(pA1));CBIAS(pA0,pA1,0);CMASK(pA0,pA1,0);
  START(pA0,pA1);
  _Pragma("unroll") for(int r=0;r<16;++r)pA1[r]=__builtin_amdgcn_exp2f(pA1[r]);
  WAIT_BAR(0);
  DMA_K(3,0);DMA_V(1,SLOTB);
  ROT();
  kload8(kf,kp0+sl_cur);
  WAIT_BAR(2);
  s16x4 vlo[8],vhi[8]; u32x4 pw0,pw1,pw2,pw3;
  #define PKW(P,B) cvtpk_s(P[B],P[B+1])
  #define PAF(k) __builtin_bit_cast(bf16x8,pw##k)
  #define VFR(i) (bf16x8){vlo[i][0],vlo[i][1],vlo[i][2],vlo[i][3],vhi[i][0],vhi[i][1],vhi[i][2],vhi[i][3]}
  #define PIN(x) asm volatile("":"+v"(x))
  #define MX3(a,b,c) __builtin_fmaxf(__builtin_fmaxf((a),(b)),(c))
  #define GAPA(MF,A0,A1,A2,A3,W0,W1,PW) do{ MF; sacc+=A0; sacc+=A1; sacc+=A2; sacc+=A3; PIN(sacc); W0; W1; PIN(PW); SBAR(); }while(0)
  #define EX(v) __builtin_amdgcn_exp2f(v)
  #define GAPB(MF,X,B) do{ MF; X[B]=EX(X[B]); X[B+1]=EX(X[B+1]); X[B+2]=EX(X[B+2]); X[B+3]=EX(X[B+3]); PIN(X); SBAR(); }while(0)
  #define VRD(i) do{ vlo[i]=vtr(vp_+(((i)>>2)*4096+((i)&3)*1024)); vhi[i]=vtr(vp_+(((i)>>2)*4096+((i)&3)*1024+512)); }while(0)
  #define KRD(G,j) do{ if(G){ kload2(kf,kp0+sl_next,j); SBAR(); } }while(0)
  #define STEP(C0,C1,P0,P1,t,GK,GV,GL) do{ SBAR(); \
    const lds_cptr vp_=vp0+sl_prev; \
    VRD(0); SBAR(); float sacc=(P0[0]+P0[1]); \
    GAPA(C0=__builtin_amdgcn_mfma_f32_32x32x16_bf16(kf[0],qr[0],negm,0,0,0), P0[2],P0[3],P0[4],P0[5],     pw0[0]=PKW(P0,0), pw0[1]=PKW(P0,2), pw0); \
    VRD(4); SBAR(); GAPA(C1=__builtin_amdgcn_mfma_f32_32x32x16_bf16(kf[1],qr[0],negm,0,0,0), P0[6],P0[7],P0[8],P0[9],     pw0[2]=PKW(P0,4), pw0[3]=PKW(P0,6), pw0); \
    VRD(1); SBAR(); GAPA(C0=__builtin_amdgcn_mfma_f32_32x32x16_bf16(kf[2],qr[1],C0,0,0,0),   P0[10],P0[11],P0[12],P0[13], pw1[0]=PKW(P0,8), pw1[1]=PKW(P0,10), pw1); \
    VRD(5); SBAR(); GAPA(C1=__builtin_amdgcn_mfma_f32_32x32x16_bf16(kf[3],qr[1],C1,0,0,0),   P0[14],P0[15],P1[0],P1[1],   pw1[2]=PKW(P0,12),pw1[3]=PKW(P0,14), pw1); \
    VRD(2); SBAR(); GAPA(C0=__builtin_amdgcn_mfma_f32_32x32x16_bf16(kf[4],qr[2],C0,0,0,0),   P1[2],P1[3],P1[4],P1[5],     pw2[0]=PKW(P1,0), pw2[1]=PKW(P1,2), pw2); \
    VRD(6); SBAR(); GAPA(C1=__builtin_amdgcn_mfma_f32_32x32x16_bf16(kf[5],qr[2],C1,0,0,0),   P1[6],P1[7],P1[8],P1[9],     pw2[2]=PKW(P1,4), pw2[3]=PKW(P1,6), pw2); \
    VRD(3); SBAR(); GAPA(C0=__builtin_amdgcn_mfma_f32_32x32x16_bf16(kf[6],qr[3],C0,0,0,0),   P1[10],P1[11],P1[12],P1[13], pw3[0]=PKW(P1,8), pw3[1]=PKW(P1,10), pw3); \
    VRD(7); SBAR(); GAPA(C1=__builtin_amdgcn_mfma_f32_32x32x16_bf16(kf[7],qr[3],C1,0,0,0),   P1[14],P1[15],0.f,0.f,       pw3[2]=PKW(P1,12),pw3[3]=PKW(P1,14), pw3); \
    l_reg+=sacc; \
    if(GK){DMA_K((t)+3,sl_cur);} if(GV){DMA_V((t)+1,sl_next);} \
    CBIAS(C0,C1,t); CMASK(C0,C1,t); \
    { float a=MX3(C0[0],C0[1],C1[0]),b=MX3(C0[2],C0[3],C1[1]); a=MX3(a,C1[2],C1[3]); \
      _Pragma("unroll") for(int r=4;r<16;r+=4){a=MX3(a,C0[r],C0[r+1]);b=MX3(b,C0[r+2],C0[r+3]);a=MX3(a,C1[r],C1[r+1]);b=MX3(b,C1[r+2],C1[r+3]);} \
      float rm=__builtin_fmaxf(a,b); { auto rr=__builtin_amdgcn_permlane32_swap(__float_as_uint(rm),__float_as_uint(rm),false,false); rm=__builtin_fmaxf(__uint_as_float(rr[0]),__uint_as_float(rr[1])); } \
      resc=false; \
      if(__builtin_expect(__any(rm>(float)THRL),0)){ const float dl=__builtin_fmaxf(rm,0.f); mhat+=dl; \
        _Pragma("unroll") for(int r=0;r<16;++r){C0[r]-=dl;C1[r]-=dl;} \
        _Pragma("unroll") for(int r=0;r<16;++r)negm[r]=-mhat; asm volatile("":"+v"(negm)); \
        const float f=__builtin_amdgcn_exp2f(-dl); l_reg*=f; if(hi==0)wsf[r32]=f; resc=true; } } \
    SBAR(); \
    GAPB(o[0]=__builtin_amdgcn_mfma_f32_32x32x16_bf16(PAF(0),VFR(0),o[0],0,0,0), C0,0); \
    GAPB(o[1]=__builtin_amdgcn_mfma_f32_32x32x16_bf16(PAF(0),VFR(4),o[1],0,0,0), C0,4); \
    KRD(GL,0); GAPB(o[0]=__builtin_amdgcn_mfma_f32_32x32x16_bf16(PAF(1),VFR(1),o[0],0,0,0), C0,8); \
    KRD(GL,1); GAPB(o[1]=__builtin_amdgcn_mfma_f32_32x32x16_bf16(PAF(1),VFR(5),o[1],0,0,0), C0,12); \
    KRD(GL,2); GAPB(o[0]=__builtin_amdgcn_mfma_f32_32x32x16_bf16(PAF(2),VFR(2),o[0],0,0,0), C1,0); \
    KRD(GL,3); GAPB(o[1]=__builtin_amdgcn_mfma_f32_32x32x16_bf16(PAF(2),VFR(6),o[1],0,0,0), C1,4); \
    GAPB(o[0]=__builtin_amdgcn_mfma_f32_32x32x16_bf16(PAF(3),VFR(3),o[0],0,0,0), C1,8); \
    GAPB(o[1]=__builtin_amdgcn_mfma_f32_32x32x16_bf16(PAF(3),VFR(7),o[1],0,0,0), C1,12); \
    }while(0)
  int t=1;
  #undef CMASK
  #define CMASK(P0,P1,t) do{}while(0)
  for(;t+5<NT;t+=2){
    STEP(pB0,pB1,pA0,pA1,t,true,true,true);     WAIT_BAR(2); RESC(); ROT();
    STEP(pA0,pA1,pB0,pB1,t+1,true,true,true);   WAIT_BAR(2); RESC(); ROT();
  }
  #undef CMASK
  #define CMASK(P0,P1,t) do{int jb_=(t)-(NT-4); if(jb_>=0)cmask(P0,P1,jb_,qrel,hi);}while(0)
  #define ENDW(tt) do{ if((tt)+3<NT){WAIT_BAR(2);} else if((tt)+2<NT){WAIT_BAR(1);} else {WAIT_BAR(0);} }while(0)
  for(;t+1<NT;t+=2){
    STEP(pB0,pB1,pA0,pA1,t,(t+3<NT),(t+1<NT),(t+1<NT));       ENDW(t);   RESC(); ROT();
    STEP(pA0,pA1,pB0,pB1,t+1,(t+4<NT),(t+2<NT),(t+2<NT));     ENDW(t+1); RESC(); ROT();
  }
  STEP(pB0,pB1,pA0,pA1,NT-1,false,false,false); RESC();
  { float sacc=pB0[0]+pB0[1]; _Pragma("unroll") for(int r=2;r<16;++r)sacc+=pB0[r]; _Pragma("unroll") for(int r=0;r<16;++r)sacc+=pB1[r]; l_reg+=sacc;
    pw0=(u32x4){PKW(pB0,0),PKW(pB0,2),PKW(pB0,4),PKW(pB0,6)};pw1=(u32x4){PKW(pB0,8),PKW(pB0,10),PKW(pB0,12),PKW(pB0,14)};pw2=(u32x4){PKW(pB1,0),PKW(pB1,2),PKW(pB1,4),PKW(pB1,6)};pw3=(u32x4){PKW(pB1,8),PKW(pB1,10),PKW(pB1,12),PKW(pB1,14)};
    SBAR(); pv(o,vb0+sl_cur,PAF(0),PAF(1),PAF(2),PAF(3)); }
  #undef PKW
  #undef PAF
  #undef VFR
  #undef PIN
  #undef MX3
  #undef GAPA
  #undef GAPB
  #undef EX
  #undef VRD
  #undef KRD
  #undef STEP
  #undef ENDW
  {auto rr=__builtin_amdgcn_permlane32_swap(__float_as_uint(l_reg),__float_as_uint(l_reg),false,false);l_reg=__uint_as_float(rr[0])+__uint_as_float(rr[1]);}
  if(hi==0)wsf[32+r32]=l_reg;asm volatile("s_waitcnt lgkmcnt(0)":::"memory");
  float rli[16];
  #pragma unroll
  for(int r=0;r<16;++r)rli[r]=__builtin_amdgcn_rcpf(wsf[32+crow(r,hi)]);
  bf16*Ow=O+(rowbase+q0+wid*QBLK)*DM+h*D;
  { bf16*stg=(bf16*)(shm+LDS_OST)+wid*2048;
    #pragma unroll
    for(int r=0;r<16;++r){const int orow=crow(r,hi);
      #pragma unroll
      for(int d0=0;d0<2;++d0)stg[orow*64+d0*32+r32]=__float2bfloat16(o[d0][r]*rli[r]);}
    asm volatile("s_waitcnt lgkmcnt(0)":::"memory");
    #pragma unroll
    for(int i=0;i<4;++i){const int row=i*8+(lane>>3),ch=lane&7; const u32x4 v=*(const u32x4*)(stg+row*64+ch*8); ATTN_STORE16(Ow+(long)row*DM+ch*8,v);} }
  asm volatile("s_waitcnt lgkmcnt(0)\n\ts_barrier":::"memory");
  #undef DMA_K
  #undef DMA_V
  #undef CMASK
  #undef CBIAS
  #undef START
  #undef RESC
  #undef ROT
}
constexpr int ATTN_LDS_BYTES=LDS_BYTES;
struct AttnTensors { const bf16* Q; const bf16* K; const bf16* V; bf16* O; };
__device__ __forceinline__ void fox_phase(char*lds,const bf16*Q,const bf16*K,const bf16*V,bf16*O,const float*CUM,const float*qg,const float*kg,int grid,int block){
  const int vcu=(grid%8==0)?(block%8)*(grid/8)+block/8:block; const int bh=vcu>>2, s=vcu&3;
  if(bh>=BATCH*NHEAD)return;
  float*nc=(float*)(lds+98304);
  for(int i=threadIdx.x;i<SEQ;i+=512)nc[i]=CUM[(size_t)bh*SEQ+i];
  const int lane=threadIdx.x&63;
  float gq=fabsf(qg[lane]),gk=fabsf(kg[lane]);
  #pragma unroll
  for(int o=1;o<64;o<<=1){gq=fmaxf(gq,__shfl_xor(gq,o));gk=fmaxf(gk,__shfl_xor(gk,o));}
  const float thresh=2.0f*(8.0f*gq*C2)*(8.0f*gk)*1.02f+40.0f;
  __syncthreads();
  const __attribute__((address_space(3))) float*ncum=(const __attribute__((address_space(3))) float*)(nc);
  for(int i=0;i<4;++i){ const int qb=(i==0)?s:(i==1)?7-s:(i==2)?8+s:15-s; const int NTf=4*qb+4;
    const bool ok=(lane<NTf-4)&&(ncum[qb*QB]-ncum[64*lane+63]>=thresh);
    int t0=__builtin_popcountll(__ballot(ok))&~1; t0=__builtin_amdgcn_readfirstlane(t0);
    attn_unit<8>(bh/NHEAD,bh%NHEAD,qb,t0,Q,K,V,O,lds,ncum+64*t0); }
}
template<int R> __device__ __forceinline__ void dil_unit(int g,int b,int j,int nb,int hp,const bf16*Q,const bf16*__restrict__ K,const bf16*__restrict__ V,const float*__restrict__ BIASV,bf16*ORUN,float*LSE,char*shm,char*aux){
  typedef __attribute__((address_space(3))) char* lptr;
  int tid_=threadIdx.x; asm volatile("":"+v"(tid_)); const int tid=tid_,lane=tid&63,r32=lane&31,hi=lane>>5; const int wid=__builtin_amdgcn_readfirstlane(tid>>6);
  const int hl=wid>>2,qs=wid&3,h=2*hp+hl;
  const unsigned lds0=(unsigned)(uintptr_t)shm;
  float*bvl=(float*)aux;
  float*wsf=(float*)(aux+2048)+wid*64;
  const long rowbase=(long)b*SEQ;
  { const int wv=tid>>6, rowK=(lane&15)+16*(wv&3), chK=(lane>>4)+4*(wv>>2), rowV=(lane>>2)+16*(wv&3), chV=(lane&3)+4*(wv>>2); u32x4 val[16];
    #pragma unroll
    for(int it=0;it<16;++it){ const int kt=it&3,kv=(it>>2)&1,hh=it>>3; val[it]=(u32x4){0u,0u,0u,0u}; const int row=kv?rowV:rowK, ch=kv?chV:chK;
      if(nb>0||kt>=2){ const int kp=nb*128-128+kt*64+row; const bf16*src=(kv?V:K)+(rowbase+(long)kp*R+j)*DM+(2*hp+hh)*D+ch*8; val[it]=*reinterpret_cast<const u32x4*>(src); } }
    { const int hh=tid>>8, x=tid&255, dd=x-64; bvl[hh*256+x]=(dd>=0&&dd<=128)?BIASV[(g*16+2*hp+hh)*132+dd]:-1e30f; }
    #pragma unroll
    for(int it=0;it<16;++it){ const int kt=it&3,kv=(it>>2)&1,hh=it>>3; const int row=kv?rowV:rowK, ch=kv?chV:chK;
      const int off=hh*65536+kv*32768+kt*8192+(kv?((ch>>2)*4096+row*64+(ch&3)*16):(ch*1024+row*16));
      if(nb>0||kt>=2||kv) *reinterpret_cast<__attribute__((address_space(3))) u32x4*>((lptr)shm+off)=val[it]; }
  }
  const int p0q=nb*128+32*qs;
  const bf16*Qw=Q+(rowbase+(long)(p0q+r32)*R+j)*DM+h*D;
  bf16x8 qr[4];
  #pragma unroll
  for(int d0=0;d0<4;++d0)qr[d0]=*reinterpret_cast<const bf16x8*>(&Qw[d0*16+hi*8]);
  const long orow=rowbase+(long)(p0q+r32)*R+j;
  float lr_old=0.f; u32x4 ov_old[4];
  #pragma unroll
  for(int i=0;i<4;++i)ov_old[i]=(u32x4){0u,0u,0u,0u};
  if(g>0){ lr_old=LSE[orow*16+h];
    #pragma unroll
    for(int i=0;i<4;++i){const int row=i*8+(lane>>3),ch=lane&7; ov_old[i]=*(const u32x4*)(ORUN+(rowbase+(long)(p0q+row)*R+j)*DM+h*D+ch*8);} }
  asm volatile("s_waitcnt vmcnt(0) lgkmcnt(0)\n\ts_barrier":::"memory");
  const int ktlo=(qs>=2)?1:0;
  const char*Kh=shm+hl*65536;
  const __attribute__((address_space(3))) float*eb=(const __attribute__((address_space(3))) float*)((lptr)aux)+hl*256+(32*qs+128-64*ktlo)+r32-4*hi-123;
  f32x16 s0[3],s1[3];
  #pragma unroll
  for(int i=0;i<3;++i){ const int kt=ktlo+i; f32x16 z=f32x16{};
    qkt(s0[i],s1[i],Kh+kt*8192,qr,z,r32,hi);
    if(nb==0&&kt<2){
      #pragma unroll
      for(int r=0;r<16;++r){s0[i][r]=-1e30f;s1[i][r]=-1e30f;} }
    else {
      #pragma unroll
      for(int r=0;r<16;++r){ const int c=(r&3)+8*(r>>2); s0[i][r]+=eb[59-c+128-64*i]; s1[i][r]+=eb[59-c-32+128-64*i]; } } }
  float mx=-1e30f;
  #pragma unroll
  for(int i=0;i<3;++i)
    #pragma unroll
    for(int r=0;r<16;++r)mx=fmaxf(mx,fmaxf(s0[i][r],s1[i][r]));
  { auto rr=__builtin_amdgcn_permlane32_swap(__float_as_uint(mx),__float_as_uint(mx),false,false); mx=fmaxf(__uint_as_float(rr[0]),__uint_as_float(rr[1])); }
  float l=0.f;
  #pragma unroll
  for(int i=0;i<3;++i)
    #pragma unroll
    for(int r=0;r<16;++r){ s0[i][r]=__builtin_amdgcn_exp2f(s0[i][r]-mx); s1[i][r]=__builtin_amdgcn_exp2f(s1[i][r]-mx); l+=s0[i][r]+s1[i][r]; }
  { auto rr=__builtin_amdgcn_permlane32_swap(__float_as_uint(l),__float_as_uint(l),false,false); l=__uint_as_float(rr[0])+__uint_as_float(rr[1]); }
  f32x16 o[2]; o[0]=f32x16{}; o[1]=f32x16{};
  const int vb0=(int)lds0+hl*65536+32768+((lane>>4)&1)*32+(lane&3)*8+(4*hi+((lane&15)>>2))*64;
  #define PKW(P,B) cvtpk_s(P[B],P[B+1])
  #pragma unroll
  for(int i=0;i<3;++i){ const int kt=ktlo+i;
    const u32x4 pw0=(u32x4){PKW(s0[i],0),PKW(s0[i],2),PKW(s0[i],4),PKW(s0[i],6)},pw1=(u32x4){PKW(s0[i],8),PKW(s0[i],10),PKW(s0[i],12),PKW(s0[i],14)};
    const u32x4 pw2=(u32x4){PKW(s1[i],0),PKW(s1[i],2),PKW(s1[i],4),PKW(s1[i],6)},pw3=(u32x4){PKW(s1[i],8),PKW(s1[i],10),PKW(s1[i],12),PKW(s1[i],14)};
    pv(o,vb0+kt*8192,__builtin_bit_cast(bf16x8,pw0),__builtin_bit_cast(bf16x8,pw1),__builtin_bit_cast(bf16x8,pw2),__builtin_bit_cast(bf16x8,pw3)); }
  #undef PKW
  float lse=mx*0.6931471805599453f+__logf(l), a=1.0f/l, bco=0.f;
  if(g>0){ const float lr=lr_old; const float mxl=fmaxf(lr,lse), nl=mxl+__logf(__expf(lr-mxl)+__expf(lse-mxl)); a=__expf(lse-nl)/l; bco=__expf(lr-nl); lse=nl; }
  if(hi==0){ wsf[r32]=a; wsf[32+r32]=bco; LSE[orow*16+h]=lse; }
  asm volatile("s_waitcnt lgkmcnt(0)\n\ts_barrier":::"memory");
  float av[16];
  #pragma unroll
  for(int r=0;r<16;++r)av[r]=wsf[crow(r,hi)];
  { bf16*stg=(bf16*)(shm)+wid*2048;
    #pragma unroll
    for(int r=0;r<16;++r){const int orw=crow(r,hi);
      #pragma unroll
      for(int d0=0;d0<2;++d0)stg[orw*64+d0*32+r32]=__float2bfloat16(o[d0][r]*av[r]);}
    asm volatile("s_waitcnt lgkmcnt(0)":::"memory");
    #pragma unroll
    for(int i=0;i<4;++i){const int row=i*8+(lane>>3),ch=lane&7; u32x4 v=*(const u32x4*)(stg+row*64+ch*8);
      bf16*dst=ORUN+(rowbase+(long)(p0q+row)*R+j)*DM+h*D+ch*8;
      if(g>0){ const float bc=wsf[32+row]; const u32x4 ov=ov_old[i]; u32x4 w;
        #pragma unroll
        for(int q=0;q<4;++q){ const float n0=__uint_as_float(v[q]<<16)+bc*__uint_as_float(ov[q]<<16), n1=__uint_as_float(v[q]&0xffff0000u)+bc*__uint_as_float(ov[q]&0xffff0000u); w[q]=cvtpk_s(n0,n1); }
        v=w; }
      *(u32x4*)dst=v; } }
  asm volatile("s_waitcnt lgkmcnt(0)\n\ts_barrier":::"memory");
}
template<int R> __device__ __forceinline__ void dil_phase(int g,char*lds,char*aux,const bf16*Q,const bf16*K,const bf16*V,const float*BIASV,bf16*ORUN,float*LSE,int grid,int block){
  constexpr int NBK=32/R;
  for(int L=block;L<1024;L+=grid){ const int hp=L&7,rest=L>>3,nb=rest%NBK,z=rest/NBK; dil_unit<R>(g,z/R,z%R,nb,hp,Q,K,V,BIASV,ORUN,LSE,lds,aux); }
}
#undef SBAR
#undef WAIT_BAR
}

__device__ __forceinline__ LAS int* moe_tables(Frame& F, int layer, bool combo) {
    LAS int* tab = (LAS int*)(F.lds + LDSCTL_OFF + 1024);
    if (F.tid == 0) { const int nl = combo ? 24 : 16; int run = 0;
        for (int k = 0; k < nl; ++k) { const int c = (int)__hip_atomic_load(F.ctl + CW_CNT + (layer * 40 + (combo ? 16 : 0) + k) * 64, RLX_AGENT); tab[k] = run; tab[32 + k] = c; run += (c + 255) >> 8; }
        tab[nl] = run; }
    __syncthreads();
    return tab;
}

#define MOE_PHASES(layer, P1, P2) \
    PHASE(P1) { LAS int* tab = moe_tables(F, layer, false); \
        pg8::MoeOrder S{F.G, (int)blockIdx.x, 16, 2, 16, 1, (const char*)(F.ws + WS_HM), (const char*)(F.ws + WS_MOE1 + (size_t)(layer) * 16 * 512 * 1024 * 2), (const int*)(F.ws + WS_ELIST), tab}; \
        pg8::EpiMoe1 E{(const int*)(F.ws + WS_ELIST), (const v4u*)(F.ws + WS_TOKREC), (bf16*)(F.ws + WS_HID2)}; \
        pg8::gemm_phase<pg8::EpiMoe1, pg8::MoeOrder, true, true>(F.lds + RING_OFF, 1024, 1024, 1024, S, E); SEAM(P1); } \
    PHASE(P2) { LAS int* tab = moe_tables(F, layer, true); \
        pg8::MoeOrder S{F.G, (int)blockIdx.x, 24, 4, 4, 2, (const char*)(F.ws + WS_HID2), (const char*)(F.ws + WS_MOE2 + (size_t)(layer) * 16 * 1024 * 256 * 2), (const int*)(F.ws + WS_CLIST), tab}; \
        pg8::EpiMoe2 E{(const int*)(F.ws + WS_CLIST), F.out, (const float*)(F.ws + WS_MOD) + (size_t)(layer) * 4 * 6144 + 5 * D, (F.flags & 1) ? 0.5f : 1.0f}; \
        pg8::gemm_phase<pg8::EpiMoe2, pg8::MoeOrder, true, true>(F.lds + RING_OFF, 512, 256, 512, S, E); SEAM(P2); }

__global__ void __launch_bounds__(NWAVES * 64, 2) mk_fwd(Args args) {
    extern __shared__ __attribute__((aligned(16))) unsigned char lds[];
    Frame F;
    F.lds = (LAS unsigned char*)lds;
    F.MISC = (volatile LAS unsigned*)(F.lds + MISC_OFF);
    F.tid = threadIdx.x; F.lane = F.tid & 63; F.wave = __builtin_amdgcn_readfirstlane(F.tid >> 6);
    F.G = gridDim.x; { const int bx = blockIdx.x; F.vcu = (F.G % 8 == 0) ? (bx % 8) * (F.G / 8) + bx / 8 : bx; }
    F.ws = args.ws; F.ctl = (gu32*)(args.ws + WS_CTL); F.in = args.in; F.out = args.out; F.flags = args.flags;
    for (int u = F.tid; u < (LDS_BYTES - LDSCTL_OFF) / 4; u += NWAVES * 64) ((LAS unsigned*)(F.lds + LDSCTL_OFF))[u] = 0u;
    __syncthreads();
    XcdBarrier bar; bar.bar = (unsigned*)(F.ctl + CW_BAR); bar.x = 0; bar.st = nullptr;
    if (MK_MODE == 0) bar = xcd_barrier_post((unsigned*)(F.ctl + CW_BAR), F.MISC + 8);
    const int lo = args.ph_lo, hi = args.ph_hi;
#define IN(k) (lo <= (k) && (k) < hi && frame_refresh(F))
#define PHASE(k) if (IN(k)) for (int rep_ = 0; rep_ < ((((DUP_MASK) >> (k)) & 1u) ? 2 : 1); ++rep_)
#define SEAM(k) do { if (MK_MODE == 0 && lo <= (k) + 1 && (k) + 1 < hi) xcd_barrier(bar); } while (0)

    PHASE(PH_PRO) { p0_prologue(F); SEAM(PH_PRO); }
    PHASE(PH_ROW_A) { rowpass<0>(F, F.in[I_X], F.in[I_NMIX], 0, 0, 1); SEAM(PH_ROW_A); }
    {
#pragma unroll
        for (int g = 0; g < 3; ++g) {
            PHASE(PH_QKV_A0 + 2 * g) {
                pg8::StaticOrder S; S.init(M, 3072, F.G, (int)blockIdx.x, F.ws + WS_HM, 1024, F.ws + WS_WAIN + (size_t)g * 3072 * 1024 * 2, 1024, 16);
                pg8::EpiQKV E{(bf16*)(F.ws + WS_Q), F.in[I_AQN], F.in[I_AKN]};
                pg8::gemm_phase<pg8::EpiQKV, pg8::StaticOrder, false, true>(F.lds + RING_OFF, 1024, 1024, 1024, S, E);
                SEAM(PH_QKV_A0 + 2 * g);
            }
            PHASE(PH_ATT_A0 + 2 * g) {
                typedef attn_body::bf16 ab16;
                if (g == 0) attn_body::dil_phase<1>(0, (char*)lds + RING_OFF, (char*)lds + LDSCTL_OFF + 2048, (const ab16*)(F.ws + WS_Q), (const ab16*)(F.ws + WS_K), (const ab16*)(F.ws + WS_V), (const float*)(F.ws + WS_BIASV), (ab16*)(F.ws + WS_ORUN), (float*)(F.ws + WS_LSE), F.G, (int)blockIdx.x);
                if (g == 1) attn_body::dil_phase<4>(1, (char*)lds + RING_OFF, (char*)lds + LDSCTL_OFF + 2048, (const ab16*)(F.ws + WS_Q), (const ab16*)(F.ws + WS_K), (const ab16*)(F.ws + WS_V), (const float*)(F.ws + WS_BIASV), (ab16*)(F.ws + WS_ORUN), (float*)(F.ws + WS_LSE), F.G, (int)blockIdx.x);
                if (g == 2) attn_body::dil_phase<16>(2, (char*)lds + RING_OFF, (char*)lds + LDSCTL_OFF + 2048, (const ab16*)(F.ws + WS_Q), (const ab16*)(F.ws + WS_K), (const ab16*)(F.ws + WS_V), (const float*)(F.ws + WS_BIASV), (ab16*)(F.ws + WS_ORUN), (float*)(F.ws + WS_LSE), F.G, (int)blockIdx.x);
                SEAM(PH_ATT_A0 + 2 * g);
            }
        }
    }
    PHASE(PH_OUT_A) {
        pg8::StaticOrder S; S.init(M, 1024, F.G, (int)blockIdx.x, F.ws + WS_ORUN, 1024, F.ws + WS_WAOUT, 1024, 16);
        pg8::EpiOut E{F.in[I_X], F.out, (const float*)(F.ws + WS_MOD) + 2 * D};
        pg8::gemm_phase<pg8::EpiOut, pg8::StaticOrder, false, false>(F.lds + RING_OFF, 1024, 1024, 1024, S, E);
        SEAM(PH_OUT_A);
    }
    PHASE(PH_ROW_F0) { rowpass<2>(F, F.out, F.in[I_NFFN], 0, 3, 4); SEAM(PH_ROW_F0); }
    MOE_PHASES(0, PH_MOE1_0, PH_MOE2_0)
    PHASE(PH_ROW_B) { rowpass<1>(F, F.out, F.in[I_NMIX] + D, 1, 0, 1); SEAM(PH_ROW_B); }
    PHASE(PH_CUM) { cumsum_phase(F); }
    PHASE(PH_QKV_B) {
        pg8::StaticOrder S; S.init(M, 3072, F.G, (int)blockIdx.x, F.ws + WS_HM, 1024, F.ws + WS_WBIN, 1024, 16);
        pg8::EpiQKV E{(bf16*)(F.ws + WS_Q), F.in[I_BQN], F.in[I_BKN]};
        pg8::gemm_phase<pg8::EpiQKV, pg8::StaticOrder, false, true>(F.lds + RING_OFF, 1024, 1024, 1024, S, E);
        SEAM(PH_QKV_B);
    }
    PHASE(PH_ATT_B) {
        typedef attn_body::bf16 ab16;
        attn_body::fox_phase((char*)lds + RING_OFF, (const ab16*)(F.ws + WS_Q), (const ab16*)(F.ws + WS_K), (const ab16*)(F.ws + WS_V), (ab16*)(F.ws + WS_ORUN), (const float*)(F.ws + WS_CUM), F.in[I_BQN], F.in[I_BKN], F.G, (int)blockIdx.x);
        SEAM(PH_ATT_B);
    }
    PHASE(PH_OUT_B) {
        pg8::StaticOrder S; S.init(M, 1024, F.G, (int)blockIdx.x, F.ws + WS_ORUN, 1024, F.ws + WS_WBOUT, 1024, 16);
        pg8::EpiOut E{F.out, F.out, (const float*)(F.ws + WS_MOD) + (size_t)4 * 6144 + 2 * D};
        pg8::gemm_phase<pg8::EpiOut, pg8::StaticOrder, false, false>(F.lds + RING_OFF, 1024, 1024, 1024, S, E);
        SEAM(PH_OUT_B);
    }
    PHASE(PH_ROW_F1) { rowpass<2>(F, F.out, F.in[I_NFFN] + D, 1, 3, 4); SEAM(PH_ROW_F1); }
    MOE_PHASES(1, PH_MOE1_1, PH_MOE2_1)
#undef IN
#undef PHASE
#undef SEAM
}

__global__ void __launch_bounds__(256) nk_qkv(const bf16* __restrict__ A, const float* __restrict__ W, int ldw, int col0, const float* __restrict__ qg, const float* __restrict__ kg,
                                              bf16* Qo, bf16* Ko, bf16* Vo) {
    const long gw = ((long)blockIdx.x * blockDim.x + threadIdx.x) >> 6; const int lane = threadIdx.x & 63;
    if (gw >= (long)M * 48) return;
    const int m = (int)(gw / 48), ch = (int)(gw % 48), t = ch / 16, h = ch % 16;
    const bf16* a = A + (size_t)m * D; const float* w = W + col0 + ch * 64 + lane;
    float acc = 0.f;
    for (int k = 0; k < D; ++k) acc += bf2f(a[k]) * w[(size_t)k * ldw];
    if (t < 2) { const float ss = wave_sum(acc * acc) * (1.f / 64.f); const float g = (t == 0 ? qg : kg)[lane]; acc = acc * (1.0f / sqrtf(ss + EPS)) * g; if (t == 0) acc *= C2; }
    bf16* o = (t == 0 ? Qo : (t == 1 ? Ko : Vo)); o[(size_t)m * D + h * 64 + lane] = (bf16)f2bf(acc);
}
__global__ void __launch_bounds__(256) nk_out(const bf16* __restrict__ A, const float* __restrict__ W, const float* xin, const float* __restrict__ gvec, float* xout) {
    const long gw = ((long)blockIdx.x * blockDim.x + threadIdx.x) >> 6; const int lane = threadIdx.x & 63;
    if (gw >= (long)M * 16) return;
    const int m = (int)(gw / 16), c = (int)(gw % 16) * 64 + lane, b = m / SEQ;
    const bf16* a = A + (size_t)m * D; float acc = 0.f;
    for (int k = 0; k < D; ++k) acc += bf2f(a[k]) * W[(size_t)k * D + c];
    xout[(size_t)m * D + c] = xin[(size_t)m * D + c] + gvec[(size_t)b * 6144 + c] * acc;
}
__global__ void __launch_bounds__(256) nk_moe1(const bf16* __restrict__ HF, const v4u* __restrict__ tokrec, const float* __restrict__ Wg, const float* __restrict__ Wu, bf16* HID2) {
    const long gw = ((long)blockIdx.x * blockDim.x + threadIdx.x) >> 6; const int lane = threadIdx.x & 63;
    if (gw >= (long)M * 8) return;
    const int m = (int)(gw / 8), rest = (int)(gw % 8), slot = rest / 4, f = (rest % 4) * 64 + lane;
    const v4u rec = tokrec[m]; const int e = slot ? (rec.x >> 8) & 0xff : rec.x & 0xff; const float w = __uint_as_float(slot ? rec.z : rec.y);
    const bf16* a = HF + (size_t)m * D; const float* wg = Wg + (size_t)e * D * FF + f; const float* wu = Wu + (size_t)e * D * FF + f;
    float g = 0.f, u = 0.f;
    for (int k = 0; k < D; ++k) { const float av = bf2f(a[k]); g += av * wg[(size_t)k * FF]; u += av * wu[(size_t)k * FF]; }
    HID2[(size_t)m * 512 + slot * 256 + f] = (bf16)f2bf(g / (1.0f + expf(-g)) * u * w);
}
__global__ void __launch_bounds__(256) nk_moe2(const bf16* __restrict__ HID2, const v4u* __restrict__ tokrec, const float* __restrict__ Wd, const float* __restrict__ gvec, float* x) {
    const long gw = ((long)blockIdx.x * blockDim.x + threadIdx.x) >> 6; const int lane = threadIdx.x & 63;
    if (gw >= (long)M * 16) return;
    const int m = (int)(gw / 16), c = (int)(gw % 16) * 64 + lane, b = m / SEQ;
    const v4u rec = tokrec[m]; float y = 0.f;
    for (int slot = 0; slot < 2; ++slot) { const int e = slot ? (rec.x >> 8) & 0xff : rec.x & 0xff;
        const bf16* a = HID2 + (size_t)m * 512 + slot * 256; const float* wd = Wd + (size_t)e * FF * D + c;
        for (int f = 0; f < FF; ++f) y += bf2f(a[f]) * wd[(size_t)f * D]; }
    x[(size_t)m * D + c] += gvec[(size_t)b * 6144 + c] * y;
}
__global__ void __launch_bounds__(256) nk_attnA(int g, const bf16* __restrict__ Q, const bf16* __restrict__ K, const bf16* __restrict__ V, const float* __restrict__ biasv, bf16* ORUN, float* LSE) {
    const long gw = ((long)blockIdx.x * blockDim.x + threadIdx.x) >> 6; const int lane = threadIdx.x & 63;
    if (gw >= (long)M * 16) return;
    const int m = (int)(gw / 16), h = (int)(gw % 16), b = m / SEQ, t = m % SEQ, r = dil_of(g);
    const bf16* q = Q + (size_t)m * D + h * 64;
    float s[3]; bool ok[3];
#pragma unroll
    for (int i = 0; i < 3; ++i) { const int mm = lane + 64 * i; ok[i] = (mm <= 128) && (t - mm * r >= 0); s[i] = -1e30f;
        if (ok[i]) { const bf16* k = K + ((size_t)b * SEQ + (t - mm * r)) * D + h * 64; float d = 0.f;
            for (int dd = 0; dd < 64; ++dd) d += bf2f(q[dd]) * bf2f(k[dd]);
            s[i] = d + biasv[(g * 16 + h) * BV_PITCH + mm]; } }
    const float mx = wave_max(fmaxf(s[0], fmaxf(s[1], s[2])));
    float p[3]; float l = 0.f;
#pragma unroll
    for (int i = 0; i < 3; ++i) { p[i] = ok[i] ? exp2f(s[i] - mx) : 0.f; l += p[i]; }
    l = wave_sum(l);
    float o = 0.f;
#pragma unroll
    for (int i = 0; i < 3; ++i) for (int j = 0; j < 64; ++j) { const int mm = j + 64 * i; const float pj = __shfl(p[i], j);
        if (mm <= 128 && t - mm * r >= 0) o += pj * bf2f(V[((size_t)b * SEQ + (t - mm * r)) * D + h * 64 + lane]); }
    o /= l; float lse = mx * LN2 + logf(l);
    if (g > 0) { const float lr = LSE[(size_t)m * 16 + h], orun = bf2f(ORUN[(size_t)m * D + h * 64 + lane]);
        const float mxl = fmaxf(lr, lse), nl = mxl + logf(expf(lr - mxl) + expf(lse - mxl));
        o = expf(lr - nl) * orun + expf(lse - nl) * o; lse = nl; }
    ORUN[(size_t)m * D + h * 64 + lane] = (bf16)f2bf(o);
    if (lane == 0) LSE[(size_t)m * 16 + h] = lse;
}
__global__ void __launch_bounds__(256) nk_attnB(const bf16* __restrict__ Q, const bf16* __restrict__ K, const bf16* __restrict__ V, const float* __restrict__ CUM, bf16* O) {
    const long gw = ((long)blockIdx.x * blockDim.x + threadIdx.x) >> 6; const int lane = threadIdx.x & 63;
    if (gw >= (long)M * 16) return;
    const int m = (int)(gw / 16), h = (int)(gw % 16), b = m / SEQ, t = m % SEQ;
    const bf16* q = Q + (size_t)m * D + h * 64; const float* cum = CUM + (size_t)(b * 16 + h) * SEQ;
    float qv[64];
#pragma unroll
    for (int dd = 0; dd < 64; ++dd) qv[dd] = bf2f(q[dd]);
    const int nch = t / 64 + 1;
    float mx = -1e30f;
    for (int ch = 0; ch < nch; ++ch) { const int sidx = ch * 64 + lane;
        if (sidx <= t) { const bf16* k = K + ((size_t)b * SEQ + sidx) * D + h * 64; float d = 0.f;
#pragma unroll
            for (int dd = 0; dd < 64; ++dd) d += qv[dd] * bf2f(k[dd]);
            mx = fmaxf(mx, d + cum[sidx]); } }
    mx = wave_max(mx);
    float l = 0.f, o = 0.f;
    for (int ch = 0; ch < nch; ++ch) { const int sidx = ch * 64 + lane; float p = 0.f;
        if (sidx <= t) { const bf16* k = K + ((size_t)b * SEQ + sidx) * D + h * 64; float d = 0.f;
#pragma unroll
            for (int dd = 0; dd < 64; ++dd) d += qv[dd] * bf2f(k[dd]);
            p = exp2f(d + cum[sidx] - mx); }
        l += p;
        const int jn = (t - ch * 64 + 1) < 64 ? (t - ch * 64 + 1) : 64;
        for (int j = 0; j < jn; ++j) o += __shfl(p, j) * bf2f(V[((size_t)b * SEQ + ch * 64 + j) * D + h * 64 + lane]); }
    l = wave_sum(l);
    O[(size_t)m * D + h * 64 + lane] = (bf16)f2bf(o / l);
}

static void launch_mk(const Args& a0, int lo, int hi, int grid, hipStream_t stream, int flags = 0) {
    Args a = a0; a.ph_lo = lo; a.ph_hi = hi; a.flags = flags;
    hipLaunchKernelGGL(mk_fwd, dim3(grid), dim3(NWAVES * 64), LDS_BYTES, stream, a);
}
extern "C" void kernel_launch(void* const* d_in, const int* in_sizes, int n_in, void* d_out, int out_size, void* d_ws, size_t ws_size, hipStream_t stream) {
    static int grid = 0;
    if (grid == 0) {
        if (n_in != 23 || in_sizes[0] != M * D || out_size != M * D || ws_size < WS_END) { fprintf(stderr, "kernel_launch: unexpected shapes (n_in %d, in0 %d, out %d, ws %zu)\n", n_in, n_in > 0 ? in_sizes[0] : -1, out_size, ws_size); grid = -1; return; }
        int dev = 0, cus = 0;
        if (hipGetDevice(&dev) != hipSuccess || hipDeviceGetAttribute(&cus, hipDeviceAttributeMultiprocessorCount, dev) != hipSuccess) { grid = -1; return; }
        if (hipFuncSetAttribute((const void*)mk_fwd, hipFuncAttributeMaxDynamicSharedMemorySize, LDS_BYTES) != hipSuccess) { fprintf(stderr, "kernel_launch: hipFuncSetAttribute failed\n"); grid = -1; return; }
        int per_cu = 0;
        if (hipOccupancyMaxActiveBlocksPerMultiprocessor(&per_cu, (const void*)mk_fwd, NWAVES * 64, LDS_BYTES) != hipSuccess || per_cu < 1) fprintf(stderr, "kernel_launch: occupancy query reports %d\n", per_cu);
        (void)hipGetLastError();
        grid = cus;
    }
    if (grid < 0) return;
    if (hipMemsetAsync((char*)d_ws + WS_CTL, 0, CTL_ZERO_BYTES, stream) != hipSuccess) return;
    Args a{};
    for (int i = 0; i < 23; ++i) a.in[i] = (const float*)d_in[i];
    a.out = (float*)d_out; a.ws = (unsigned char*)d_ws;
#if MK_MODE == 0
    launch_mk(a, 0, NPH, grid, stream);
#else
    unsigned char* ws = (unsigned char*)d_ws;
    const float* const* in = a.in;
    bf16 *HM = (bf16*)(ws + WS_HM), *Qb = (bf16*)(ws + WS_Q), *Kb = (bf16*)(ws + WS_K), *Vb = (bf16*)(ws + WS_V), *OR = (bf16*)(ws + WS_ORUN), *HID2 = (bf16*)(ws + WS_HID2);
    float *MOD = (float*)(ws + WS_MOD), *LSE = (float*)(ws + WS_LSE), *BV = (float*)(ws + WS_BIASV), *CUM = (float*)(ws + WS_CUM);
    const v4u* TR = (const v4u*)(ws + WS_TOKREC);
    float* out = (float*)d_out;
    for (int ph = 0; ph < NPH; ++ph) {
        if (!((NAIVE_MASK >> ph) & 1u)) {
            const bool dup = (HOST_DUP_MASK >> ph) & 1u, moe2 = (ph == PH_MOE2_0 || ph == PH_MOE2_1), rowf = (ph == PH_ROW_F0 || ph == PH_ROW_F1);
            if (dup) launch_mk(a, ph, ph + 1, grid, stream, moe2 ? 1 : (rowf ? 2 : 0));
            launch_mk(a, ph, ph + 1, grid, stream, (dup && moe2) ? 1 : 0); continue; }
        switch (ph) {
            case PH_QKV_A0: case PH_QKV_A1: case PH_QKV_A2: { const int g = (ph - PH_QKV_A0) / 2;
                hipLaunchKernelGGL(nk_qkv, dim3(M * 48 / 4), dim3(256), 0, stream, HM, in[I_AWIN], 9216, g * 3072, in[I_AQN], in[I_AKN], Qb, Kb, Vb); break; }
            case PH_ATT_A0: case PH_ATT_A1: case PH_ATT_A2: { const int g = (ph - PH_ATT_A0) / 2;
                hipLaunchKernelGGL(nk_attnA, dim3(M * 16 / 4), dim3(256), 0, stream, g, Qb, Kb, Vb, BV, OR, LSE); break; }
            case PH_OUT_A: hipLaunchKernelGGL(nk_out, dim3(M * 16 / 4), dim3(256), 0, stream, OR, in[I_AWOUT], in[I_X], MOD + 2 * D, out); break;
            case PH_MOE1_0: hipLaunchKernelGGL(nk_moe1, dim3(M * 8 / 4), dim3(256), 0, stream, HM, TR, in[I_WG], in[I_WU], HID2); break;
            case PH_MOE2_0: hipLaunchKernelGGL(nk_moe2, dim3(M * 16 / 4), dim3(256), 0, stream, HID2, TR, in[I_WD], MOD + 5 * D, out); break;
            case PH_QKV_B: hipLaunchKernelGGL(nk_qkv, dim3(M * 48 / 4), dim3(256), 0, stream, HM, in[I_BWIN], 3088, 0, in[I_BQN], in[I_BKN], Qb, Kb, Vb); break;
            case PH_ATT_B: hipLaunchKernelGGL(nk_attnB, dim3(M * 16 / 4), dim3(256), 0, stream, Qb, Kb, Vb, CUM, OR); break;
            case PH_OUT_B: hipLaunchKernelGGL(nk_out, dim3(M * 16 / 4), dim3(256), 0, stream, OR, in[I_BWOUT], out, MOD + 4 * 6144 + 2 * D, out); break;
            case PH_MOE1_1: hipLaunchKernelGGL(nk_moe1, dim3(M * 8 / 4), dim3(256), 0, stream, HM, TR, in[I_WG] + (size_t)NE * D * FF, in[I_WU] + (size_t)NE * D * FF, HID2); break;
            case PH_MOE2_1: hipLaunchKernelGGL(nk_moe2, dim3(M * 16 / 4), dim3(256), 0, stream, HID2, TR, in[I_WD] + (size_t)NE * FF * D, MOD + 4 * 6144 + 5 * D, out); break;
            default: launch_mk(a, ph, ph + 1, grid, stream); break;
        }
    }
#endif
}
```

```cpp
#include <hip/hip_runtime.h>
#include <hip/hip_bf16.h>
#include <cstdio>
#include <cstdint>
#include <cmath>

#ifndef MK_MODE
#define MK_MODE 0
#endif
#ifndef DUP_MASK
#define DUP_MASK 0u
#endif
#ifndef HOST_DUP_MASK
#define HOST_DUP_MASK 0u
#endif
#ifndef HOST_DUP_FLAGS
#define HOST_DUP_FLAGS -1
#endif
#ifndef NAIVE_MASK
#define NAIVE_MASK 0u
#endif

constexpr int BATCH = 4, SEQ = 4096, D = 1024, H = 16, HD = 64, M = BATCH * SEQ;
constexpr int NE = 16, FF = 256, NCOMBO = 24;
constexpr float EPS = 1e-6f, LOG2E = 1.4426950408889634f, LN2 = 0.6931471805599453f;
constexpr float C2 = 0.125f * LOG2E;
constexpr int BV_PITCH = 132;
constexpr int NPH = 20;
enum Phase { PH_PRO = 0, PH_ROW_A = 1, PH_QKV_A0 = 2, PH_ATT_A0 = 3, PH_QKV_A1 = 4, PH_ATT_A1 = 5, PH_QKV_A2 = 6, PH_ATT_A2 = 7, PH_OUT_A = 8, PH_ROW_F0 = 9, PH_MOE1_0 = 10, PH_MOE2_0 = 11,
             PH_ROW_B = 12, PH_CUM = 13, PH_QKV_B = 14, PH_ATT_B = 15, PH_OUT_B = 16, PH_ROW_F1 = 17, PH_MOE1_1 = 18, PH_MOE2_1 = 19 };

constexpr size_t MiB = 1u << 20;
constexpr size_t WS_CTL = 0, CTL_ZERO_BYTES = 1 * MiB;
constexpr size_t WS_MOD = 1 * MiB;
constexpr size_t WS_BIASV = 1 * MiB + 256 * 1024;
constexpr size_t WS_TOKREC = 1 * MiB + 512 * 1024;
constexpr size_t WS_CUM = 2 * MiB;
constexpr size_t WS_LOGF = 3 * MiB;
constexpr size_t WS_LSE = 4 * MiB;
constexpr size_t WS_ELIST = 5 * MiB;
constexpr size_t WS_CLIST = 6 * MiB;
constexpr size_t WS_WAIN = 8 * MiB;
constexpr size_t WS_WAOUT = 26 * MiB;
constexpr size_t WS_WBIN = 28 * MiB;
constexpr size_t WS_WBOUT = 34 * MiB;
constexpr size_t WS_MOE1 = 36 * MiB;
constexpr size_t WS_MOE2 = 68 * MiB;
constexpr size_t WS_HM = 84 * MiB;
constexpr size_t WS_Q = 116 * MiB, WS_K = 148 * MiB, WS_V = 180 * MiB;
constexpr size_t WS_ORUN = 212 * MiB;
constexpr size_t WS_HID2 = 116 * MiB;
constexpr size_t WS_END = 244 * MiB;
constexpr int CW_TMO = 0, CW_CODE = 1, CW_BAR = 4096, CW_CNT = 16384;

constexpr int RING_OFF = 0, RING_BYTES = 131072;
constexpr int LDSCTL_OFF = RING_BYTES, MISC_OFF = LDSCTL_OFF + 320;
constexpr int LDS_BYTES = 163840;
constexpr int GTAB_OFF = LDSCTL_OFF + 8192;

#define GAS __attribute__((address_space(1)))
#define LAS __attribute__((address_space(3)))
typedef unsigned short bf16;
typedef unsigned v4u __attribute__((ext_vector_type(4)));
typedef unsigned v2u __attribute__((ext_vector_type(2)));
typedef float f32x4 __attribute__((ext_vector_type(4)));
typedef short bf16x8 __attribute__((ext_vector_type(8)));
typedef GAS unsigned gu32;
#define RLX_AGENT __ATOMIC_RELAXED, __HIP_MEMORY_SCOPE_AGENT
#define LDS_WAIT() asm volatile("s_waitcnt lgkmcnt(0)" ::: "memory")
#define VM_WAIT() asm volatile("s_waitcnt vmcnt(0)" ::: "memory")
__device__ __forceinline__ unsigned f2bf(float f) { unsigned u = __builtin_bit_cast(unsigned, f); return (u + 0x7fffu + ((u >> 16) & 1u)) >> 16; }
__device__ __forceinline__ unsigned pk2(float lo, float hi) { return f2bf(lo) | (f2bf(hi) << 16); }
__device__ __forceinline__ float bf2f(unsigned u) { return __uint_as_float(u << 16); }
__device__ __forceinline__ float wave_sum(float v) {
#pragma unroll
    for (int o = 1; o < 64; o <<= 1) v += __shfl_xor(v, o);
    return v;
}
__device__ __forceinline__ float wave_max(float v) {
#pragma unroll
    for (int o = 1; o < 64; o <<= 1) v = fmaxf(v, __shfl_xor(v, o));
    return v;
}
__host__ __device__ __forceinline__ int dil_of(int g) { return g == 0 ? 1 : (g == 1 ? 4 : 16); }

#define XB_TMO      128
#define XB_XCNT(j)  (256  + 64 * (j))
#define XB_XSUB(j)  (1280 + 64 * (j))
#define XB_XGEN(j)  (2304 + 64 * (j))
#define XB_TOP      3328
#define XB_TOPGEN   3392
#define XCD_BAR_WORDS 3456
#define XB_SPIN_CAP (1u << 18)
__device__ __forceinline__ unsigned xb_ld(unsigned* p)              { return __hip_atomic_load(p, __ATOMIC_RELAXED, __HIP_MEMORY_SCOPE_AGENT); }
__device__ __forceinline__ unsigned xb_add(unsigned* p, unsigned v) { return __hip_atomic_fetch_add(p, v, __ATOMIC_RELAXED, __HIP_MEMORY_SCOPE_AGENT); }
__device__ __forceinline__ unsigned xb_xcc_id() { return (unsigned)__builtin_amdgcn_s_getreg((3 << 11) | 20) & 0xFu; }
#define XB_SPIN(cond, bar) do { unsigned _sp = 0; while (cond) { __builtin_amdgcn_s_sleep(1); \
    if ((++_sp & 255u) == 0u) { if (xb_ld(&(bar)[XB_TMO])) break; if (_sp > XB_SPIN_CAP) { atomicAdd(&(bar)[XB_TMO], 1u); break; } } } } while (0)
struct XcdBarrier { unsigned* bar; unsigned x; volatile LAS unsigned* st; };
__device__ __forceinline__ XcdBarrier xcd_barrier_post(unsigned* bar, volatile LAS unsigned* st) {
    XcdBarrier b; b.bar = bar; b.x = xb_xcc_id(); b.st = st;
    if (threadIdx.x == 0) (void)xb_add(&bar[XB_XCNT(b.x)], 1u);
    return b;
}
__device__ __forceinline__ void xcd_barrier_complete(unsigned* bar, unsigned x, unsigned& nloc, unsigned& nx) {
    const unsigned G = gridDim.x * gridDim.y * gridDim.z;
    unsigned sum, cnt, mine, sp = 0u;
    for (;;) {
        sum = 0u; cnt = 0u; mine = 0u;
#pragma unroll
        for (unsigned j = 0; j < 16; ++j) { const unsigned c = xb_ld(&bar[XB_XCNT(j)]); sum += c; cnt += (c > 0u) ? 1u : 0u; mine = (j == x) ? c : mine; }
        if (sum == G) break;
        __builtin_amdgcn_s_sleep(1);
        if ((++sp & 255u) == 0u) { if (xb_ld(&bar[XB_TMO])) break; if (sp > XB_SPIN_CAP) { atomicAdd(&bar[XB_TMO], 1u); break; } }
    }
    nloc = mine > 0u ? mine : 1u; nx = cnt > 0u ? cnt : 1u;
}
__device__ __forceinline__ void xcd_barrier(const XcdBarrier& b) {
    asm volatile("s_waitcnt vmcnt(0)" ::: "memory");
    __syncthreads();
    if (threadIdx.x == 0) {
        unsigned* bar = b.bar;
        __builtin_amdgcn_s_waitcnt(0);
        unsigned nloc = b.st[0], nx = b.st[1];
        if (nloc == 0u) { xcd_barrier_complete(bar, b.x, nloc, nx); b.st[0] = nloc; b.st[1] = nx; }
        const unsigned old = xb_add(&bar[XB_XSUB(b.x)], 1u);
        const unsigned gen = old / nloc;
        if (old + 1u == (gen + 1u) * nloc) {
            __builtin_amdgcn_fence(__ATOMIC_RELEASE, "agent");
            asm volatile("s_waitcnt vmcnt(0)" ::: "memory");
            const unsigned og = xb_add(&bar[XB_TOP], 1u);
            const unsigned tg = og / nx;
            if (og + 1u == (tg + 1u) * nx) xb_add(&bar[XB_TOPGEN], 1u);
            else XB_SPIN(xb_ld(&bar[XB_TOPGEN]) == tg, bar);
            __builtin_amdgcn_fence(__ATOMIC_ACQUIRE, "agent");
            xb_add(&bar[XB_XGEN(b.x)], 1u);
            asm volatile("s_waitcnt vmcnt(0)" ::: "memory");
        } else {
            XB_SPIN(xb_ld(&bar[XB_XGEN(b.x)]) == gen, bar);
            __builtin_amdgcn_fence(__ATOMIC_ACQUIRE, "agent");
            asm volatile("s_waitcnt vmcnt(0)" ::: "memory");
        }
    }
    __syncthreads();
}

constexpr int NWAVES = 8;
struct Args { const float* in[23]; float* out; unsigned char* ws; int ph_lo, ph_hi, flags, pad; };
__device__ __forceinline__ bool frame_refresh(struct Frame& F);
struct Frame {
    LAS unsigned char* lds;
    volatile LAS unsigned* MISC;
    gu32* ctl;
    int tid, lane, wave, vcu, G;
    unsigned char* ws;
    const float* const* in;
    float* out;
    int flags;
};
__device__ __forceinline__ bool frame_refresh(Frame& F) { int t = threadIdx.x; asm volatile("" : "+v"(t)); F.tid = t; F.lane = t & 63; F.wave = __builtin_amdgcn_readfirstlane(t >> 6); return true; }
enum In { I_X = 0, I_C, I_WADA, I_BADA, I_NMIX, I_NFFN, I_RELB, I_AWIN, I_AWOUT, I_AQN, I_AKN, I_BWIN, I_BFB, I_BWOUT, I_BQN, I_BKN, I_RGW, I_RGB, I_REW, I_REB, I_WG, I_WU, I_WD };

__device__ __forceinline__ void pro_mod_item(Frame& F, int item) {
    LAS float* s = (LAS float*)(F.lds + RING_OFF);
    LAS float* part = (LAS float*)(F.lds + RING_OFF + 16384);
    const float* c = F.in[I_C];
    for (int i = F.tid; i < 4 * D; i += NWAVES * 64) { const float v = c[i]; s[i] = v / (1.f + __expf(-v)); }
    __syncthreads();
    const int layer = item / 96, cc = item % 96, col = cc * 64 + F.lane;
    const float* W = F.in[I_WADA] + (size_t)layer * D * 6144 + col;
    float a0 = 0.f, a1 = 0.f, a2 = 0.f, a3 = 0.f;
    const int k0 = F.wave * 128;
#pragma unroll 8
    for (int k = k0; k < k0 + 128; ++k) { const float w = W[(size_t)k * 6144]; a0 += s[k] * w; a1 += s[D + k] * w; a2 += s[2 * D + k] * w; a3 += s[3 * D + k] * w; }
    part[(F.wave * 4 + 0) * 64 + F.lane] = a0; part[(F.wave * 4 + 1) * 64 + F.lane] = a1; part[(F.wave * 4 + 2) * 64 + F.lane] = a2; part[(F.wave * 4 + 3) * 64 + F.lane] = a3;
    __syncthreads();
    if (F.wave < 4) {
        float t = 0.f;
#pragma unroll
        for (int w = 0; w < 8; ++w) t += part[(w * 4 + F.wave) * 64 + F.lane];
        float* MOD = (float*)(F.ws + WS_MOD);
        MOD[(size_t)(layer * 4 + F.wave) * 6144 + col] = t + F.in[I_BADA][layer * 6144 + col];
    }
    __syncthreads();
}
__device__ __forceinline__ void pro_biasv(Frame& F) {
    float* BV = (float*)(F.ws + WS_BIASV);
    for (int i = F.tid; i < 48 * 129; i += NWAVES * 64) {
        const int gh = i / 129, dist = i % 129, g = gh / 16, d = dist * dil_of(g);
        int bucket;
        if (d < 16) bucket = d;
        else { const float v = logf((float)d / 16.0f) / 4.852030263919617f * 16.0f; bucket = 16 + (int)v; if (bucket > 31) bucket = 31; }
        BV[gh * BV_PITCH + dist] = F.in[I_RELB][bucket * 48 + gh] * LOG2E;
    }
}
__device__ __forceinline__ int rowmap(int mode, int n) {
    if (mode == 0) return n;
    if (mode == 1) return (n & ~255) + 128 * ((n >> 5) & 1) + 32 * ((n >> 6) & 3) + (n & 31);
    return 256 * (n >> 7) + (n & 127) + (mode == 3 ? 128 : 0);
}
__device__ __forceinline__ void transpose_item(const float* W, int ldw, bf16* WT, int ldt, int k0, int n0, int mode, LAS float* scr, int lane) {
    float tv[32];
#pragma unroll
    for (int i = 0; i < 32; ++i) { const int kk = 2 * i + (lane >> 5); tv[i] = W[(size_t)(k0 + kk) * ldw + n0 + (lane & 31)]; }
#pragma unroll
    for (int i = 0; i < 32; ++i) { const int kk = 2 * i + (lane >> 5); scr[kk * 33 + (lane & 31)] = tv[i]; }
    LDS_WAIT(); asm volatile("" ::: "memory");
    const int c = lane & 7;
#pragma unroll
    for (int j = 0; j < 4; ++j) { const int n = (lane >> 3) + 8 * j; const LAS float* s = scr + (8 * c) * 33 + n;
        v4u o; o.x = pk2(s[0 * 33], s[1 * 33]); o.y = pk2(s[2 * 33], s[3 * 33]); o.z = pk2(s[4 * 33], s[5 * 33]); o.w = pk2(s[6 * 33], s[7 * 33]);
        *(GAS v4u*)(WT + (size_t)rowmap(mode, n0 + n) * ldt + k0 + 8 * c) = o; }
    LDS_WAIT(); asm volatile("" ::: "memory");
}
__device__ __forceinline__ void p0_prologue(Frame& F) {
    if (blockIdx.x < 192) pro_mod_item(F, blockIdx.x);
    if (blockIdx.x == F.G - 1) pro_biasv(F);
    __syncthreads();
    LAS float* scr = (LAS float*)(F.lds + RING_OFF + F.wave * 16384);
    const int gw = F.vcu * NWAVES + F.wave, NGW = F.G * NWAVES;
    constexpr int I_A = 16 * 288, I_AO = 16 * 32, I_B = 16 * 96, I_BO = 16 * 32, I_E = 32 * 128;
    constexpr int NITEMS = I_A + I_AO + I_B + I_BO + 3 * I_E;
    for (int it = gw; it < NITEMS; it += NGW) {
        int r = it;
        if (r < I_A) { transpose_item(F.in[I_AWIN], 9216, (bf16*)(F.ws + WS_WAIN), 1024, 64 * (r / 288), 32 * (r % 288), 1, scr, F.lane); continue; } r -= I_A;
        if (r < I_AO) { transpose_item(F.in[I_AWOUT], 1024, (bf16*)(F.ws + WS_WAOUT), 1024, 64 * (r / 32), 32 * (r % 32), 0, scr, F.lane); continue; } r -= I_AO;
        if (r < I_B) { transpose_item(F.in[I_BWIN], 3088, (bf16*)(F.ws + WS_WBIN), 1024, 64 * (r / 96), 32 * (r % 96), 1, scr, F.lane); continue; } r -= I_B;
        if (r < I_BO) { transpose_item(F.in[I_BWOUT], 1024, (bf16*)(F.ws + WS_WBOUT), 1024, 64 * (r / 32), 32 * (r % 32), 0, scr, F.lane); continue; } r -= I_BO;
        if (r < I_E) { const int le = r / 128, q = r % 128;
            transpose_item(F.in[I_WG] + (size_t)le * D * FF, FF, (bf16*)(F.ws + WS_MOE1) + (size_t)le * 512 * D, 1024, 64 * (q / 8), 32 * (q % 8), 2, scr, F.lane); continue; } r -= I_E;
        if (r < I_E) { const int le = r / 128, q = r % 128;
            transpose_item(F.in[I_WU] + (size_t)le * D * FF, FF, (bf16*)(F.ws + WS_MOE1) + (size_t)le * 512 * D, 1024, 64 * (q / 8), 32 * (q % 8), 3, scr, F.lane); continue; } r -= I_E;
        { const int le = r / 128, q = r % 128;
            transpose_item(F.in[I_WD] + (size_t)le * FF * D, D, (bf16*)(F.ws + WS_MOE2) + (size_t)le * D * FF, 256, 64 * (q / 32), 32 * (q % 32), 0, scr, F.lane); }
    }
}

template <int N> __device__ __forceinline__ void reduce_scatter(float (&a)[64], int lane) {
    if constexpr (N >= 1) {
        const bool up = (lane & N) != 0;
#pragma unroll
        for (int i = 0; i < N; ++i) { const float keep = up ? a[i + N] : a[i], send = up ? a[i] : a[i + N]; a[i] = keep + __shfl_xor(send, N); }
        reduce_scatter<N / 2>(a, lane);
    }
}
template <int MODE> __device__ __forceinline__ void rowpass(Frame& F, const float* xin, const float* gain, int layer, int sh_idx, int sc_idx) {
    constexpr int NW = MODE == 1 ? 16 : (MODE == 2 ? 20 : 0), NWP = MODE == 1 ? 16 : 32, RPG = MODE == 1 ? 4 : 2;
    LAS float* Wl = (LAS float*)(F.lds + RING_OFF);
    LAS int* rowinfo = (LAS int*)(F.lds + RING_OFF + 98304);
    LAS float* wsum = (LAS float*)(F.lds + RING_OFF + 98304 + 1024) + F.wave * 64;
    const float* MOD = (const float*)(F.ws + WS_MOD) + (size_t)layer * 4 * 6144;
    bf16* HM = (bf16*)(F.ws + WS_HM);
    if constexpr (MODE == 1) { const float* W = F.in[I_BWIN] + 3072; f32x4 t[8];
#pragma unroll
        for (int q = 0; q < 8; ++q) { const int i = F.tid + q * 512, c = i >> 2, j4 = i & 3; t[q] = *(const f32x4*)(W + (size_t)c * 3088 + 4 * j4); }
#pragma unroll
        for (int q = 0; q < 8; ++q) { const int i = F.tid + q * 512, c = i >> 2, j4 = i & 3; Wl[(4 * j4 + 0) * D + c] = t[q].x; Wl[(4 * j4 + 1) * D + c] = t[q].y; Wl[(4 * j4 + 2) * D + c] = t[q].z; Wl[(4 * j4 + 3) * D + c] = t[q].w; } }
    if constexpr (MODE == 2) { const float* Wg = F.in[I_RGW] + (size_t)layer * D * 4; const float* We = F.in[I_REW] + (size_t)layer * D * 16; f32x4 t[10];
#pragma unroll
        for (int q = 0; q < 8; ++q) { const int i = F.tid + q * 512; t[q] = *(const f32x4*)(We + 4 * (size_t)i); }
#pragma unroll
        for (int q = 0; q < 2; ++q) { const int i = F.tid + q * 512; t[8 + q] = *(const f32x4*)(Wg + 4 * (size_t)i); }
#pragma unroll
        for (int q = 0; q < 8; ++q) { const int i = F.tid + q * 512, c = i >> 2, j4 = i & 3; Wl[(4 + 4 * j4 + 0) * D + c] = t[q].x; Wl[(4 + 4 * j4 + 1) * D + c] = t[q].y; Wl[(4 + 4 * j4 + 2) * D + c] = t[q].z; Wl[(4 + 4 * j4 + 3) * D + c] = t[q].w; }
#pragma unroll
        for (int q = 0; q < 2; ++q) { const int c = F.tid + q * 512; Wl[0 * D + c] = t[8 + q].x; Wl[1 * D + c] = t[8 + q].y; Wl[2 * D + c] = t[8 + q].z; Wl[3 * D + c] = t[8 + q].w; } }
    __syncthreads();
    for (int rb = blockIdx.x; rb < M / 64; rb += F.G) {
        const int b = (rb * 64) / SEQ;
        f32x4 Gv[4], Sv[4];
#pragma unroll
        for (int j = 0; j < 4; ++j) { const int c = 4 * F.lane + 256 * j;
            const f32x4 gv = *(const f32x4*)(gain + c), sc = *(const f32x4*)(MOD + (size_t)b * 6144 + sc_idx * D + c), sh = *(const f32x4*)(MOD + (size_t)b * 6144 + sh_idx * D + c);
            Gv[j] = gv * (sc + 1.0f); Sv[j] = sh; }
        constexpr bool PF = (RPG == 2);
        f32x4 vn[RPG][4];
        if constexpr (PF) {
#pragma unroll
            for (int r = 0; r < RPG; ++r) { const GAS f32x4* xr = (const GAS f32x4*)(xin + (size_t)(rb * 64 + F.wave * 8 + r) * D) + F.lane;
#pragma unroll
                for (int j = 0; j < 4; ++j) vn[r][j] = xr[64 * j]; } }
#pragma unroll 1
        for (int grp = 0; grp < 8 / RPG; ++grp) {
            const int m0 = rb * 64 + F.wave * 8 + grp * RPG;
            f32x4 v[RPG][4];
            if constexpr (PF) {
#pragma unroll
                for (int r = 0; r < RPG; ++r)
#pragma unroll
                    for (int j = 0; j < 4; ++j) v[r][j] = vn[r][j];
                if (grp + 1 < 8 / RPG) {
#pragma unroll
                    for (int r = 0; r < RPG; ++r) { const GAS f32x4* xr = (const GAS f32x4*)(xin + (size_t)(m0 + RPG + r) * D) + F.lane;
#pragma unroll
                        for (int j = 0; j < 4; ++j) vn[r][j] = xr[64 * j]; } }
            } else {
#pragma unroll
                for (int r = 0; r < RPG; ++r) { const GAS f32x4* xr = (const GAS f32x4*)(xin + (size_t)(m0 + r) * D) + F.lane;
#pragma unroll
                    for (int j = 0; j < 4; ++j) v[r][j] = xr[64 * j]; }
            }
#pragma unroll
            for (int r = 0; r < RPG; ++r) { float ss = 0.f;
#pragma unroll
                for (int j = 0; j < 4; ++j) ss += (v[r][j].x * v[r][j].x + v[r][j].y * v[r][j].y) + (v[r][j].z * v[r][j].z + v[r][j].w * v[r][j].w);
                const float rstd = 1.0f / sqrtf(wave_sum(ss) * (1.f / D) + EPS);
                GAS unsigned long long* o8 = (GAS unsigned long long*)(HM + (size_t)(m0 + r) * D) + F.lane;
#pragma unroll
                for (int j = 0; j < 4; ++j) { v[r][j] = v[r][j] * rstd * Gv[j] + Sv[j];
                    o8[64 * j] = (unsigned long long)pk2(v[r][j].x, v[r][j].y) | ((unsigned long long)pk2(v[r][j].z, v[r][j].w) << 32); } }
            if constexpr (NW > 0) {
                float a[64];
#pragma unroll
                for (int i = 0; i < 64; ++i) a[i] = 0.f;
#pragma unroll
                for (int jj = 0; jj < NW; ++jj) {
                    asm volatile("" ::: "memory");
#pragma unroll
                    for (int j = 0; j < 4; ++j) { const f32x4 w = *(const LAS f32x4*)(Wl + jj * D + 4 * F.lane + 256 * j);
#pragma unroll
                        for (int r = 0; r < RPG; ++r) a[r * NWP + jj] += (v[r][j].x * w.x + v[r][j].y * w.y) + (v[r][j].z * w.z + v[r][j].w * w.w); }
                }
                reduce_scatter<32>(a, F.lane);
                const float tot = a[0];
                if constexpr (MODE == 1) {
                    float* LOGF = (float*)(F.ws + WS_LOGF);
                    const float z = tot + F.in[I_BFB][F.lane & 15];
                    LOGF[(size_t)m0 * 16 + F.lane] = fminf(z, 0.f) - log1pf(expf(-fabsf(z)));
                }
                if constexpr (MODE == 2) {
                    wsum[F.lane] = tot; LDS_WAIT();
                    if (F.lane < RPG) {
                        const float* bg = F.in[I_RGB] + layer * 4; const float* be = F.in[I_REB] + layer * 16;
                        v4u* TOKREC = (v4u*)(F.ws + ((F.flags & 2) ? WS_END : WS_TOKREC));
                        const LAS float* dr = wsum + F.lane * NWP;
                        const float g0 = dr[0] + bg[0], g1 = dr[1] + bg[1], g2 = dr[2] + bg[2], g3 = dr[3] + bg[3];
                        int gi = 0; float gm = g0; if (g1 > gm) { gm = g1; gi = 1; } if (g2 > gm) { gm = g2; gi = 2; } if (g3 > gm) { gm = g3; gi = 3; }
                        const float gw = 1.0f / (expf(g0 - gm) + expf(g1 - gm) + expf(g2 - gm) + expf(g3 - gm));
                        float es[4];
#pragma unroll
                        for (int i = 0; i < 4; ++i) es[i] = dr[4 + gi * 4 + i] + be[gi * 4 + i];
                        int i1 = 0; float v1 = es[0];
#pragma unroll
                        for (int i = 1; i < 4; ++i) if (es[i] > v1) { v1 = es[i]; i1 = i; }
                        int i2 = -1; float v2 = -INFINITY;
#pragma unroll
                        for (int i = 0; i < 4; ++i) if (i != i1 && es[i] > v2) { v2 = es[i]; i2 = i; }
                        const float ex = expf(v2 - v1), w1 = gw / (1.0f + ex), w2 = gw * ex / (1.0f + ex);
                        const int aa = i1 < i2 ? i1 : i2, bb = i1 < i2 ? i2 : i1;
                        const float wlo = i1 < i2 ? w1 : w2, whi = i1 < i2 ? w2 : w1;
                        const int pidx = aa == 0 ? bb - 1 : (aa == 1 ? bb + 1 : 5);
                        const int lo = gi * 4 + aa, hi = gi * 4 + bb, combo = gi * 6 + pidx;
                        v4u rec; rec.x = (unsigned)(lo | (hi << 8) | (combo << 16)); rec.y = __float_as_uint(wlo); rec.z = __float_as_uint(whi); rec.w = 0u;
                        TOKREC[m0 + F.lane] = rec; rowinfo[F.wave * 8 + grp * RPG + F.lane] = lo | (hi << 8) | (combo << 16);
                    }
                    LDS_WAIT();
                }
            }
        }
        if (MODE == 2) {
            __syncthreads();
            if (F.tid < 40) {
                const int t = F.tid; int n = 0;
#pragma unroll 8
                for (int r = 0; r < 64; ++r) { const int ri = rowinfo[r]; const bool mem = t < 16 ? ((ri & 0xff) == t || ((ri >> 8) & 0xff) == t) : ((ri >> 16) == t - 16); n += mem ? 1 : 0; }
                gu32* cnt = F.ctl + CW_CNT + (((F.flags & 2) ? 2 : layer) * 40 + t) * 64;
                const int base = (int)__hip_atomic_fetch_add(cnt, (unsigned)n, RLX_AGENT);
                int* list = (int*)(F.ws + ((F.flags & 2) ? WS_END + MiB : (t < 16 ? WS_ELIST : WS_CLIST))) + (t < 16 ? t : ((F.flags & 2) ? t : t - 16)) * M;
                int kk = 0;
                for (int r = 0; r < 64; ++r) { const int ri = rowinfo[r]; const bool mem = t < 16 ? ((ri & 0xff) == t || ((ri >> 8) & 0xff) == t) : ((ri >> 16) == t - 16);
                    if (mem) { list[base + kk] = rb * 64 + r; ++kk; } }
            }
            __syncthreads();
        }
    }
}

__device__ __forceinline__ void cumsum_phase(Frame& F) {
    LAS float* wt = (LAS float*)(F.lds + RING_OFF);
    for (int bh = blockIdx.x; bh < BATCH * H; bh += F.G) {
        const int b = bh / H, h = bh % H;
        const float* LOGF = (const float*)(F.ws + WS_LOGF) + (size_t)b * SEQ * 16 + h;
        float v[8]; float run = 0.f;
#pragma unroll
        for (int i = 0; i < 8; ++i) { run += LOGF[(size_t)(F.tid * 8 + i) * 16]; v[i] = run; }
        float inc = run;
#pragma unroll
        for (int o = 1; o < 64; o <<= 1) { const float n = __shfl_up(inc, o); if (F.lane >= o) inc += n; }
        if (F.lane == 63) wt[F.wave] = inc;
        __syncthreads();
        float base = inc - run;
        for (int w = 0; w < F.wave; ++w) base += wt[w];
        float* CUM = (float*)(F.ws + WS_CUM) + (size_t)bh * SEQ + F.tid * 8;
#pragma unroll
        for (int i = 0; i < 8; ++i) CUM[i] = -(base + v[i]) * LOG2E;
        __syncthreads();
    }
}

namespace pg8 {
typedef unsigned short bf16_t;
typedef unsigned u32x4 __attribute__((ext_vector_type(4)));
constexpr int BM = 256, BK = 64, HALF = 128, HTB = HALF * BK * 2, STAGE_BYTES = 8 * HTB, NXCD = 8, WGM = 8;
__host__ __device__ __forceinline__ int lds_byte(int r, int c) { const int st = (r >> 4) * 2 + (c >> 5), rr = r & 15, cc = c & 31, ob = rr * 64 + cc * 2; return st * 1024 + (ob ^ (((ob >> 9) & 1) << 5)); }
__host__ __device__ __forceinline__ void stage_rc(int b, int& R, int& C) { const int st = b / 1024, sb = b % 1024, swz = sb ^ (((sb >> 9) & 1) << 5); R = (st >> 1) * 16 + swz / 64; C = (st & 1) * 32 + (swz % 64) / 2; }
__host__ __device__ __forceinline__ int perm32(int rho) { const int n = rho >> 4, i = rho & 15; return 8 * (i >> 2) + 4 * n + (i & 3); }
struct Unit { int pm, pn, e, cnt; };
__device__ __forceinline__ unsigned cvt_pk_bf16(float lo, float hi) { unsigned r; asm volatile("v_cvt_pk_bf16_f32 %0, %1, %2" : "=v"(r) : "v"(lo), "v"(hi)); return r; }

struct StaticOrder {
    int nM, nN, nwg, G, c; const char* A; const char* Bt; size_t tstepA, tstepB; int ks;
    __device__ void init(int M_, int N_, int G_, int c_, const void* A_, int lda, const void* Bt_, int ldb, int nt) { nM = M_ / BM; nN = N_ / BM; nwg = nM * nN; G = G_; c = c_; A = (const char*)A_; Bt = (const char*)Bt_; tstepA = (size_t)BM * lda * 2; tstepB = (size_t)BM * ldb * 2; ks = nt; }
    __device__ bool next(int i, Unit& u) const {
        const long L = (long)i * G + c; if (L >= nwg) return false;
        int wgid = (int)L; { const int q = nwg / NXCD, r = nwg % NXCD, xcd = wgid % NXCD, off = wgid / NXCD; wgid = (xcd < r ? xcd * (q + 1) : r * (q + 1) + (xcd - r) * q) + off; }
        const int nig = WGM * nN, gid = wgid / nig, fm = gid * WGM, gsz = (nM - fm) < WGM ? (nM - fm) : WGM;
        u.pm = fm + ((wgid % nig) % gsz); u.pn = (wgid % nig) / gsz; u.e = 0; u.cnt = 0; return true;
    }
    __device__ __forceinline__ const char* a_base(const Unit& u) const { return A + (size_t)u.pm * tstepA; }
    __device__ __forceinline__ const char* b_lo(const Unit& u) const { return Bt + (size_t)u.pn * tstepB; }
    __device__ __forceinline__ const char* b_hi(const Unit& u) const { return Bt + (size_t)u.pn * tstepB; }
    __device__ __forceinline__ int row(const Unit&, int) const { return 0; }
};
struct MoeOrder {
    int G, c, nl, ntn, ks, mode; const char* A; const char* B; const int* lists; const LAS int* tab;
    __device__ bool next(int i, Unit& u) const {
        const int L = i * G + c, total = __builtin_amdgcn_readfirstlane(tab[nl]) * ntn; if (L >= total) return false;
        const int rt = L / ntn; int e = 0;
        for (int k = 1; k < nl; ++k) e = (tab[k] <= rt) ? k : e;
        u.e = __builtin_amdgcn_readfirstlane(e); u.pm = __builtin_amdgcn_readfirstlane(rt - tab[e]); u.pn = L % ntn; u.cnt = __builtin_amdgcn_readfirstlane(tab[32 + e]); return true;
    }
    __device__ __forceinline__ const char* a_base(const Unit&) const { return A; }
    __device__ __forceinline__ const char* b_lo(const Unit& u) const {
        if (mode == 1) return B + ((size_t)u.e * 512 + (size_t)u.pn * 256) * 1024 * 2;
        const int g = u.e / 6, p = u.e % 6, a = p < 3 ? 0 : (p < 5 ? 1 : 2);
        return B + ((size_t)(g * 4 + a) * 1024 + (size_t)u.pn * 256) * 256 * 2; }
    __device__ __forceinline__ const char* b_hi(const Unit& u) const {
        if (mode == 1) return b_lo(u);
        const int g = u.e / 6, p = u.e % 6, b = p < 3 ? p + 1 : (p < 5 ? p - 1 : 3);
        return B + ((size_t)(g * 4 + b) * 1024 + (size_t)u.pn * 256) * 256 * 2; }
    __device__ __forceinline__ int row(const Unit& u, int r) const { int idx = u.pm * 256 + r; idx = idx < u.cnt ? idx : u.cnt - 1; return lists[(size_t)u.e * 16384 + idx]; }
};

struct EpiQKV {
    static constexpr bool PERM = true;
    bf16_t* Qo; const float* qg; const float* kg;
    __device__ __forceinline__ void operator()(const f32x4 (&acc)[2][2][4][2], const Unit& u, int wr, int wc, int fr, int fq) const {
        const int t = u.pn >> 2, hcol = (u.pn & 3) * 256 + wc * 64;
        bf16_t* base = Qo + (size_t)t * ((WS_K - WS_Q) / 2) + hcol + 8 * fq;
        f32x4 gv[2][2];
        const float* gp = qg + (t == 1 ? (kg - qg) : 0) + 8 * fq;
#pragma unroll
        for (int bj = 0; bj < 2; ++bj)
#pragma unroll
            for (int n = 0; n < 2; ++n) gv[bj][n] = (t < 2) ? *(const f32x4*)(gp + 32 * bj + 4 * n) : (f32x4){1.f, 1.f, 1.f, 1.f};
        const float sc = (t == 0) ? C2 : 1.0f;
#pragma unroll
        for (int ai = 0; ai < 2; ++ai)
#pragma unroll
            for (int m = 0; m < 4; ++m) {
                float rs = sc;
                if (t < 2) { float ss = 0.f;
#pragma unroll
                    for (int bj = 0; bj < 2; ++bj)
#pragma unroll
                        for (int n = 0; n < 2; ++n) { const f32x4 x = acc[ai][bj][m][n]; ss += (x[0] * x[0] + x[1] * x[1]) + (x[2] * x[2] + x[3] * x[3]); }
                    ss += __shfl_xor(ss, 16); ss += __shfl_xor(ss, 32);
                    rs = sc / sqrtf(ss * (1.0f / 64.0f) + EPS); }
                bf16_t* rowp = base + (size_t)(u.pm * BM + ai * HALF + wr * 64 + m * 16 + fr) * 1024;
#pragma unroll
                for (int bj = 0; bj < 2; ++bj) { const f32x4 v0 = acc[ai][bj][m][0] * rs * gv[bj][0], v1 = acc[ai][bj][m][1] * rs * gv[bj][1];
                    u32x4 w; w.x = cvt_pk_bf16(v0[0], v0[1]); w.y = cvt_pk_bf16(v0[2], v0[3]); w.z = cvt_pk_bf16(v1[0], v1[1]); w.w = cvt_pk_bf16(v1[2], v1[3]);
                    *(u32x4*)(rowp + 32 * bj) = w; } }
    }
};
struct EpiOut {
    static constexpr bool PERM = false;
    const float* xin; float* xout; const float* gvec;
    __device__ __forceinline__ void operator()(const f32x4 (&acc)[2][2][4][2], const Unit& u, int wr, int wc, int fr, int fq) const {
        const int col0 = u.pn * BM + wc * 32 + 4 * fq, b = (u.pm * BM) / SEQ;
        f32x4 g[2][2];
#pragma unroll
        for (int bj = 0; bj < 2; ++bj)
#pragma unroll
            for (int n = 0; n < 2; ++n) g[bj][n] = *(const f32x4*)(gvec + (size_t)b * 6144 + col0 + bj * HALF + n * 16);
#pragma unroll
        for (int ai = 0; ai < 2; ++ai)
#pragma unroll
            for (int m = 0; m < 4; ++m) { const size_t off = (size_t)(u.pm * BM + ai * HALF + wr * 64 + m * 16 + fr) * D + col0;
#pragma unroll
                for (int bj = 0; bj < 2; ++bj)
#pragma unroll
                    for (int n = 0; n < 2; ++n) { const f32x4 xi = *(const f32x4*)(xin + off + bj * HALF + n * 16); *(f32x4*)(xout + off + bj * HALF + n * 16) = xi + g[bj][n] * acc[ai][bj][m][n]; }
                if (m == 3) asm volatile("" ::: "memory"); }
    }
};
struct EpiMoe1 {
    static constexpr bool PERM = true;
    const int* lists; const v4u* tokrec; bf16_t* HID2; int skip;
    __device__ __forceinline__ void operator()(const f32x4 (&acc)[2][2][4][2], const Unit& u, int wr, int wc, int fr, int fq) const {
        if (skip) return;
        const int f = u.pn * 128 + wc * 32 + 8 * fq;
        int tok[2][4]; v4u rec[2][4];
#pragma unroll
        for (int ai = 0; ai < 2; ++ai)
#pragma unroll
            for (int m = 0; m < 4; ++m) { int idx = u.pm * BM + ai * HALF + wr * 64 + m * 16 + fr; idx = idx < u.cnt ? idx : u.cnt - 1; tok[ai][m] = lists[(size_t)u.e * 16384 + idx]; }
#pragma unroll
        for (int ai = 0; ai < 2; ++ai)
#pragma unroll
            for (int m = 0; m < 4; ++m) rec[ai][m] = tokrec[tok[ai][m]];
#pragma unroll
        for (int ai = 0; ai < 2; ++ai)
#pragma unroll
            for (int m = 0; m < 4; ++m) { const int idx = u.pm * BM + ai * HALF + wr * 64 + m * 16 + fr;
                const int slot = ((int)(rec[ai][m].x & 0xffu) == u.e) ? 0 : 1; const float w = __uint_as_float(slot ? rec[ai][m].z : rec[ai][m].y);
                float h[8];
#pragma unroll
                for (int n = 0; n < 2; ++n)
#pragma unroll
                    for (int j = 0; j < 4; ++j) { const float g = acc[ai][0][m][n][j], up = acc[ai][1][m][n][j]; h[n * 4 + j] = g * __builtin_amdgcn_rcpf(1.0f + __expf(-g)) * up * w; }
                u32x4 o; o.x = cvt_pk_bf16(h[0], h[1]); o.y = cvt_pk_bf16(h[2], h[3]); o.z = cvt_pk_bf16(h[4], h[5]); o.w = cvt_pk_bf16(h[6], h[7]);
                if (idx < u.cnt) *(u32x4*)(HID2 + (size_t)tok[ai][m] * 512 + slot * 256 + f) = o; }
    }
};
struct EpiMoe2 {
    static constexpr bool PERM = false;
    const int* lists; float* x; const LAS float* gtab; int skip;
    __device__ __forceinline__ void operator()(const f32x4 (&acc)[2][2][4][2], const Unit& u, int wr, int wc, int fr, int fq) const {
        if (skip) return;
        const int col0 = u.pn * BM + wc * 32 + 4 * fq;
        int tok[2][4];
#pragma unroll
        for (int ai = 0; ai < 2; ++ai)
#pragma unroll
            for (int m = 0; m < 4; ++m) { int idx = u.pm * BM + ai * HALF + wr * 64 + m * 16 + fr; idx = idx < u.cnt ? idx : u.cnt - 1; tok[ai][m] = lists[(size_t)u.e * 16384 + idx]; }
#pragma unroll
        for (int ai = 0; ai < 2; ++ai) {
            f32x4 xi[4][2][2];
#pragma unroll
            for (int m = 0; m < 4; ++m) { const float* xp = x + (size_t)tok[ai][m] * D + col0;
#pragma unroll
                for (int bj = 0; bj < 2; ++bj)
#pragma unroll
                    for (int n = 0; n < 2; ++n) xi[m][bj][n] = *(const f32x4*)(xp + bj * HALF + n * 16); }
#pragma unroll
            for (int m = 0; m < 4; ++m) { const int idx = u.pm * BM + ai * HALF + wr * 64 + m * 16 + fr; const int t = tok[ai][m];
                const LAS float* gp = gtab + (t / SEQ) * D + col0; float* xp = x + (size_t)t * D + col0;
#pragma unroll
                for (int bj = 0; bj < 2; ++bj)
#pragma unroll
                    for (int n = 0; n < 2; ++n) { const f32x4 g = *(const LAS f32x4*)(gp + bj * HALF + n * 16); const f32x4 o = xi[m][bj][n] + g * acc[ai][bj][m][n];
                        if (idx < u.cnt) *(f32x4*)(xp + bj * HALF + n * 16) = o; } }
            asm volatile("" ::: "memory"); }
    }
};

template <class Epi, class Sched, bool GATHER, bool ALIGN_EPI>
__device__ __forceinline__ void gemm_phase(LAS unsigned char* lds, const int lda, const int ldb, const int K, const Sched& S, const Epi& E) {
    int tid_ = threadIdx.x; asm volatile("" : "+v"(tid_));
    const int tid = tid_, wid = __builtin_amdgcn_readfirstlane(tid >> 6), lane = tid & 63, wr = wid >> 2, wc = wid & 3, fr = lane & 15, fq = lane >> 4;
    const int nt = K / BK, ks = S.ks;
    unsigned voffA[2][2], voffB[2], nvA[2][2];
#pragma unroll
    for (int i = 0; i < 2; ++i) { int R, C; stage_rc(tid * 16 + i * 8192, R, C); const int Rb = Epi::PERM ? ((R & ~31) + perm32(R & 31)) : R;
        voffB[i] = (unsigned)(Rb * ldb + C) * 2u; voffA[0][i] = (unsigned)(R * lda + C) * 2u; voffA[1][i] = 0u; nvA[0][i] = 0u; nvA[1][i] = 0u; }
    const size_t kstep = (size_t)(BK * 2);
    const size_t hstepA = GATHER ? (size_t)0 : (size_t)HALF * lda * 2, hstepB = (size_t)HALF * ldb * 2;
    const unsigned ldsw = (unsigned)wid * 1024u;
    const int aoff = lds_byte(wr * 64 + fr, fq * 8), boff = lds_byte(wc * 32 + fr, fq * 8);
#define PG8_SA(b, h) (((b) * 2 + (h)) * HTB)
#define PG8_SB(b, h) ((4 + (b) * 2 + (h)) * HTB)
#define PG8_STAGE(bufoff, gbase, voff) do { _Pragma("unroll") for (int _i = 0; _i < 2; ++_i) \
        __builtin_amdgcn_global_load_lds((const unsigned*)((const char*)(gbase) + (voff)[_i]), (LAS unsigned*)(lds + (bufoff) + ldsw + _i * 8192), 16, 0, 0); } while (0)
#define PG8_STAGE_A(bufoff, gbase, h) do { if constexpr (GATHER) { PG8_STAGE(bufoff, gbase, voffA[h]); } else { PG8_STAGE(bufoff, (gbase) + (h) * hstepA, voffA[0]); } } while (0)
#define PG8_STAGE_B(bufoff, gbase, h) PG8_STAGE(bufoff, (gbase) + (h) * hstepB, voffB)
#define PG8_GATHER_OFFS(dst, u) do { _Pragma("unroll") for (int _h = 0; _h < 2; ++_h) _Pragma("unroll") for (int _i = 0; _i < 2; ++_i) { int _R, _C; stage_rc(tid * 16 + _i * 8192, _R, _C); \
        dst[_h][_i] = (unsigned)(S.row(u, _h * HALF + _R) * lda + _C) * 2u; } } while (0)
#define PG8_LDA(dst, b, h) do { _Pragma("unroll") for (int m = 0; m < 4; ++m) _Pragma("unroll") for (int k = 0; k < 2; ++k) dst[m][k] = *(const LAS bf16x8*)(lds + PG8_SA(b, h) + aoff + m * 2048 + k * 1024); } while (0)
#define PG8_LDB(dst, b, h) do { _Pragma("unroll") for (int n = 0; n < 2; ++n) _Pragma("unroll") for (int k = 0; k < 2; ++k) dst[n][k] = *(const LAS bf16x8*)(lds + PG8_SB(b, h) + boff + n * 2048 + k * 1024); } while (0)
#define PG8_MMA(ai, bj, At, Bt) do { __builtin_amdgcn_s_setprio(1); _Pragma("unroll") for (int m = 0; m < 4; ++m) _Pragma("unroll") for (int n = 0; n < 2; ++n) _Pragma("unroll") for (int k = 0; k < 2; ++k) \
        acc[ai][bj][m][n] = __builtin_amdgcn_mfma_f32_16x16x32_bf16(Bt[n][k], At[m][k], acc[ai][bj][m][n], 0, 0, 0); __builtin_amdgcn_s_setprio(0); } while (0)
#define PG8_WAIT_V(n) asm volatile("s_waitcnt vmcnt(" #n ")" ::: "memory")
#define PG8_WAIT_L(n) asm volatile("s_waitcnt lgkmcnt(" #n ")" ::: "memory")
#define PG8_BAR __builtin_amdgcn_s_barrier()
#define PG8_SCHED __builtin_amdgcn_sched_barrier(0)
#define PG8_BPTR(blo, bhi, t) (((t) < ks) ? (blo) + (size_t)(t) * kstep : (bhi) + (size_t)((t) - ks) * kstep)
    Unit cur, nxt; int ui = 0;
    if (!S.next(0, cur)) return;
    f32x4 acc[2][2][4][2];
#pragma unroll
    for (int a = 0; a < 2; ++a)
#pragma unroll
        for (int b = 0; b < 2; ++b)
#pragma unroll
            for (int m = 0; m < 4; ++m)
#pragma unroll
                for (int n = 0; n < 2; ++n) acc[a][b][m][n] = (f32x4){0.f, 0.f, 0.f, 0.f};
    bf16x8 At[4][2], B0[2][2], B1[2][2];
    const char* cA = S.a_base(cur); const char* cBlo = S.b_lo(cur); const char* cBhi = S.b_hi(cur);
    if constexpr (GATHER) { PG8_GATHER_OFFS(voffA, cur); }
    PG8_STAGE_B(PG8_SB(0, 0), cBlo, 0); PG8_STAGE_B(PG8_SB(0, 1), cBlo, 1); PG8_STAGE_A(PG8_SA(0, 0), cA, 0); PG8_STAGE_A(PG8_SA(0, 1), cA, 1);
    if (wr == 1) PG8_BAR;
    PG8_WAIT_V(2); PG8_BAR;
    PG8_STAGE_B(PG8_SB(1, 0), cBlo + kstep, 0); PG8_STAGE_A(PG8_SA(1, 0), cA + kstep, 0); PG8_STAGE_B(PG8_SB(1, 1), cBlo + kstep, 1);
    PG8_WAIT_V(6); PG8_BAR;
    for (;;) {
        const bool has_next = S.next(ui + 1, nxt);
        const char* nA = has_next ? S.a_base(nxt) : cA; const char* nBlo = has_next ? S.b_lo(nxt) : cBlo; const char* nBhi = has_next ? S.b_hi(nxt) : cBhi;
        if constexpr (GATHER) { if (has_next) { PG8_GATHER_OFFS(nvA, nxt); } else {
#pragma unroll
            for (int h = 0; h < 2; ++h)
#pragma unroll
                for (int i = 0; i < 2; ++i) nvA[h][i] = voffA[h][i]; } }
#pragma unroll 1
        for (int t = 0; t < nt; t += 2) {
            const bool last = (t == nt - 2);
            const char* a1 = cA + (size_t)(t + 1) * kstep;
            const char* a2 = last ? nA : cA + (size_t)(t + 2) * kstep; const char* b2 = last ? nBlo : PG8_BPTR(cBlo, cBhi, t + 2);
            const char* a3 = a2 + kstep; const char* b3 = b2 + kstep;
            PG8_LDB(B0, 0, 0); PG8_LDB(B1, 0, 1); PG8_SCHED; PG8_LDA(At, 0, 0); PG8_STAGE_A(PG8_SA(1, 1), a1, 1);
            if constexpr (GATHER) { if (last) {
#pragma unroll
                for (int h = 0; h < 2; ++h)
#pragma unroll
                    for (int i = 0; i < 2; ++i) voffA[h][i] = nvA[h][i]; } }
            PG8_WAIT_V(8); PG8_WAIT_L(0); PG8_BAR; PG8_MMA(0, 0, At, B0); PG8_MMA(0, 1, At, B1); PG8_BAR; PG8_SCHED;
            PG8_LDA(At, 0, 1); PG8_STAGE_B(PG8_SB(0, 0), b2, 0); PG8_STAGE_B(PG8_SB(0, 1), b2, 1); PG8_STAGE_A(PG8_SA(0, 0), a2, 0);
            PG8_WAIT_V(8); PG8_WAIT_L(0); PG8_BAR; PG8_MMA(1, 0, At, B0); PG8_MMA(1, 1, At, B1); PG8_BAR; PG8_SCHED;
            PG8_LDB(B0, 1, 0); PG8_LDB(B1, 1, 1); PG8_SCHED; PG8_LDA(At, 1, 0); PG8_STAGE_A(PG8_SA(0, 1), a2, 1);
            PG8_WAIT_V(8); PG8_WAIT_L(0); PG8_BAR; PG8_MMA(0, 0, At, B0); PG8_MMA(0, 1, At, B1); PG8_BAR; PG8_SCHED;
            PG8_LDA(At, 1, 1); PG8_STAGE_B(PG8_SB(1, 0), b3, 0); PG8_STAGE_B(PG8_SB(1, 1), b3, 1); PG8_STAGE_A(PG8_SA(1, 0), a3, 0);
            PG8_WAIT_V(8); PG8_WAIT_L(0); PG8_BAR; PG8_MMA(1, 0, At, B0); PG8_MMA(1, 1, At, B1); PG8_BAR; PG8_SCHED;
        }
        if constexpr (ALIGN_EPI) { if (wr == 0) PG8_BAR; }
        E(acc, cur, wr, wc, fr, fq);
        if (!has_next) break;
#pragma unroll
        for (int a = 0; a < 2; ++a)
#pragma unroll
            for (int b = 0; b < 2; ++b)
#pragma unroll
                for (int m = 0; m < 4; ++m)
#pragma unroll
                    for (int n = 0; n < 2; ++n) acc[a][b][m][n] = (f32x4){0.f, 0.f, 0.f, 0.f};
        cur = nxt; cA = nA; cBlo = nBlo; cBhi = nBhi; ++ui;
        if constexpr (ALIGN_EPI) { if (wr == 1) PG8_BAR; }
    }
    PG8_WAIT_V(0);
    if constexpr (!ALIGN_EPI) { if (wr == 0) PG8_BAR; }
    PG8_BAR;
#undef PG8_SA
#undef PG8_SB
#undef PG8_STAGE
#undef PG8_STAGE_A
#undef PG8_STAGE_B
#undef PG8_GATHER_OFFS
#undef PG8_LDA
#undef PG8_LDB
#undef PG8_MMA
#undef PG8_WAIT_V
#undef PG8_WAIT_L
#undef PG8_BAR
#undef PG8_SCHED
#undef PG8_BPTR
}
}

namespace attn_body {
using bf16=__hip_bfloat16;
using bf16x8=__attribute__((ext_vector_type(8)))short;
using s16x4=__attribute__((ext_vector_type(4)))short;
using f32x16=__attribute__((ext_vector_type(16)))float;
using u32x4=__attribute__((ext_vector_type(4)))unsigned;
constexpr int BATCH=4,NHEAD=16,SEQ=4096,D=64,DM=NHEAD*D;
constexpr int NW=8,QBLK=32,QB=QBLK*NW,KVBLK=64,NQB=SEQ/QB;
constexpr int ATTN_PITCH=DM, ATTN_UNIT_ROWS=QB;
__device__ __forceinline__ int crow(int r,int hi){return (r&3)+8*(r>>2)+4*hi;}
#define SBAR() __builtin_amdgcn_sched_barrier(0)
__device__ __forceinline__ void cmask(f32x16&p0,f32x16&p1,int jb,int qrel,int hi){
  const float NEG=-INFINITY; int kb=64*jb+4*hi;
  #pragma unroll
  for(int r=0;r<16;++r){int kv=kb+(r&3)+8*(r>>2); if(kv>qrel)p0[r]=NEG; if(kv+32>qrel)p1[r]=NEG;}
}

constexpr int NSLOT=3, SLOTB=8192;
constexpr int LDS_K=0, LDS_V=NSLOT*SLOTB, LDS_WS=2*NSLOT*SLOTB, LDS_OST=LDS_WS+NW*64*4, LDS_BYTES=LDS_OST+NW*4096;
constexpr float C2=0.125f*1.4426950408889634f;
__device__ __forceinline__ void glds16(const void*gsrc,unsigned lds_dst){unsigned keep;
  asm volatile("s_mov_b32 %0, m0\n\ts_mov_b32 m0, %2\n\ts_nop 0\n\tglobal_load_lds_dwordx4 %1, off\n\ts_mov_b32 m0, %0":"=&s"(keep):"v"(gsrc),"s"(lds_dst):"memory");}
__device__ __forceinline__ float max3f(float a,float b,float c){float r;asm("v_max3_f32 %0, %1, %2, %3":"=v"(r):"v"(a),"v"(b),"v"(c));return r;}
__device__ __forceinline__ float max2f(float a,float b){float r;asm("v_max_f32_e32 %0, %1, %2":"=v"(r):"v"(a),"v"(b));return r;}
__device__ __forceinline__ float fadd_s(float a,float b){float r;asm("v_add_f32_e32 %0, %1, %2":"=v"(r):"v"(a),"v"(b));return r;}
__device__ __forceinline__ float fsub_s(float a,float b){float r;asm("v_sub_f32_e32 %0, %1, %2":"=v"(r):"v"(a),"v"(b));return r;}
typedef float f32x2_t __attribute__((ext_vector_type(2))); typedef float f32x4_t __attribute__((ext_vector_type(4))); typedef __bf16 bf16x2_t __attribute__((ext_vector_type(2)));
__device__ __forceinline__ unsigned cvtpk_s(float lo,float hi){f32x2_t v={lo,hi};bf16x2_t b=__builtin_convertvector(v,bf16x2_t);return __builtin_bit_cast(unsigned,b);}
#define WAIT_BAR(N) asm volatile("s_waitcnt vmcnt(" #N ") lgkmcnt(0)\n\ts_barrier":::"memory")

__device__ __forceinline__ void qkt(f32x16&p0,f32x16&p1,const char*Kslot,const bf16x8*qr,const f32x16&negm,int r32,int hi){
  const char*kb=Kslot+hi*1024+r32*16;
  #pragma unroll
  for(int d0=0;d0<4;++d0){
    const bf16x8 b0=*reinterpret_cast<const bf16x8*>(kb+d0*2048);
    const bf16x8 b1=*reinterpret_cast<const bf16x8*>(kb+d0*2048+512);
    if(d0==0){p0=__builtin_amdgcn_mfma_f32_32x32x16_bf16(b0,qr[0],negm,0,0,0);p1=__builtin_amdgcn_mfma_f32_32x32x16_bf16(b1,qr[0],negm,0,0,0);}
    else{p0=__builtin_amdgcn_mfma_f32_32x32x16_bf16(b0,qr[d0],p0,0,0,0);p1=__builtin_amdgcn_mfma_f32_32x32x16_bf16(b1,qr[d0],p1,0,0,0);}}
}
typedef __attribute__((address_space(3))) const char* lds_cptr;
typedef short v4i16_t __attribute__((ext_vector_type(4)));
__device__ __forceinline__ void kload8(bf16x8*kf,lds_cptr kp){
  kf[0]=*(const __attribute__((address_space(3))) bf16x8*)(kp);      kf[1]=*(const __attribute__((address_space(3))) bf16x8*)(kp+512);
  kf[2]=*(const __attribute__((address_space(3))) bf16x8*)(kp+2048); kf[3]=*(const __attribute__((address_space(3))) bf16x8*)(kp+2560);
  kf[4]=*(const __attribute__((address_space(3))) bf16x8*)(kp+4096); kf[5]=*(const __attribute__((address_space(3))) bf16x8*)(kp+4608);
  kf[6]=*(const __attribute__((address_space(3))) bf16x8*)(kp+6144); kf[7]=*(const __attribute__((address_space(3))) bf16x8*)(kp+6656);
}
__device__ __forceinline__ void kload2(bf16x8*kf,lds_cptr kp,int j){ kf[2*j]=*(const __attribute__((address_space(3))) bf16x8*)(kp+j*2048); kf[2*j+1]=*(const __attribute__((address_space(3))) bf16x8*)(kp+j*2048+512); }
__device__ __forceinline__ s16x4 vtr(lds_cptr p){ return __builtin_bit_cast(s16x4,__builtin_amdgcn_ds_read_tr16_b64_v4i16((__attribute__((address_space(3))) v4i16_t*)p)); }
__device__ __forceinline__ float rowmax(const f32x16&p0,const f32x16&p1){
  float a=max3f(p0[0],p0[1],p1[0]),b=max3f(p0[2],p0[3],p1[1]);a=max3f(a,p1[2],p1[3]);
  #pragma unroll
  for(int r=4;r<16;r+=4){a=max3f(a,p0[r],p0[r+1]);b=max3f(b,p0[r+2],p0[r+3]);a=max3f(a,p1[r],p1[r+1]);b=max3f(b,p1[r+2],p1[r+3]);}
  const float m=max2f(a,b);
  auto rr=__builtin_amdgcn_permlane32_swap(__float_as_uint(m),__float_as_uint(m),false,false);
  return max2f(__uint_as_float(rr[0]),__uint_as_float(rr[1]));
}
__device__ __forceinline__ void pv(f32x16*o,int vb,bf16x8 pa0,bf16x8 pa1,bf16x8 pa2,bf16x8 pa3){
  #pragma unroll
  for(int d0=0;d0<2;++d0){s16x4 lo[4],hi[4];
    #pragma unroll
    for(int ks=0;ks<4;++ks){
      asm volatile("ds_read_b64_tr_b16 %0,%1 offset:%c2":"=&v"(lo[ks]):"v"(vb),"i"(d0*4096+ks*1024):"memory");
      asm volatile("ds_read_b64_tr_b16 %0,%1 offset:%c2":"=&v"(hi[ks]):"v"(vb),"i"(d0*4096+ks*1024+512):"memory");}
    asm volatile("s_waitcnt lgkmcnt(0)":::"memory");SBAR();
    #define PK(k) (bf16x8){lo[k][0],lo[k][1],lo[k][2],lo[k][3],hi[k][0],hi[k][1],hi[k][2],hi[k][3]}
    o[d0]=__builtin_amdgcn_mfma_f32_32x32x16_bf16(pa0,PK(0),o[d0],0,0,0);
    o[d0]=__builtin_amdgcn_mfma_f32_32x32x16_bf16(pa1,PK(1),o[d0],0,0,0);
    o[d0]=__builtin_amdgcn_mfma_f32_32x32x16_bf16(pa2,PK(2),o[d0],0,0,0);
    o[d0]=__builtin_amdgcn_mfma_f32_32x32x16_bf16(pa3,PK(3),o[d0],0,0,0);
    #undef PK
  }
}

#ifndef ATTN_STORE16
#define ATTN_STORE16(p,v) (*(u32x4*)(p)=(v))
#endif
template<int THRL> __device__ __forceinline__ void attn_unit(int b,int h,int qb,int t0,const bf16*Q,const bf16*__restrict__ K,const bf16*__restrict__ V,bf16*O,char*shm,const __attribute__((address_space(3))) float*ncum){
  int tid_=threadIdx.x; asm volatile("":"+v"(tid_)); const int tid=tid_,lane=tid&63,r32=lane&31,hi=lane>>5; const int wid=__builtin_amdgcn_readfirstlane(tid>>6);
  const long rowbase=(long)b*SEQ; const int q0=qb*QB;
  const bf16*Qw=Q+(rowbase+q0+wid*QBLK)*DM+h*D;
  const bf16*Kh=K+(rowbase+(long)t0*KVBLK)*DM+h*D,*Vh=V+(rowbase+(long)t0*KVBLK)*DM+h*D;
  const unsigned lds0=(unsigned)(uintptr_t)shm;
  float*wsf=(float*)(shm+LDS_WS)+wid*64;
  const bf16*ksrc=Kh+(long)lane*DM+wid*8;
  const bf16*vsrc=Vh+(long)(16*(wid&3)+(lane>>2))*DM+(wid>>2)*32+(lane&3)*8;
  const unsigned kdst=lds0+LDS_K+wid*1024, vdst=lds0+LDS_V+wid*1024;
  #define DMA_K(t,slot) glds16(ksrc+(long)(t)*KVBLK*DM,(unsigned)__builtin_amdgcn_readfirstlane(kdst+(slot)))
  #define DMA_V(t,slot) glds16(vsrc+(long)(t)*KVBLK*DM,(unsigned)__builtin_amdgcn_readfirstlane(vdst+(slot)))
  const int vb0=(int)(lds0+LDS_V)+((lane>>4)&1)*32+(lane&3)*8+(4*hi+((lane&15)>>2))*64;
  const char*Kbase=shm+LDS_K; bf16x8 kf[8];
  const lds_cptr shm3=(lds_cptr)shm; const lds_cptr kp0=shm3+LDS_K+hi*1024+r32*16; const lds_cptr vp0=shm3+LDS_V+((lane>>4)&1)*32+(lane&3)*8+(4*hi+((lane&15)>>2))*64;
  const int NT=(q0+QB)/KVBLK-t0;
  DMA_K(0,0);DMA_V(0,0);DMA_K(1,SLOTB);
  bf16x8 qr[4];
  #pragma unroll
  for(int d0=0;d0<4;++d0)qr[d0]=*reinterpret_cast<const bf16x8*>(&Qw[(long)r32*DM+d0*16+hi*8]);
  float mhat=ncum[q0-t0*KVBLK+wid*QBLK+r32],l_reg=0.f;f32x16 o[2];o[0]=f32x16{};o[1]=f32x16{};f32x16 negm; { float z_=-mhat; asm volatile("":"+v"(z_)); _Pragma("unroll") for(int r=0;r<16;++r)negm[r]=z_; } asm volatile("":"+v"(negm));
  const int qrel=wid*QBLK+r32;
  #define CMASK(P0,P1,t) do{int jb_=(t)-(NT-4); if(jb_>=0)cmask(P0,P1,jb_,qrel,hi);}while(0)
  #define CBIAS(P0,P1,t) do{ const __attribute__((address_space(3))) float*cb_=ncum+64*(t)+4*hi; \
    _Pragma("unroll") for(int g4=0;g4<4;++g4){ const f32x4_t b0_=*(const __attribute__((address_space(3))) f32x4_t*)(cb_+8*g4); const f32x4_t b1_=*(const __attribute__((address_space(3))) f32x4_t*)(cb_+32+8*g4); \
      P0[4*g4]+=b0_[0];P0[4*g4+1]+=b0_[1];P0[4*g4+2]+=b0_[2];P0[4*g4+3]+=b0_[3]; P1[4*g4]+=b1_[0];P1[4*g4+1]+=b1_[1];P1[4*g4+2]+=b1_[2];P1[4*g4+3]+=b1_[3]; } }while(0)
  bool resc=false;
  #define START(P0,P1) do{ const float rm=rowmax(P0,P1); resc=false; \
    { const float dl=max2f(rm,0.f); mhat=fadd_s(mhat,dl); \
      _Pragma("unroll") for(int r=0;r<16;++r){P0[r]=fsub_s(P0[r],dl);P1[r]=fsub_s(P1[r],dl);} \
      _Pragma("unroll") for(int r=0;r<16;++r)negm[r]=-mhat; asm volatile("":"+v"(negm)); } \
    _Pragma("unroll") for(int r=0;r<16;++r)P0[r]=__builtin_amdgcn_exp2f(P0[r]); }while(0)
  #define RESC() do{ if(resc){ asm volatile("s_waitcnt lgkmcnt(0)":::"memory"); \
      _Pragma("unroll") for(int d_=0;d_<2;++d_) _Pragma("unroll") for(int r=0;r<16;++r)o[d_][r]*=wsf[crow(r,hi)]; } }while(0)
  f32x16 pA0,pA1,pB0,pB1;
  int sl_prev=0,sl_cur=0,sl_next=SLOTB;
  #define ROT() do{sl_prev=sl_cur;sl_cur=sl_next;sl_next=(sl_next==(NSLOT-1)*SLOTB)?0:sl_next+SLOTB;}while(0)
  DMA_K(2,2*SLOTB);
  WAIT_BAR(3);
  qkt(pA0,pA1,Kbase,qr,negm,r32,hi);asm volatile("s_nop 15\n\ts_nop 7":"+v"(pA0),"+v"(pA1));CBIAS(pA0,pA1,0);CMASK(pA0,pA1,0);
  START(pA0,pA1);
  _Pragma("unroll") for(int r=0;r<16;++r)pA1[r]=__builtin_amdgcn_exp2f(pA1[r]);
  WAIT_BAR(0);
  DMA_K(3,0);DMA_V(1,SLOTB);
  ROT();
  kload8(kf,kp0+sl_cur);
  WAIT_BAR(2);
  s16x4 vlo[8],vhi[8]; u32x4 pw0,pw1,pw2,pw3;
  #define PKW(P,B) cvtpk_s(P[B],P[B+1])
  #define PAF(k) __builtin_bit_cast(bf16x8,pw##k)
  #define VFR(i) (bf16x8){vlo[i][0],vlo[i][1],vlo[i][2],vlo[i][3],vhi[i][0],vhi[i][1],vhi[i][2],vhi[i][3]}
  #define PIN(x) asm volatile("":"+v"(x))
  #define MX3(a,b,c) __builtin_fmaxf(__builtin_fmaxf((a),(b)),(c))
  #define GAPA(MF,A0,A1,A2,A3,W0,W1,PW) do{ MF; sacc+=A0; sacc+=A1; sacc+=A2; sacc+=A3; PIN(sacc); W0; W1; PIN(PW); SBAR(); }while(0)
  #define EX(v) __builtin_amdgcn_exp2f(v)
  #define GAPB(MF,X,B) do{ MF; X[B]=EX(X[B]); X[B+1]=EX(X[B+1]); X[B+2]=EX(X[B+2]); X[B+3]=EX(X[B+3]); PIN(X); SBAR(); }while(0)
  #define VRD(i) do{ vlo[i]=vtr(vp_+(((i)>>2)*4096+((i)&3)*1024)); vhi[i]=vtr(vp_+(((i)>>2)*4096+((i)&3)*1024+512)); }while(0)
  #define KRD(G,j) do{ if(G){ kload2(kf,kp0+sl_next,j); SBAR(); } }while(0)
  #define STEP(C0,C1,P0,P1,t,GK,GV,GL) do{ SBAR(); \
    const lds_cptr vp_=vp0+sl_prev; \
    VRD(0); SBAR(); float sacc=(P0[0]+P0[1]); \
    GAPA(C0=__builtin_amdgcn_mfma_f32_32x32x16_bf16(kf[0],qr[0],negm,0,0,0), P0[2],P0[3],P0[4],P0[5],     pw0[0]=PKW(P0,0), pw0[1]=PKW(P0,2), pw0); \
    VRD(4); SBAR(); GAPA(C1=__builtin_amdgcn_mfma_f32_32x32x16_bf16(kf[1],qr[0],negm,0,0,0), P0[6],P0[7],P0[8],P0[9],     pw0[2]=PKW(P0,4), pw0[3]=PKW(P0,6), pw0); \
    VRD(1); SBAR(); GAPA(C0=__builtin_amdgcn_mfma_f32_32x32x16_bf16(kf[2],qr[1],C0,0,0,0),   P0[10],P0[11],P0[12],P0[13], pw1[0]=PKW(P0,8), pw1[1]=PKW(P0,10), pw1); \
    VRD(5); SBAR(); GAPA(C1=__builtin_amdgcn_mfma_f32_32x32x16_bf16(kf[3],qr[1],C1,0,0,0),   P0[14],P0[15],P1[0],P1[1],   pw1[2]=PKW(P0,12),pw1[3]=PKW(P0,14), pw1); \
    VRD(2); SBAR(); GAPA(C0=__builtin_amdgcn_mfma_f32_32x32x16_bf16(kf[4],qr[2],C0,0,0,0),   P1[2],P1[3],P1[4],P1[5],     pw2[0]=PKW(P1,0), pw2[1]=PKW(P1,2), pw2); \
    VRD(6); SBAR(); GAPA(C1=__builtin_amdgcn_mfma_f32_32x32x16_bf16(kf[5],qr[2],C1,0,0,0),   P1[6],P1[7],P1[8],P1[9],     pw2[2]=PKW(P1,4), pw2[3]=PKW(P1,6), pw2); \
    VRD(3); SBAR(); GAPA(C0=__builtin_amdgcn_mfma_f32_32x32x16_bf16(kf[6],qr[3],C0,0,0,0),   P1[10],P1[11],P1[12],P1[13], pw3[0]=PKW(P1,8), pw3[1]=PKW(P1,10), pw3); \
    VRD(7); SBAR(); GAPA(C1=__builtin_amdgcn_mfma_f32_32x32x16_bf16(kf[7],qr[3],C1,0,0,0),   P1[14],P1[15],0.f,0.f,       pw3[2]=PKW(P1,12),pw3[3]=PKW(P1,14), pw3); \
    l_reg+=sacc; \
    if(GK){DMA_K((t)+3,sl_cur);} if(GV){DMA_V((t)+1,sl_next);} \
    CBIAS(C0,C1,t); CMASK(C0,C1,t); \
    { float a=MX3(C0[0],C0[1],C1[0]),b=MX3(C0[2],C0[3],C1[1]); a=MX3(a,C1[2],C1[3]); \
      _Pragma("unroll") for(int r=4;r<16;r+=4){a=MX3(a,C0[r],C0[r+1]);b=MX3(b,C0[r+2],C0[r+3]);a=MX3(a,C1[r],C1[r+1]);b=MX3(b,C1[r+2],C1[r+3]);} \
      float rm=__builtin_fmaxf(a,b); { auto rr=__builtin_amdgcn_permlane32_swap(__float_as_uint(rm),__float_as_uint(rm),false,false); rm=__builtin_fmaxf(__uint_as_float(rr[0]),__uint_as_float(rr[1])); } \
      resc=false; \
      if(__builtin_expect(__any(rm>(float)THRL),0)){ const float dl=__builtin_fmaxf(rm,0.f); mhat+=dl; \
        _Pragma("unroll") for(int r=0;r<16;++r){C0[r]-=dl;C1[r]-=dl;} \
        _Pragma("unroll") for(int r=0;r<16;++r)negm[r]=-mhat; asm volatile("":"+v"(negm)); \
        const float f=__builtin_amdgcn_exp2f(-dl); l_reg*=f; if(hi==0)wsf[r32]=f; resc=true; } } \
    SBAR(); \
    GAPB(o[0]=__builtin_amdgcn_mfma_f32_32x32x16_bf16(PAF(0),VFR(0),o[0],0,0,0), C0,0); \
    GAPB(o[1]=__builtin_amdgcn_mfma_f32_32x32x16_bf16(PAF(0),VFR(4),o[1],0,0,0), C0,4); \
    KRD(GL,0); GAPB(o[0]=__builtin_amdgcn_mfma_f32_32x32x16_bf16(PAF(1),VFR(1),o[0],0,0,0), C0,8); \
    KRD(GL,1); GAPB(o[1]=__builtin_amdgcn_mfma_f32_32x32x16_bf16(PAF(1),VFR(5),o[1],0,0,0), C0,12); \
    KRD(GL,2); GAPB(o[0]=__builtin_amdgcn_mfma_f32_32x32x16_bf16(PAF(2),VFR(2),o[0],0,0,0), C1,0); \
    KRD(GL,3); GAPB(o[1]=__builtin_amdgcn_mfma_f32_32x32x16_bf16(PAF(2),VFR(6),o[1],0,0,0), C1,4); \
    GAPB(o[0]=__builtin_amdgcn_mfma_f32_32x32x16_bf16(PAF(3),VFR(3),o[0],0,0,0), C1,8); \
    GAPB(o[1]=__builtin_amdgcn_mfma_f32_32x32x16_bf16(PAF(3),VFR(7),o[1],0,0,0), C1,12); \
    }while(0)
  int t=1;
  #undef CMASK
  #define CMASK(P0,P1,t) do{}while(0)
  for(;t+5<NT;t+=2){
    STEP(pB0,pB1,pA0,pA1,t,true,true,true);     WAIT_BAR(2); RESC(); ROT();
    STEP(pA0,pA1,pB0,pB1,t+1,true,true,true);   WAIT_BAR(2); RESC(); ROT();
  }
  #undef CMASK
  #define CMASK(P0,P1,t) do{int jb_=(t)-(NT-4); if(jb_>=0)cmask(P0,P1,jb_,qrel,hi);}while(0)
  #define ENDW(tt) do{ if((tt)+3<NT){WAIT_BAR(2);} else if((tt)+2<NT){WAIT_BAR(1);} else {WAIT_BAR(0);} }while(0)
  for(;t+1<NT;t+=2){
    STEP(pB0,pB1,pA0,pA1,t,(t+3<NT),(t+1<NT),(t+1<NT));       ENDW(t);   RESC(); ROT();
    STEP(pA0,pA1,pB0,pB1,t+1,(t+4<NT),(t+2<NT),(t+2<NT));     ENDW(t+1); RESC(); ROT();
  }
  STEP(pB0,pB1,pA0,pA1,NT-1,false,false,false); RESC();
  { float sacc=pB0[0]+pB0[1]; _Pragma("unroll") for(int r=2;r<16;++r)sacc+=pB0[r]; _Pragma("unroll") for(int r=0;r<16;++r)sacc+=pB1[r]; l_reg+=sacc;
    pw0=(u32x4){PKW(pB0,0),PKW(pB0,2),PKW(pB0,4),PKW(pB0,6)};pw1=(u32x4){PKW(pB0,8),PKW(pB0,10),PKW(pB0,12),PKW(pB0,14)};pw2=(u32x4){PKW(pB1,0),PKW(pB1,2),PKW(pB1,4),PKW(pB1,6)};pw3=(u32x4){PKW(pB1,8),PKW(pB1,10),PKW(pB1,12),PKW(pB1,14)};
    SBAR(); pv(o,vb0+sl_cur,PAF(0),PAF(1),PAF(2),PAF(3)); }
  #undef PKW
  #undef PAF
  #undef VFR
  #undef PIN
  #undef MX3
  #undef GAPA
  #undef GAPB
  #undef EX
  #undef VRD
  #undef KRD
  #undef STEP
  #undef ENDW
  {auto rr=__builtin_amdgcn_permlane32_swap(__float_as_uint(l_reg),__float_as_uint(l_reg),false,false);l_reg=__uint_as_float(rr[0])+__uint_as_float(rr[1]);}
  if(hi==0)wsf[32+r32]=l_reg;asm volatile("s_waitcnt lgkmcnt(0)":::"memory");
  float rli[16];
  #pragma unroll
  for(int r=0;r<16;++r)rli[r]=__builtin_amdgcn_rcpf(wsf[32+crow(r,hi)]);
  bf16*Ow=O+(rowbase+q0+wid*QBLK)*DM+h*D;
  { bf16*stg=(bf16*)(shm+LDS_OST)+wid*2048;
    #pragma unroll
    for(int r=0;r<16;++r){const int orow=crow(r,hi);
      #pragma unroll
      for(int d0=0;d0<2;++d0)stg[orow*64+d0*32+r32]=__float2bfloat16(o[d0][r]*rli[r]);}
    asm volatile("s_waitcnt lgkmcnt(0)":::"memory");
    #pragma unroll
    for(int i=0;i<4;++i){const int row=i*8+(lane>>3),ch=lane&7; const u32x4 v=*(const u32x4*)(stg+row*64+ch*8); ATTN_STORE16(Ow+(long)row*DM+ch*8,v);} }
  asm volatile("s_waitcnt lgkmcnt(0)\n\ts_barrier":::"memory");
  #undef DMA_K
  #undef DMA_V
  #undef CMASK
  #undef CBIAS
  #undef START
  #undef RESC
  #undef ROT
}
constexpr int ATTN_LDS_BYTES=LDS_BYTES;
struct AttnTensors { const bf16* Q; const bf16* K; const bf16* V; bf16* O; };
__device__ __forceinline__ void fox_phase(char*lds,const bf16*Q,const bf16*K,const bf16*V,bf16*O,const float*CUM,const float*qg,const float*kg,int grid,int block){
  const int vcu=(grid%8==0)?(block%8)*(grid/8)+block/8:block; const int bh=vcu>>2, s=vcu&3;
  if(bh>=BATCH*NHEAD)return;
  float*nc=(float*)(lds+98304);
  for(int i=threadIdx.x;i<SEQ;i+=512)nc[i]=CUM[(size_t)bh*SEQ+i];
  const int lane=threadIdx.x&63;
  float gq=fabsf(qg[lane]),gk=fabsf(kg[lane]);
  #pragma unroll
  for(int o=1;o<64;o<<=1){gq=fmaxf(gq,__shfl_xor(gq,o));gk=fmaxf(gk,__shfl_xor(gk,o));}
  const float thresh=2.0f*(8.0f*gq*C2)*(8.0f*gk)*1.02f+32.0f;
  __syncthreads();
  const __attribute__((address_space(3))) float*ncum=(const __attribute__((address_space(3))) float*)(nc);
  for(int i=0;i<4;++i){ const int qb=(i==0)?s:(i==1)?7-s:(i==2)?8+s:15-s; const int NTf=4*qb+4;
    const bool ok=(lane<NTf-4)&&(ncum[qb*QB]-ncum[64*lane+63]>=thresh);
    int t0=__builtin_popcountll(__ballot(ok))&~1; t0=__builtin_amdgcn_readfirstlane(t0);
    attn_unit<8>(bh/NHEAD,bh%NHEAD,qb,t0,Q,K,V,O,lds,ncum+64*t0); }
}
template<int R> __device__ __forceinline__ void dil_unit(int g,int b,int j,int nb,int hp,const bf16*Q,const bf16*__restrict__ K,const bf16*__restrict__ V,const float*__restrict__ BIASV,bf16*ORUN,float*LSE,char*shm,char*aux){
  typedef __attribute__((address_space(3))) char* lptr;
  int tid_=threadIdx.x; asm volatile("":"+v"(tid_)); const int tid=tid_,lane=tid&63,r32=lane&31,hi=lane>>5; const int wid=__builtin_amdgcn_readfirstlane(tid>>6);
  const int hl=wid>>2,qs=wid&3,h=2*hp+hl;
  const unsigned lds0=(unsigned)(uintptr_t)shm;
  float*bvl=(float*)aux;
  float*wsf=(float*)(aux+2048)+wid*64;
  const long rowbase=(long)b*SEQ;
  { const int wv=tid>>6, rowK=(lane&15)+16*(wv&3), chK=(lane>>4)+4*(wv>>2), rowV=(lane>>2)+16*(wv&3), chV=(lane&3)+4*(wv>>2); u32x4 val[16];
    #pragma unroll
    for(int it=0;it<16;++it){ const int kt=it&3,kv=(it>>2)&1,hh=it>>3; val[it]=(u32x4){0u,0u,0u,0u}; const int row=kv?rowV:rowK, ch=kv?chV:chK;
      if(nb>0||kt>=2){ const int kp=nb*128-128+kt*64+row; const bf16*src=(kv?V:K)+(rowbase+(long)kp*R+j)*DM+(2*hp+hh)*D+ch*8; val[it]=*reinterpret_cast<const u32x4*>(src); } }
    { const int hh=tid>>8, x=tid&255, dd=x-64; bvl[hh*256+x]=(dd>=0&&dd<=128)?BIASV[(g*16+2*hp+hh)*132+dd]:-1e30f; }
    #pragma unroll
    for(int it=0;it<16;++it){ const int kt=it&3,kv=(it>>2)&1,hh=it>>3; const int row=kv?rowV:rowK, ch=kv?chV:chK;
      const int off=hh*65536+kv*32768+kt*8192+(kv?((ch>>2)*4096+row*64+(ch&3)*16):(ch*1024+row*16));
      if(nb>0||kt>=2||kv) *reinterpret_cast<__attribute__((address_space(3))) u32x4*>((lptr)shm+off)=val[it]; }
  }
  const int p0q=nb*128+32*qs;
  const bf16*Qw=Q+(rowbase+(long)(p0q+r32)*R+j)*DM+h*D;
  bf16x8 qr[4];
  #pragma unroll
  for(int d0=0;d0<4;++d0)qr[d0]=*reinterpret_cast<const bf16x8*>(&Qw[d0*16+hi*8]);
  const long orow=rowbase+(long)(p0q+r32)*R+j;
  float lr_old=0.f; u32x4 ov_old[4];
  #pragma unroll
  for(int i=0;i<4;++i)ov_old[i]=(u32x4){0u,0u,0u,0u};
  if(g>0){ lr_old=LSE[orow*16+h];
    #pragma unroll
    for(int i=0;i<4;++i){const int row=i*8+(lane>>3),ch=lane&7; ov_old[i]=*(const u32x4*)(ORUN+(rowbase+(long)(p0q+row)*R+j)*DM+h*D+ch*8);} }
  asm volatile("s_waitcnt vmcnt(0) lgkmcnt(0)\n\ts_barrier":::"memory");
  const int ktlo=(qs>=2)?1:0;
  const char*Kh=shm+hl*65536;
  const __attribute__((address_space(3))) float*eb=(const __attribute__((address_space(3))) float*)((lptr)aux)+hl*256+(32*qs+128-64*ktlo)+r32-4*hi-123;
  f32x16 s0[3],s1[3];
  #pragma unroll
  for(int i=0;i<3;++i){ const int kt=ktlo+i; f32x16 z=f32x16{};
    qkt(s0[i],s1[i],Kh+kt*8192,qr,z,r32,hi);
    if(nb==0&&kt<2){
      #pragma unroll
      for(int r=0;r<16;++r){s0[i][r]=-1e30f;s1[i][r]=-1e30f;} }
    else {
      #pragma unroll
      for(int r=0;r<16;++r){ const int c=(r&3)+8*(r>>2); s0[i][r]+=eb[59-c+128-64*i]; s1[i][r]+=eb[59-c-32+128-64*i]; } } }
  float mx=-1e30f;
  #pragma unroll
  for(int i=0;i<3;++i)
    #pragma unroll
    for(int r=0;r<16;++r)mx=fmaxf(mx,fmaxf(s0[i][r],s1[i][r]));
  { auto rr=__builtin_amdgcn_permlane32_swap(__float_as_uint(mx),__float_as_uint(mx),false,false); mx=fmaxf(__uint_as_float(rr[0]),__uint_as_float(rr[1])); }
  float l=0.f;
  #pragma unroll
  for(int i=0;i<3;++i)
    #pragma unroll
    for(int r=0;r<16;++r){ s0[i][r]=__builtin_amdgcn_exp2f(s0[i][r]-mx); s1[i][r]=__builtin_amdgcn_exp2f(s1[i][r]-mx); l+=s0[i][r]+s1[i][r]; }
  { auto rr=__builtin_amdgcn_permlane32_swap(__float_as_uint(l),__float_as_uint(l),false,false); l=__uint_as_float(rr[0])+__uint_as_float(rr[1]); }
  f32x16 o[2]; o[0]=f32x16{}; o[1]=f32x16{};
  const int vb0=(int)lds0+hl*65536+32768+((lane>>4)&1)*32+(lane&3)*8+(4*hi+((lane&15)>>2))*64;
  #define PKW(P,B) cvtpk_s(P[B],P[B+1])
  #pragma unroll
  for(int i=0;i<3;++i){ const int kt=ktlo+i;
    const u32x4 pw0=(u32x4){PKW(s0[i],0),PKW(s0[i],2),PKW(s0[i],4),PKW(s0[i],6)},pw1=(u32x4){PKW(s0[i],8),PKW(s0[i],10),PKW(s0[i],12),PKW(s0[i],14)};
    const u32x4 pw2=(u32x4){PKW(s1[i],0),PKW(s1[i],2),PKW(s1[i],4),PKW(s1[i],6)},pw3=(u32x4){PKW(s1[i],8),PKW(s1[i],10),PKW(s1[i],12),PKW(s1[i],14)};
    pv(o,vb0+kt*8192,__builtin_bit_cast(bf16x8,pw0),__builtin_bit_cast(bf16x8,pw1),__builtin_bit_cast(bf16x8,pw2),__builtin_bit_cast(bf16x8,pw3)); }
  #undef PKW
  float lse=mx*0.6931471805599453f+__logf(l), a=1.0f/l, bco=0.f;
  if(g>0){ const float lr=lr_old; const float mxl=fmaxf(lr,lse), nl=mxl+__logf(__expf(lr-mxl)+__expf(lse-mxl)); a=__expf(lse-nl)/l; bco=__expf(lr-nl); lse=nl; }
  if(hi==0){ wsf[r32]=a; wsf[32+r32]=bco; LSE[orow*16+h]=lse; }
  asm volatile("s_waitcnt lgkmcnt(0)\n\ts_barrier":::"memory");
  float av[16];
  #pragma unroll
  for(int r=0;r<16;++r)av[r]=wsf[crow(r,hi)];
  { bf16*stg=(bf16*)(shm)+wid*2048;
    #pragma unroll
    for(int r=0;r<16;++r){const int orw=crow(r,hi);
      #pragma unroll
      for(int d0=0;d0<2;++d0)stg[orw*64+d0*32+r32]=__float2bfloat16(o[d0][r]*av[r]);}
    asm volatile("s_waitcnt lgkmcnt(0)":::"memory");
    #pragma unroll
    for(int i=0;i<4;++i){const int row=i*8+(lane>>3),ch=lane&7; u32x4 v=*(const u32x4*)(stg+row*64+ch*8);
      bf16*dst=ORUN+(rowbase+(long)(p0q+row)*R+j)*DM+h*D+ch*8;
      if(g>0){ const float bc=wsf[32+row]; const u32x4 ov=ov_old[i]; u32x4 w;
        #pragma unroll
        for(int q=0;q<4;++q){ const float n0=__uint_as_float(v[q]<<16)+bc*__uint_as_float(ov[q]<<16), n1=__uint_as_float(v[q]&0xffff0000u)+bc*__uint_as_float(ov[q]&0xffff0000u); w[q]=cvtpk_s(n0,n1); }
        v=w; }
      *(u32x4*)dst=v; } }
  asm volatile("s_waitcnt lgkmcnt(0)\n\ts_barrier":::"memory");
}
template<int R> __device__ __forceinline__ void dil_phase(int g,char*lds,char*aux,const bf16*Q,const bf16*K,const bf16*V,const float*BIASV,bf16*ORUN,float*LSE,int grid,int block){
  constexpr int NBK=32/R;
  for(int L=block;L<1024;L+=grid){ const int hp=L&7,rest=L>>3,nb=rest%NBK,z=rest/NBK; dil_unit<R>(g,z/R,z%R,nb,hp,Q,K,V,BIASV,ORUN,LSE,lds,aux); }
}
#undef SBAR
#undef WAIT_BAR
}

__device__ __forceinline__ LAS int* moe_tables(Frame& F, int layer, bool combo) {
    LAS int* tab = (LAS int*)(F.lds + LDSCTL_OFF + 1024);
    const int nl = combo ? 24 : 16;
    if (F.tid < nl) tab[32 + F.tid] = (int)__hip_atomic_load(F.ctl + CW_CNT + (layer * 40 + (combo ? 16 : 0) + F.tid) * 64, RLX_AGENT);
    __syncthreads();
    if (F.tid == 0) { int run = 0;
        for (int k = 0; k < nl; ++k) { tab[k] = run; run += (tab[32 + k] + 255) >> 8; }
        tab[nl] = run; }
    __syncthreads();
    return tab;
}

#define MOE_PHASES(layer, P1, P2) \
    PHASE(P1) { LAS int* tab = moe_tables(F, layer, false); \
        pg8::MoeOrder S{F.G, (int)blockIdx.x, 16, 2, 16, 1, (const char*)(F.ws + WS_HM), (const char*)(F.ws + WS_MOE1 + (size_t)(layer) * 16 * 512 * 1024 * 2), (const int*)(F.ws + WS_ELIST), tab}; \
        pg8::EpiMoe1 E{(const int*)(F.ws + WS_ELIST), (const v4u*)(F.ws + WS_TOKREC), (bf16*)(F.ws + WS_HID2), F.flags & 4}; \
        pg8::gemm_phase<pg8::EpiMoe1, pg8::MoeOrder, true, true>(F.lds + RING_OFF, 1024, 1024, 1024, S, E); SEAM(P1); } \
    PHASE(P2) { LAS int* tab = moe_tables(F, layer, true); \
        { LAS float* gt = (LAS float*)(F.lds + GTAB_OFF); const float* gv = (const float*)(F.ws + WS_MOD) + (size_t)(layer) * 4 * 6144 + 5 * D; const float gs = (F.flags & 1) ? 0.5f : 1.0f; \
          for (int i = F.tid; i < 4 * D; i += NWAVES * 64) gt[i] = gv[(size_t)(i >> 10) * 6144 + (i & 1023)] * gs; __syncthreads(); } \
        pg8::MoeOrder S{F.G, (int)blockIdx.x, 24, 4, 4, 2, (const char*)(F.ws + WS_HID2), (const char*)(F.ws + WS_MOE2 + (size_t)(layer) * 16 * 1024 * 256 * 2), (const int*)(F.ws + WS_CLIST), tab}; \
        pg8::EpiMoe2 E{(const int*)(F.ws + WS_CLIST), F.out, (const LAS float*)(F.lds + GTAB_OFF), F.flags & 4}; \
        pg8::gemm_phase<pg8::EpiMoe2, pg8::MoeOrder, true, true>(F.lds + RING_OFF, 512, 256, 512, S, E); SEAM(P2); }

__global__ void __launch_bounds__(NWAVES * 64, 2) mk_fwd(Args args) {
    extern __shared__ __attribute__((aligned(16))) unsigned char lds[];
    Frame F;
    F.lds = (LAS unsigned char*)lds;
    F.MISC = (volatile LAS unsigned*)(F.lds + MISC_OFF);
    F.tid = threadIdx.x; F.lane = F.tid & 63; F.wave = __builtin_amdgcn_readfirstlane(F.tid >> 6);
    F.G = gridDim.x; { const int bx = blockIdx.x; F.vcu = (F.G % 8 == 0) ? (bx % 8) * (F.G / 8) + bx / 8 : bx; }
    F.ws = args.ws; F.ctl = (gu32*)(args.ws + WS_CTL); F.in = args.in; F.out = args.out; F.flags = args.flags;
    for (int u = F.tid; u < (LDS_BYTES - LDSCTL_OFF) / 4; u += NWAVES * 64) ((LAS unsigned*)(F.lds + LDSCTL_OFF))[u] = 0u;
    __syncthreads();
    XcdBarrier bar; bar.bar = (unsigned*)(F.ctl + CW_BAR); bar.x = 0; bar.st = nullptr;
    if (MK_MODE == 0) bar = xcd_barrier_post((unsigned*)(F.ctl + CW_BAR), F.MISC + 8);
    const int lo = args.ph_lo, hi = args.ph_hi;
#define IN(k) (lo <= (k) && (k) < hi && frame_refresh(F))
#define PHASE(k) if (IN(k)) for (int rep_ = 0; rep_ < ((((DUP_MASK) >> (k)) & 1u) ? 2 : 1); ++rep_)
#define SEAM(k) do { if (MK_MODE == 0 && lo <= (k) + 1 && (k) + 1 < hi) xcd_barrier(bar); } while (0)

    PHASE(PH_PRO) { p0_prologue(F); SEAM(PH_PRO); }
    PHASE(PH_ROW_A) { rowpass<0>(F, F.in[I_X], F.in[I_NMIX], 0, 0, 1); SEAM(PH_ROW_A); }
    {
#pragma unroll
        for (int g = 0; g < 3; ++g) {
            PHASE(PH_QKV_A0 + 2 * g) {
                pg8::StaticOrder S; S.init(M, 3072, F.G, (int)blockIdx.x, F.ws + WS_HM, 1024, F.ws + WS_WAIN + (size_t)g * 3072 * 1024 * 2, 1024, 16);
                pg8::EpiQKV E{(bf16*)(F.ws + WS_Q), F.in[I_AQN], F.in[I_AKN]};
                pg8::gemm_phase<pg8::EpiQKV, pg8::StaticOrder, false, true>(F.lds + RING_OFF, 1024, 1024, 1024, S, E);
                SEAM(PH_QKV_A0 + 2 * g);
            }
            PHASE(PH_ATT_A0 + 2 * g) {
                typedef attn_body::bf16 ab16;
                if (g == 0) attn_body::dil_phase<1>(0, (char*)lds + RING_OFF, (char*)lds + LDSCTL_OFF + 2048, (const ab16*)(F.ws + WS_Q), (const ab16*)(F.ws + WS_K), (const ab16*)(F.ws + WS_V), (const float*)(F.ws + WS_BIASV), (ab16*)(F.ws + WS_ORUN), (float*)(F.ws + WS_LSE), F.G, (int)blockIdx.x);
                if (g == 1) attn_body::dil_phase<4>(1, (char*)lds + RING_OFF, (char*)lds + LDSCTL_OFF + 2048, (const ab16*)(F.ws + WS_Q), (const ab16*)(F.ws + WS_K), (const ab16*)(F.ws + WS_V), (const float*)(F.ws + WS_BIASV), (ab16*)(F.ws + WS_ORUN), (float*)(F.ws + WS_LSE), F.G, (int)blockIdx.x);
                if (g == 2) attn_body::dil_phase<16>(2, (char*)lds + RING_OFF, (char*)lds + LDSCTL_OFF + 2048, (const ab16*)(F.ws + WS_Q), (const ab16*)(F.ws + WS_K), (const ab16*)(F.ws + WS_V), (const float*)(F.ws + WS_BIASV), (ab16*)(F.ws + WS_ORUN), (float*)(F.ws + WS_LSE), F.G, (int)blockIdx.x);
                SEAM(PH_ATT_A0 + 2 * g);
            }
        }
    }
    PHASE(PH_OUT_A) {
        pg8::StaticOrder S; S.init(M, 1024, F.G, (int)blockIdx.x, F.ws + WS_ORUN, 1024, F.ws + WS_WAOUT, 1024, 16);
        pg8::EpiOut E{F.in[I_X], F.out, (const float*)(F.ws + WS_MOD) + 2 * D};
        pg8::gemm_phase<pg8::EpiOut, pg8::StaticOrder, false, false>(F.lds + RING_OFF, 1024, 1024, 1024, S, E);
        SEAM(PH_OUT_A);
    }
    PHASE(PH_ROW_F0) { rowpass<2>(F, F.out, F.in[I_NFFN], 0, 3, 4); SEAM(PH_ROW_F0); }
    MOE_PHASES(0, PH_MOE1_0, PH_MOE2_0)
    PHASE(PH_ROW_B) { rowpass<1>(F, F.out, F.in[I_NMIX] + D, 1, 0, 1); SEAM(PH_ROW_B); }
    PHASE(PH_CUM) { cumsum_phase(F); }
    PHASE(PH_QKV_B) {
        pg8::StaticOrder S; S.init(M, 3072, F.G, (int)blockIdx.x, F.ws + WS_HM, 1024, F.ws + WS_WBIN, 1024, 16);
        pg8::EpiQKV E{(bf16*)(F.ws + WS_Q), F.in[I_BQN], F.in[I_BKN]};
        pg8::gemm_phase<pg8::EpiQKV, pg8::StaticOrder, false, true>(F.lds + RING_OFF, 1024, 1024, 1024, S, E);
        SEAM(PH_QKV_B);
    }
    PHASE(PH_ATT_B) {
        typedef attn_body::bf16 ab16;
        attn_body::fox_phase((char*)lds + RING_OFF, (const ab16*)(F.ws + WS_Q), (const ab16*)(F.ws + WS_K), (const ab16*)(F.ws + WS_V), (ab16*)(F.ws + WS_ORUN), (const float*)(F.ws + WS_CUM), F.in[I_BQN], F.in[I_BKN], F.G, (int)blockIdx.x);
        SEAM(PH_ATT_B);
    }
    PHASE(PH_OUT_B) {
        pg8::StaticOrder S; S.init(M, 1024, F.G, (int)blockIdx.x, F.ws + WS_ORUN, 1024, F.ws + WS_WBOUT, 1024, 16);
        pg8::EpiOut E{F.out, F.out, (const float*)(F.ws + WS_MOD) + (size_t)4 * 6144 + 2 * D};
        pg8::gemm_phase<pg8::EpiOut, pg8::StaticOrder, false, false>(F.lds + RING_OFF, 1024, 1024, 1024, S, E);
        SEAM(PH_OUT_B);
    }
    PHASE(PH_ROW_F1) { rowpass<2>(F, F.out, F.in[I_NFFN] + D, 1, 3, 4); SEAM(PH_ROW_F1); }
    MOE_PHASES(1, PH_MOE1_1, PH_MOE2_1)
#undef IN
#undef PHASE
#undef SEAM
}

__global__ void __launch_bounds__(256) nk_qkv(const bf16* __restrict__ A, const float* __restrict__ W, int ldw, int col0, const float* __restrict__ qg, const float* __restrict__ kg,
                                              bf16* Qo, bf16* Ko, bf16* Vo) {
    const long gw = ((long)blockIdx.x * blockDim.x + threadIdx.x) >> 6; const int lane = threadIdx.x & 63;
    if (gw >= (long)M * 48) return;
    const int m = (int)(gw / 48), ch = (int)(gw % 48), t = ch / 16, h = ch % 16;
    const bf16* a = A + (size_t)m * D; const float* w = W + col0 + ch * 64 + lane;
    float acc = 0.f;
    for (int k = 0; k < D; ++k) acc += bf2f(a[k]) * w[(size_t)k * ldw];
    if (t < 2) { const float ss = wave_sum(acc * acc) * (1.f / 64.f); const float g = (t == 0 ? qg : kg)[lane]; acc = acc * (1.0f / sqrtf(ss + EPS)) * g; if (t == 0) acc *= C2; }
    bf16* o = (t == 0 ? Qo : (t == 1 ? Ko : Vo)); o[(size_t)m * D + h * 64 + lane] = (bf16)f2bf(acc);
}
__global__ void __launch_bounds__(256) nk_out(const bf16* __restrict__ A, const float* __restrict__ W, const float* xin, const float* __restrict__ gvec, float* xout) {
    const long gw = ((long)blockIdx.x * blockDim.x + threadIdx.x) >> 6; const int lane = threadIdx.x & 63;
    if (gw >= (long)M * 16) return;
    const int m = (int)(gw / 16), c = (int)(gw % 16) * 64 + lane, b = m / SEQ;
    const bf16* a = A + (size_t)m * D; float acc = 0.f;
    for (int k = 0; k < D; ++k) acc += bf2f(a[k]) * W[(size_t)k * D + c];
    xout[(size_t)m * D + c] = xin[(size_t)m * D + c] + gvec[(size_t)b * 6144 + c] * acc;
}
__global__ void __launch_bounds__(256) nk_moe1(const bf16* __restrict__ HF, const v4u* __restrict__ tokrec, const float* __restrict__ Wg, const float* __restrict__ Wu, bf16* HID2) {
    const long gw = ((long)blockIdx.x * blockDim.x + threadIdx.x) >> 6; const int lane = threadIdx.x & 63;
    if (gw >= (long)M * 8) return;
    const int m = (int)(gw / 8), rest = (int)(gw % 8), slot = rest / 4, f = (rest % 4) * 64 + lane;
    const v4u rec = tokrec[m]; const int e = slot ? (rec.x >> 8) & 0xff : rec.x & 0xff; const float w = __uint_as_float(slot ? rec.z : rec.y);
    const bf16* a = HF + (size_t)m * D; const float* wg = Wg + (size_t)e * D * FF + f; const float* wu = Wu + (size_t)e * D * FF + f;
    float g = 0.f, u = 0.f;
    for (int k = 0; k < D; ++k) { const float av = bf2f(a[k]); g += av * wg[(size_t)k * FF]; u += av * wu[(size_t)k * FF]; }
    HID2[(size_t)m * 512 + slot * 256 + f] = (bf16)f2bf(g / (1.0f + expf(-g)) * u * w);
}
__global__ void __launch_bounds__(256) nk_moe2(const bf16* __restrict__ HID2, const v4u* __restrict__ tokrec, const float* __restrict__ Wd, const float* __restrict__ gvec, float* x) {
    const long gw = ((long)blockIdx.x * blockDim.x + threadIdx.x) >> 6; const int lane = threadIdx.x & 63;
    if (gw >= (long)M * 16) return;
    const int m = (int)(gw / 16), c = (int)(gw % 16) * 64 + lane, b = m / SEQ;
    const v4u rec = tokrec[m]; float y = 0.f;
    for (int slot = 0; slot < 2; ++slot) { const int e = slot ? (rec.x >> 8) & 0xff : rec.x & 0xff;
        const bf16* a = HID2 + (size_t)m * 512 + slot * 256; const float* wd = Wd + (size_t)e * FF * D + c;
        for (int f = 0; f < FF; ++f) y += bf2f(a[f]) * wd[(size_t)f * D]; }
    x[(size_t)m * D + c] += gvec[(size_t)b * 6144 + c] * y;
}
__global__ void __launch_bounds__(256) nk_attnA(int g, const bf16* __restrict__ Q, const bf16* __restrict__ K, const bf16* __restrict__ V, const float* __restrict__ biasv, bf16* ORUN, float* LSE) {
    const long gw = ((long)blockIdx.x * blockDim.x + threadIdx.x) >> 6; const int lane = threadIdx.x & 63;
    if (gw >= (long)M * 16) return;
    const int m = (int)(gw / 16), h = (int)(gw % 16), b = m / SEQ, t = m % SEQ, r = dil_of(g);
    const bf16* q = Q + (size_t)m * D + h * 64;
    float s[3]; bool ok[3];
#pragma unroll
    for (int i = 0; i < 3; ++i) { const int mm = lane + 64 * i; ok[i] = (mm <= 128) && (t - mm * r >= 0); s[i] = -1e30f;
        if (ok[i]) { const bf16* k = K + ((size_t)b * SEQ + (t - mm * r)) * D + h * 64; float d = 0.f;
            for (int dd = 0; dd < 64; ++dd) d += bf2f(q[dd]) * bf2f(k[dd]);
            s[i] = d + biasv[(g * 16 + h) * BV_PITCH + mm]; } }
    const float mx = wave_max(fmaxf(s[0], fmaxf(s[1], s[2])));
    float p[3]; float l = 0.f;
#pragma unroll
    for (int i = 0; i < 3; ++i) { p[i] = ok[i] ? exp2f(s[i] - mx) : 0.f; l += p[i]; }
    l = wave_sum(l);
    float o = 0.f;
#pragma unroll
    for (int i = 0; i < 3; ++i) for (int j = 0; j < 64; ++j) { const int mm = j + 64 * i; const float pj = __shfl(p[i], j);
        if (mm <= 128 && t - mm * r >= 0) o += pj * bf2f(V[((size_t)b * SEQ + (t - mm * r)) * D + h * 64 + lane]); }
    o /= l; float lse = mx * LN2 + logf(l);
    if (g > 0) { const float lr = LSE[(size_t)m * 16 + h], orun = bf2f(ORUN[(size_t)m * D + h * 64 + lane]);
        const float mxl = fmaxf(lr, lse), nl = mxl + logf(expf(lr - mxl) + expf(lse - mxl));
        o = expf(lr - nl) * orun + expf(lse - nl) * o; lse = nl; }
    ORUN[(size_t)m * D + h * 64 + lane] = (bf16)f2bf(o);
    if (lane == 0) LSE[(size_t)m * 16 + h] = lse;
}
__global__ void __launch_bounds__(256) nk_attnB(const bf16* __restrict__ Q, const bf16* __restrict__ K, const bf16* __restrict__ V, const float* __restrict__ CUM, bf16* O) {
    const long gw = ((long)blockIdx.x * blockDim.x + threadIdx.x) >> 6; const int lane = threadIdx.x & 63;
    if (gw >= (long)M * 16) return;
    const int m = (int)(gw / 16), h = (int)(gw % 16), b = m / SEQ, t = m % SEQ;
    const bf16* q = Q + (size_t)m * D + h * 64; const float* cum = CUM + (size_t)(b * 16 + h) * SEQ;
    float qv[64];
#pragma unroll
    for (int dd = 0; dd < 64; ++dd) qv[dd] = bf2f(q[dd]);
    const int nch = t / 64 + 1;
    float mx = -1e30f;
    for (int ch = 0; ch < nch; ++ch) { const int sidx = ch * 64 + lane;
        if (sidx <= t) { const bf16* k = K + ((size_t)b * SEQ + sidx) * D + h * 64; float d = 0.f;
#pragma unroll
            for (int dd = 0; dd < 64; ++dd) d += qv[dd] * bf2f(k[dd]);
            mx = fmaxf(mx, d + cum[sidx]); } }
    mx = wave_max(mx);
    float l = 0.f, o = 0.f;
    for (int ch = 0; ch < nch; ++ch) { const int sidx = ch * 64 + lane; float p = 0.f;
        if (sidx <= t) { const bf16* k = K + ((size_t)b * SEQ + sidx) * D + h * 64; float d = 0.f;
#pragma unroll
            for (int dd = 0; dd < 64; ++dd) d += qv[dd] * bf2f(k[dd]);
            p = exp2f(d + cum[sidx] - mx); }
        l += p;
        const int jn = (t - ch * 64 + 1) < 64 ? (t - ch * 64 + 1) : 64;
        for (int j = 0; j < jn; ++j) o += __shfl(p, j) * bf2f(V[((size_t)b * SEQ + ch * 64 + j) * D + h * 64 + lane]); }
    l = wave_sum(l);
    O[(size_t)m * D + h * 64 + lane] = (bf16)f2bf(o / l);
}

static void launch_mk(const Args& a0, int lo, int hi, int grid, hipStream_t stream, int flags = 0) {
    Args a = a0; a.ph_lo = lo; a.ph_hi = hi; a.flags = flags;
    hipLaunchKernelGGL(mk_fwd, dim3(grid), dim3(NWAVES * 64), LDS_BYTES, stream, a);
}
extern "C" void kernel_launch(void* const* d_in, const int* in_sizes, int n_in, void* d_out, int out_size, void* d_ws, size_t ws_size, hipStream_t stream) {
    static int grid = 0;
    if (grid == 0) {
        if (n_in != 23 || in_sizes[0] != M * D || out_size != M * D || ws_size < WS_END) { fprintf(stderr, "kernel_launch: unexpected shapes (n_in %d, in0 %d, out %d, ws %zu)\n", n_in, n_in > 0 ? in_sizes[0] : -1, out_size, ws_size); grid = -1; return; }
        int dev = 0, cus = 0;
        if (hipGetDevice(&dev) != hipSuccess || hipDeviceGetAttribute(&cus, hipDeviceAttributeMultiprocessorCount, dev) != hipSuccess) { grid = -1; return; }
        if (hipFuncSetAttribute((const void*)mk_fwd, hipFuncAttributeMaxDynamicSharedMemorySize, LDS_BYTES) != hipSuccess) { fprintf(stderr, "kernel_launch: hipFuncSetAttribute failed\n"); grid = -1; return; }
        int per_cu = 0;
        if (hipOccupancyMaxActiveBlocksPerMultiprocessor(&per_cu, (const void*)mk_fwd, NWAVES * 64, LDS_BYTES) != hipSuccess || per_cu < 1) fprintf(stderr, "kernel_launch: occupancy query reports %d\n", per_cu);
        (void)hipGetLastError();
        grid = cus;
    }
    if (grid < 0) return;
    if (hipMemsetAsync((char*)d_ws + WS_CTL, 0, CTL_ZERO_BYTES, stream) != hipSuccess) return;
    Args a{};
    for (int i = 0; i < 23; ++i) a.in[i] = (const float*)d_in[i];
    a.out = (float*)d_out; a.ws = (unsigned char*)d_ws;
#if MK_MODE == 0
    launch_mk(a, 0, NPH, grid, stream);
#else
    unsigned char* ws = (unsigned char*)d_ws;
    const float* const* in = a.in;
    bf16 *HM = (bf16*)(ws + WS_HM), *Qb = (bf16*)(ws + WS_Q), *Kb = (bf16*)(ws + WS_K), *Vb = (bf16*)(ws + WS_V), *OR = (bf16*)(ws + WS_ORUN), *HID2 = (bf16*)(ws + WS_HID2);
    float *MOD = (float*)(ws + WS_MOD), *LSE = (float*)(ws + WS_LSE), *BV = (float*)(ws + WS_BIASV), *CUM = (float*)(ws + WS_CUM);
    const v4u* TR = (const v4u*)(ws + WS_TOKREC);
    float* out = (float*)d_out;
    for (int ph = 0; ph < NPH; ++ph) {
        if (!((NAIVE_MASK >> ph) & 1u)) {
            const bool dup = (HOST_DUP_MASK >> ph) & 1u, moe2 = (ph == PH_MOE2_0 || ph == PH_MOE2_1), rowf = (ph == PH_ROW_F0 || ph == PH_ROW_F1);
            if (dup) launch_mk(a, ph, ph + 1, grid, stream, HOST_DUP_FLAGS >= 0 ? HOST_DUP_FLAGS : (moe2 ? 1 : (rowf ? 2 : 0)));
            launch_mk(a, ph, ph + 1, grid, stream, (dup && moe2 && HOST_DUP_FLAGS < 0) ? 1 : 0); continue; }
        switch (ph) {
            case PH_QKV_A0: case PH_QKV_A1: case PH_QKV_A2: { const int g = (ph - PH_QKV_A0) / 2;
                hipLaunchKernelGGL(nk_qkv, dim3(M * 48 / 4), dim3(256), 0, stream, HM, in[I_AWIN], 9216, g * 3072, in[I_AQN], in[I_AKN], Qb, Kb, Vb); break; }
            case PH_ATT_A0: case PH_ATT_A1: case PH_ATT_A2: { const int g = (ph - PH_ATT_A0) / 2;
                hipLaunchKernelGGL(nk_attnA, dim3(M * 16 / 4), dim3(256), 0, stream, g, Qb, Kb, Vb, BV, OR, LSE); break; }
            case PH_OUT_A: hipLaunchKernelGGL(nk_out, dim3(M * 16 / 4), dim3(256), 0, stream, OR, in[I_AWOUT], in[I_X], MOD + 2 * D, out); break;
            case PH_MOE1_0: hipLaunchKernelGGL(nk_moe1, dim3(M * 8 / 4), dim3(256), 0, stream, HM, TR, in[I_WG], in[I_WU], HID2); break;
            case PH_MOE2_0: hipLaunchKernelGGL(nk_moe2, dim3(M * 16 / 4), dim3(256), 0, stream, HID2, TR, in[I_WD], MOD + 5 * D, out); break;
            case PH_QKV_B: hipLaunchKernelGGL(nk_qkv, dim3(M * 48 / 4), dim3(256), 0, stream, HM, in[I_BWIN], 3088, 0, in[I_BQN], in[I_BKN], Qb, Kb, Vb); break;
            case PH_ATT_B: hipLaunchKernelGGL(nk_attnB, dim3(M * 16 / 4), dim3(256), 0, stream, Qb, Kb, Vb, CUM, OR); break;
            case PH_OUT_B: hipLaunchKernelGGL(nk_out, dim3(M * 16 / 4), dim3(256), 0, stream, OR, in[I_BWOUT], out, MOD + 4 * 6144 + 2 * D, out); break;
            case PH_MOE1_1: hipLaunchKernelGGL(nk_moe1, dim3(M * 8 / 4), dim3(256), 0, stream, HM, TR, in[I_WG] + (size_t)NE * D * FF, in[I_WU] + (size_t)NE * D * FF, HID2); break;
            case PH_MOE2_1: hipLaunchKernelGGL(nk_moe2, dim3(M * 16 / 4), dim3(256), 0, stream, HID2, TR, in[I_WD] + (size_t)NE * FF * D, MOD + 4 * 6144 + 5 * D, out); break;
            default: launch_mk(a, ph, ph + 1, grid, stream); break;
        }
    }
#endif
}
```

```cpp
#include <hip/hip_runtime.h>
#include <hip/hip_bf16.h>
#include <cstdio>
#include <cstdint>
#include <cmath>

#ifndef MK_MODE
#define MK_MODE 0
#endif
#ifndef DUP_MASK
#define DUP_MASK 0u
#endif
#ifndef HOST_DUP_MASK
#define HOST_DUP_MASK 0u
#endif
#ifndef HOST_DUP_FLAGS
#define HOST_DUP_FLAGS -1
#endif
#ifndef NAIVE_MASK
#define NAIVE_MASK 0u
#endif

constexpr int BATCH = 4, SEQ = 4096, D = 1024, H = 16, HD = 64, M = BATCH * SEQ;
constexpr int NE = 16, FF = 256, NCOMBO = 24;
constexpr float EPS = 1e-6f, LOG2E = 1.4426950408889634f, LN2 = 0.6931471805599453f;
constexpr float C2 = 0.125f * LOG2E;
constexpr int BV_PITCH = 132;
constexpr int NPH = 20;
enum Phase { PH_PRO = 0, PH_ROW_A = 1, PH_QKV_A0 = 2, PH_ATT_A0 = 3, PH_QKV_A1 = 4, PH_ATT_A1 = 5, PH_QKV_A2 = 6, PH_ATT_A2 = 7, PH_OUT_A = 8, PH_ROW_F0 = 9, PH_MOE1_0 = 10, PH_MOE2_0 = 11,
             PH_ROW_B = 12, PH_CUM = 13, PH_QKV_B = 14, PH_ATT_B = 15, PH_OUT_B = 16, PH_ROW_F1 = 17, PH_MOE1_1 = 18, PH_MOE2_1 = 19 };

constexpr size_t MiB = 1u << 20;
constexpr size_t WS_CTL = 0, CTL_ZERO_BYTES = 1 * MiB;
constexpr size_t WS_MOD = 1 * MiB;
constexpr size_t WS_BIASV = 1 * MiB + 256 * 1024;
constexpr size_t WS_TOKREC = 1 * MiB + 512 * 1024;
constexpr size_t WS_CUM = 2 * MiB;
constexpr size_t WS_LOGF = 3 * MiB;
constexpr size_t WS_LSE = 4 * MiB;
constexpr size_t WS_ELIST = 5 * MiB;
constexpr size_t WS_CLIST = 6 * MiB;
constexpr size_t WS_WAIN = 8 * MiB;
constexpr size_t WS_WAOUT = 26 * MiB;
constexpr size_t WS_WBIN = 28 * MiB;
constexpr size_t WS_WBOUT = 34 * MiB;
constexpr size_t WS_MOE1 = 36 * MiB;
constexpr size_t WS_MOE2 = 68 * MiB;
constexpr size_t WS_HM = 84 * MiB;
constexpr size_t WS_Q = 116 * MiB, WS_K = 148 * MiB, WS_V = 180 * MiB;
constexpr size_t WS_ORUN = 212 * MiB;
constexpr size_t WS_HID2 = 116 * MiB;
constexpr size_t WS_END = 244 * MiB;
constexpr int CW_TMO = 0, CW_CODE = 1, CW_BAR = 4096, CW_CNT = 16384;

constexpr int RING_OFF = 0, RING_BYTES = 131072;
constexpr int LDSCTL_OFF = RING_BYTES, MISC_OFF = LDSCTL_OFF + 320;
constexpr int LDS_BYTES = 163840;
constexpr int GTAB_OFF = LDSCTL_OFF + 8192;

#define GAS __attribute__((address_space(1)))
#define LAS __attribute__((address_space(3)))
typedef unsigned short bf16;
typedef unsigned v4u __attribute__((ext_vector_type(4)));
typedef unsigned v2u __attribute__((ext_vector_type(2)));
typedef float f32x4 __attribute__((ext_vector_type(4)));
typedef short bf16x8 __attribute__((ext_vector_type(8)));
typedef GAS unsigned gu32;
#define RLX_AGENT __ATOMIC_RELAXED, __HIP_MEMORY_SCOPE_AGENT
#define LDS_WAIT() asm volatile("s_waitcnt lgkmcnt(0)" ::: "memory")
#define VM_WAIT() asm volatile("s_waitcnt vmcnt(0)" ::: "memory")
__device__ __forceinline__ unsigned f2bf(float f) { unsigned u = __builtin_bit_cast(unsigned, f); return (u + 0x7fffu + ((u >> 16) & 1u)) >> 16; }
__device__ __forceinline__ unsigned pk2(float lo, float hi) { return f2bf(lo) | (f2bf(hi) << 16); }
__device__ __forceinline__ float bf2f(unsigned u) { return __uint_as_float(u << 16); }
__device__ __forceinline__ float wave_sum(float v) {
#pragma unroll
    for (int o = 1; o < 64; o <<= 1) v += __shfl_xor(v, o);
    return v;
}
__device__ __forceinline__ float wave_max(float v) {
#pragma unroll
    for (int o = 1; o < 64; o <<= 1) v = fmaxf(v, __shfl_xor(v, o));
    return v;
}
__host__ __device__ __forceinline__ int dil_of(int g) { return g == 0 ? 1 : (g == 1 ? 4 : 16); }

#define XB_TMO      128
#define XB_XCNT(j)  (256  + 64 * (j))
#define XB_XSUB(j)  (1280 + 64 * (j))
#define XB_XGEN(j)  (2304 + 64 * (j))
#define XB_TOP      3328
#define XB_TOPGEN   3392
#define XCD_BAR_WORDS 3456
#define XB_SPIN_CAP (1u << 18)
__device__ __forceinline__ unsigned xb_ld(unsigned* p)              { return __hip_atomic_load(p, __ATOMIC_RELAXED, __HIP_MEMORY_SCOPE_AGENT); }
__device__ __forceinline__ unsigned xb_add(unsigned* p, unsigned v) { return __hip_atomic_fetch_add(p, v, __ATOMIC_RELAXED, __HIP_MEMORY_SCOPE_AGENT); }
__device__ __forceinline__ unsigned xb_xcc_id() { return (unsigned)__builtin_amdgcn_s_getreg((3 << 11) | 20) & 0xFu; }
#define XB_SPIN(cond, bar) do { unsigned _sp = 0; while (cond) { __builtin_amdgcn_s_sleep(1); \
    if ((++_sp & 255u) == 0u) { if (xb_ld(&(bar)[XB_TMO])) break; if (_sp > XB_SPIN_CAP) { atomicAdd(&(bar)[XB_TMO], 1u); break; } } } } while (0)
struct XcdBarrier { unsigned* bar; unsigned x; volatile LAS unsigned* st; };
__device__ __forceinline__ XcdBarrier xcd_barrier_post(unsigned* bar, volatile LAS unsigned* st) {
    XcdBarrier b; b.bar = bar; b.x = xb_xcc_id(); b.st = st;
    if (threadIdx.x == 0) (void)xb_add(&bar[XB_XCNT(b.x)], 1u);
    return b;
}
__device__ __forceinline__ void xcd_barrier_complete(unsigned* bar, unsigned x, unsigned& nloc, unsigned& nx) {
    const unsigned G = gridDim.x * gridDim.y * gridDim.z;
    unsigned sum, cnt, mine, sp = 0u;
    for (;;) {
        sum = 0u; cnt = 0u; mine = 0u;
#pragma unroll
        for (unsigned j = 0; j < 16; ++j) { const unsigned c = xb_ld(&bar[XB_XCNT(j)]); sum += c; cnt += (c > 0u) ? 1u : 0u; mine = (j == x) ? c : mine; }
        if (sum == G) break;
        __builtin_amdgcn_s_sleep(1);
        if ((++sp & 255u) == 0u) { if (xb_ld(&bar[XB_TMO])) break; if (sp > XB_SPIN_CAP) { atomicAdd(&bar[XB_TMO], 1u); break; } }
    }
    nloc = mine > 0u ? mine : 1u; nx = cnt > 0u ? cnt : 1u;
}
__device__ __forceinline__ void xcd_barrier(const XcdBarrier& b) {
    asm volatile("s_waitcnt vmcnt(0)" ::: "memory");
    __syncthreads();
    if (threadIdx.x == 0) {
        unsigned* bar = b.bar;
        __builtin_amdgcn_s_waitcnt(0);
        unsigned nloc = b.st[0], nx = b.st[1];
        if (nloc == 0u) { xcd_barrier_complete(bar, b.x, nloc, nx); b.st[0] = nloc; b.st[1] = nx; }
        const unsigned old = xb_add(&bar[XB_XSUB(b.x)], 1u);
        const unsigned gen = old / nloc;
        if (old + 1u == (gen + 1u) * nloc) {
            __builtin_amdgcn_fence(__ATOMIC_RELEASE, "agent");
            asm volatile("s_waitcnt vmcnt(0)" ::: "memory");
            const unsigned og = xb_add(&bar[XB_TOP], 1u);
            const unsigned tg = og / nx;
            if (og + 1u == (tg + 1u) * nx) xb_add(&bar[XB_TOPGEN], 1u);
            else XB_SPIN(xb_ld(&bar[XB_TOPGEN]) == tg, bar);
            __builtin_amdgcn_fence(__ATOMIC_ACQUIRE, "agent");
            xb_add(&bar[XB_XGEN(b.x)], 1u);
            asm volatile("s_waitcnt vmcnt(0)" ::: "memory");
        } else {
            XB_SPIN(xb_ld(&bar[XB_XGEN(b.x)]) == gen, bar);
            __builtin_amdgcn_fence(__ATOMIC_ACQUIRE, "agent");
            asm volatile("s_waitcnt vmcnt(0)" ::: "memory");
        }
    }
    __syncthreads();
}

constexpr int NWAVES = 8;
struct Args { const float* in[23]; float* out; unsigned char* ws; int ph_lo, ph_hi, flags, pad; };
__device__ __forceinline__ bool frame_refresh(struct Frame& F);
struct Frame {
    LAS unsigned char* lds;
    volatile LAS unsigned* MISC;
    gu32* ctl;
    int tid, lane, wave, vcu, G;
    unsigned char* ws;
    const float* const* in;
    float* out;
    int flags;
};
__device__ __forceinline__ bool frame_refresh(Frame& F) { int t = threadIdx.x; asm volatile("" : "+v"(t)); F.tid = t; F.lane = t & 63; F.wave = __builtin_amdgcn_readfirstlane(t >> 6); return true; }
enum In { I_X = 0, I_C, I_WADA, I_BADA, I_NMIX, I_NFFN, I_RELB, I_AWIN, I_AWOUT, I_AQN, I_AKN, I_BWIN, I_BFB, I_BWOUT, I_BQN, I_BKN, I_RGW, I_RGB, I_REW, I_REB, I_WG, I_WU, I_WD };

__device__ __forceinline__ void pro_mod_item(Frame& F, int item) {
    LAS float* s = (LAS float*)(F.lds + RING_OFF);
    LAS float* part = (LAS float*)(F.lds + RING_OFF + 16384);
    const float* c = F.in[I_C];
    for (int i = F.tid; i < 4 * D; i += NWAVES * 64) { const float v = c[i]; s[i] = v / (1.f + __expf(-v)); }
    __syncthreads();
    const int layer = item / 96, cc = item % 96, col = cc * 64 + F.lane;
    const float* W = F.in[I_WADA] + (size_t)layer * D * 6144 + col;
    float a0 = 0.f, a1 = 0.f, a2 = 0.f, a3 = 0.f;
    const int k0 = F.wave * 128;
#pragma unroll 8
    for (int k = k0; k < k0 + 128; ++k) { const float w = W[(size_t)k * 6144]; a0 += s[k] * w; a1 += s[D + k] * w; a2 += s[2 * D + k] * w; a3 += s[3 * D + k] * w; }
    part[(F.wave * 4 + 0) * 64 + F.lane] = a0; part[(F.wave * 4 + 1) * 64 + F.lane] = a1; part[(F.wave * 4 + 2) * 64 + F.lane] = a2; part[(F.wave * 4 + 3) * 64 + F.lane] = a3;
    __syncthreads();
    if (F.wave < 4) {
        float t = 0.f;
#pragma unroll
        for (int w = 0; w < 8; ++w) t += part[(w * 4 + F.wave) * 64 + F.lane];
        float* MOD = (float*)(F.ws + WS_MOD);
        MOD[(size_t)(layer * 4 + F.wave) * 6144 + col] = t + F.in[I_BADA][layer * 6144 + col];
    }
    __syncthreads();
}
__device__ __forceinline__ void pro_biasv(Frame& F) {
    float* BV = (float*)(F.ws + WS_BIASV);
    for (int i = F.tid; i < 48 * 129; i += NWAVES * 64) {
        const int gh = i / 129, dist = i % 129, g = gh / 16, d = dist * dil_of(g);
        int bucket;
        if (d < 16) bucket = d;
        else { const float v = logf((float)d / 16.0f) / 4.852030263919617f * 16.0f; bucket = 16 + (int)v; if (bucket > 31) bucket = 31; }
        BV[gh * BV_PITCH + dist] = F.in[I_RELB][bucket * 48 + gh] * LOG2E;
    }
}
__device__ __forceinline__ int rowmap(int mode, int n) {
    if (mode == 0) return n;
    if (mode == 1) return (n & ~255) + 128 * ((n >> 5) & 1) + 32 * ((n >> 6) & 3) + (n & 31);
    return 256 * (n >> 7) + (n & 127) + (mode == 3 ? 128 : 0);
}
__device__ __forceinline__ void transpose_item(const float* W, int ldw, bf16* WT, int ldt, int k0, int n0, int mode, LAS float* scr, int lane) {
    float tv[32];
#pragma unroll
    for (int i = 0; i < 32; ++i) { const int kk = 2 * i + (lane >> 5); tv[i] = W[(size_t)(k0 + kk) * ldw + n0 + (lane & 31)]; }
#pragma unroll
    for (int i = 0; i < 32; ++i) { const int kk = 2 * i + (lane >> 5); scr[kk * 33 + (lane & 31)] = tv[i]; }
    LDS_WAIT(); asm volatile("" ::: "memory");
    const int c = lane & 7;
#pragma unroll
    for (int j = 0; j < 4; ++j) { const int n = (lane >> 3) + 8 * j; const LAS float* s = scr + (8 * c) * 33 + n;
        v4u o; o.x = pk2(s[0 * 33], s[1 * 33]); o.y = pk2(s[2 * 33], s[3 * 33]); o.z = pk2(s[4 * 33], s[5 * 33]); o.w = pk2(s[6 * 33], s[7 * 33]);
        *(GAS v4u*)(WT + (size_t)rowmap(mode, n0 + n) * ldt + k0 + 8 * c) = o; }
    LDS_WAIT(); asm volatile("" ::: "memory");
}
__device__ __forceinline__ void p0_prologue(Frame& F) {
    if (blockIdx.x < 192) pro_mod_item(F, blockIdx.x);
    if (blockIdx.x == F.G - 1) pro_biasv(F);
    __syncthreads();
    LAS float* scr = (LAS float*)(F.lds + RING_OFF + F.wave * 16384);
    const int gw = F.vcu * NWAVES + F.wave, NGW = F.G * NWAVES;
    constexpr int I_A = 16 * 288, I_AO = 16 * 32, I_B = 16 * 96, I_BO = 16 * 32, I_E = 32 * 128;
    constexpr int NITEMS = I_A + I_AO + I_B + I_BO + 3 * I_E;
    for (int it = gw; it < NITEMS; it += NGW) {
        int r = it;
        if (r < I_A) { transpose_item(F.in[I_AWIN], 9216, (bf16*)(F.ws + WS_WAIN), 1024, 64 * (r / 288), 32 * (r % 288), 1, scr, F.lane); continue; } r -= I_A;
        if (r < I_AO) { transpose_item(F.in[I_AWOUT], 1024, (bf16*)(F.ws + WS_WAOUT), 1024, 64 * (r / 32), 32 * (r % 32), 0, scr, F.lane); continue; } r -= I_AO;
        if (r < I_B) { transpose_item(F.in[I_BWIN], 3088, (bf16*)(F.ws + WS_WBIN), 1024, 64 * (r / 96), 32 * (r % 96), 1, scr, F.lane); continue; } r -= I_B;
        if (r < I_BO) { transpose_item(F.in[I_BWOUT], 1024, (bf16*)(F.ws + WS_WBOUT), 1024, 64 * (r / 32), 32 * (r % 32), 0, scr, F.lane); continue; } r -= I_BO;
        if (r < I_E) { const int le = r / 128, q = r % 128;
            transpose_item(F.in[I_WG] + (size_t)le * D * FF, FF, (bf16*)(F.ws + WS_MOE1) + (size_t)le * 512 * D, 1024, 64 * (q / 8), 32 * (q % 8), 2, scr, F.lane); continue; } r -= I_E;
        if (r < I_E) { const int le = r / 128, q = r % 128;
            transpose_item(F.in[I_WU] + (size_t)le * D * FF, FF, (bf16*)(F.ws + WS_MOE1) + (size_t)le * 512 * D, 1024, 64 * (q / 8), 32 * (q % 8), 3, scr, F.lane); continue; } r -= I_E;
        { const int le = r / 128, q = r % 128;
            transpose_item(F.in[I_WD] + (size_t)le * FF * D, D, (bf16*)(F.ws + WS_MOE2) + (size_t)le * D * FF, 256, 64 * (q / 32), 32 * (q % 32), 0, scr, F.lane); }
    }
}

template <int N> __device__ __forceinline__ void reduce_scatter(float (&a)[64], int lane) {
    if constexpr (N >= 1) {
        const bool up = (lane & N) != 0;
#pragma unroll
        for (int i = 0; i < N; ++i) { const float keep = up ? a[i + N] : a[i], send = up ? a[i] : a[i + N]; a[i] = keep + __shfl_xor(send, N); }
        reduce_scatter<N / 2>(a, lane);
    }
}
template <int MODE> __device__ __forceinline__ void rowpass(Frame& F, const float* xin, const float* gain, int layer, int sh_idx, int sc_idx) {
    constexpr int NW = MODE == 1 ? 16 : (MODE == 2 ? 20 : 0), NWP = MODE == 1 ? 16 : 32, RPG = MODE == 1 ? 4 : 2;
    LAS float* Wl = (LAS float*)(F.lds + RING_OFF);
    LAS int* rowinfo = (LAS int*)(F.lds + RING_OFF + 98304);
    LAS float* wsum = (LAS float*)(F.lds + RING_OFF + 98304 + 1024) + F.wave * 64;
    const float* MOD = (const float*)(F.ws + WS_MOD) + (size_t)layer * 4 * 6144;
    bf16* HM = (bf16*)(F.ws + WS_HM);
    if constexpr (MODE == 1) { const float* W = F.in[I_BWIN] + 3072; f32x4 t[8];
#pragma unroll
        for (int q = 0; q < 8; ++q) { const int i = F.tid + q * 512, c = i >> 2, j4 = i & 3; t[q] = *(const f32x4*)(W + (size_t)c * 3088 + 4 * j4); }
#pragma unroll
        for (int q = 0; q < 8; ++q) { const int i = F.tid + q * 512, c = i >> 2, j4 = i & 3; Wl[(4 * j4 + 0) * D + c] = t[q].x; Wl[(4 * j4 + 1) * D + c] = t[q].y; Wl[(4 * j4 + 2) * D + c] = t[q].z; Wl[(4 * j4 + 3) * D + c] = t[q].w; } }
    if constexpr (MODE == 2) { const float* Wg = F.in[I_RGW] + (size_t)layer * D * 4; const float* We = F.in[I_REW] + (size_t)layer * D * 16; f32x4 t[10];
#pragma unroll
        for (int q = 0; q < 8; ++q) { const int i = F.tid + q * 512; t[q] = *(const f32x4*)(We + 4 * (size_t)i); }
#pragma unroll
        for (int q = 0; q < 2; ++q) { const int i = F.tid + q * 512; t[8 + q] = *(const f32x4*)(Wg + 4 * (size_t)i); }
#pragma unroll
        for (int q = 0; q < 8; ++q) { const int i = F.tid + q * 512, c = i >> 2, j4 = i & 3; Wl[(4 + 4 * j4 + 0) * D + c] = t[q].x; Wl[(4 + 4 * j4 + 1) * D + c] = t[q].y; Wl[(4 + 4 * j4 + 2) * D + c] = t[q].z; Wl[(4 + 4 * j4 + 3) * D + c] = t[q].w; }
#pragma unroll
        for (int q = 0; q < 2; ++q) { const int c = F.tid + q * 512; Wl[0 * D + c] = t[8 + q].x; Wl[1 * D + c] = t[8 + q].y; Wl[2 * D + c] = t[8 + q].z; Wl[3 * D + c] = t[8 + q].w; } }
    __syncthreads();
    for (int rb = blockIdx.x; rb < M / 64; rb += F.G) {
        const int b = (rb * 64) / SEQ;
        f32x4 Gv[4], Sv[4];
#pragma unroll
        for (int j = 0; j < 4; ++j) { const int c = 4 * F.lane + 256 * j;
            const f32x4 gv = *(const f32x4*)(gain + c), sc = *(const f32x4*)(MOD + (size_t)b * 6144 + sc_idx * D + c), sh = *(const f32x4*)(MOD + (size_t)b * 6144 + sh_idx * D + c);
            Gv[j] = gv * (sc + 1.0f); Sv[j] = sh; }
        constexpr bool PF = (RPG == 2);
        f32x4 vn[RPG][4];
        if constexpr (PF) {
#pragma unroll
            for (int r = 0; r < RPG; ++r) { const GAS f32x4* xr = (const GAS f32x4*)(xin + (size_t)(rb * 64 + F.wave * 8 + r) * D) + F.lane;
#pragma unroll
                for (int j = 0; j < 4; ++j) vn[r][j] = xr[64 * j]; } }
#pragma unroll 1
        for (int grp = 0; grp < 8 / RPG; ++grp) {
            const int m0 = rb * 64 + F.wave * 8 + grp * RPG;
            f32x4 v[RPG][4];
            if constexpr (PF) {
#pragma unroll
                for (int r = 0; r < RPG; ++r)
#pragma unroll
                    for (int j = 0; j < 4; ++j) v[r][j] = vn[r][j];
                if (grp + 1 < 8 / RPG) {
#pragma unroll
                    for (int r = 0; r < RPG; ++r) { const GAS f32x4* xr = (const GAS f32x4*)(xin + (size_t)(m0 + RPG + r) * D) + F.lane;
#pragma unroll
                        for (int j = 0; j < 4; ++j) vn[r][j] = xr[64 * j]; } }
            } else {
#pragma unroll
                for (int r = 0; r < RPG; ++r) { const GAS f32x4* xr = (const GAS f32x4*)(xin + (size_t)(m0 + r) * D) + F.lane;
#pragma unroll
                    for (int j = 0; j < 4; ++j) v[r][j] = xr[64 * j]; }
            }
#pragma unroll
            for (int r = 0; r < RPG; ++r) { float ss = 0.f;
#pragma unroll
                for (int j = 0; j < 4; ++j) ss += (v[r][j].x * v[r][j].x + v[r][j].y * v[r][j].y) + (v[r][j].z * v[r][j].z + v[r][j].w * v[r][j].w);
                const float rstd = 1.0f / sqrtf(wave_sum(ss) * (1.f / D) + EPS);
                GAS unsigned long long* o8 = (GAS unsigned long long*)(HM + (size_t)(m0 + r) * D) + F.lane;
#pragma unroll
                for (int j = 0; j < 4; ++j) { v[r][j] = v[r][j] * rstd * Gv[j] + Sv[j];
                    o8[64 * j] = (unsigned long long)pk2(v[r][j].x, v[r][j].y) | ((unsigned long long)pk2(v[r][j].z, v[r][j].w) << 32); } }
            if constexpr (NW > 0) {
                float a[64];
#pragma unroll
                for (int i = 0; i < 64; ++i) a[i] = 0.f;
#pragma unroll
                for (int jj = 0; jj < NW; ++jj) {
                    asm volatile("" ::: "memory");
#pragma unroll
                    for (int j = 0; j < 4; ++j) { const f32x4 w = *(const LAS f32x4*)(Wl + jj * D + 4 * F.lane + 256 * j);
#pragma unroll
                        for (int r = 0; r < RPG; ++r) a[r * NWP + jj] += (v[r][j].x * w.x + v[r][j].y * w.y) + (v[r][j].z * w.z + v[r][j].w * w.w); }
                }
                reduce_scatter<32>(a, F.lane);
                const float tot = a[0];
                if constexpr (MODE == 1) {
                    float* LOGF = (float*)(F.ws + WS_LOGF);
                    const float z = tot + F.in[I_BFB][F.lane & 15];
                    LOGF[(size_t)m0 * 16 + F.lane] = fminf(z, 0.f) - log1pf(expf(-fabsf(z)));
                }
                if constexpr (MODE == 2) {
                    wsum[F.lane] = tot; LDS_WAIT();
                    if (F.lane < RPG) {
                        const float* bg = F.in[I_RGB] + layer * 4; const float* be = F.in[I_REB] + layer * 16;
                        v4u* TOKREC = (v4u*)(F.ws + ((F.flags & 2) ? WS_END : WS_TOKREC));
                        const LAS float* dr = wsum + F.lane * NWP;
                        const float g0 = dr[0] + bg[0], g1 = dr[1] + bg[1], g2 = dr[2] + bg[2], g3 = dr[3] + bg[3];
                        int gi = 0; float gm = g0; if (g1 > gm) { gm = g1; gi = 1; } if (g2 > gm) { gm = g2; gi = 2; } if (g3 > gm) { gm = g3; gi = 3; }
                        const float gw = 1.0f / (expf(g0 - gm) + expf(g1 - gm) + expf(g2 - gm) + expf(g3 - gm));
                        float es[4];
#pragma unroll
                        for (int i = 0; i < 4; ++i) es[i] = dr[4 + gi * 4 + i] + be[gi * 4 + i];
                        int i1 = 0; float v1 = es[0];
#pragma unroll
                        for (int i = 1; i < 4; ++i) if (es[i] > v1) { v1 = es[i]; i1 = i; }
                        int i2 = -1; float v2 = -INFINITY;
#pragma unroll
                        for (int i = 0; i < 4; ++i) if (i != i1 && es[i] > v2) { v2 = es[i]; i2 = i; }
                        const float ex = expf(v2 - v1), w1 = gw / (1.0f + ex), w2 = gw * ex / (1.0f + ex);
                        const int aa = i1 < i2 ? i1 : i2, bb = i1 < i2 ? i2 : i1;
                        const float wlo = i1 < i2 ? w1 : w2, whi = i1 < i2 ? w2 : w1;
                        const int pidx = aa == 0 ? bb - 1 : (aa == 1 ? bb + 1 : 5);
                        const int lo = gi * 4 + aa, hi = gi * 4 + bb, combo = gi * 6 + pidx;
                        v4u rec; rec.x = (unsigned)(lo | (hi << 8) | (combo << 16)); rec.y = __float_as_uint(wlo); rec.z = __float_as_uint(whi); rec.w = 0u;
                        TOKREC[m0 + F.lane] = rec; rowinfo[F.wave * 8 + grp * RPG + F.lane] = lo | (hi << 8) | (combo << 16);
                    }
                    LDS_WAIT();
                }
            }
        }
        if (MODE == 2) {
            __syncthreads();
            if (F.tid < 40) {
                const int t = F.tid; int n = 0;
#pragma unroll 8
                for (int r = 0; r < 64; ++r) { const int ri = rowinfo[r]; const bool mem = t < 16 ? ((ri & 0xff) == t || ((ri >> 8) & 0xff) == t) : ((ri >> 16) == t - 16); n += mem ? 1 : 0; }
                gu32* cnt = F.ctl + CW_CNT + (((F.flags & 2) ? 2 : layer) * 40 + t) * 64;
                const int base = (int)__hip_atomic_fetch_add(cnt, (unsigned)n, RLX_AGENT);
                int* list = (int*)(F.ws + ((F.flags & 2) ? WS_END + MiB : (t < 16 ? WS_ELIST : WS_CLIST))) + (t < 16 ? t : ((F.flags & 2) ? t : t - 16)) * M;
                int kk = 0;
                for (int r = 0; r < 64; ++r) { const int ri = rowinfo[r]; const bool mem = t < 16 ? ((ri & 0xff) == t || ((ri >> 8) & 0xff) == t) : ((ri >> 16) == t - 16);
                    if (mem) { list[base + kk] = rb * 64 + r; ++kk; } }
            }
            __syncthreads();
        }
    }
}

__device__ __forceinline__ void cumsum_phase(Frame& F) {
    LAS float* wt = (LAS float*)(F.lds + RING_OFF);
    for (int bh = blockIdx.x; bh < BATCH * H; bh += F.G) {
        const int b = bh / H, h = bh % H;
        const float* LOGF = (const float*)(F.ws + WS_LOGF) + (size_t)b * SEQ * 16 + h;
        float v[8]; float run = 0.f;
#pragma unroll
        for (int i = 0; i < 8; ++i) { run += LOGF[(size_t)(F.tid * 8 + i) * 16]; v[i] = run; }
        float inc = run;
#pragma unroll
        for (int o = 1; o < 64; o <<= 1) { const float n = __shfl_up(inc, o); if (F.lane >= o) inc += n; }
        if (F.lane == 63) wt[F.wave] = inc;
        __syncthreads();
        float base = inc - run;
        for (int w = 0; w < F.wave; ++w) base += wt[w];
        float* CUM = (float*)(F.ws + WS_CUM) + (size_t)bh * SEQ + F.tid * 8;
#pragma unroll
        for (int i = 0; i < 8; ++i) CUM[i] = -(base + v[i]) * LOG2E;
        __syncthreads();
    }
}

namespace pg8 {
typedef unsigned short bf16_t;
typedef unsigned u32x4 __attribute__((ext_vector_type(4)));
constexpr int BM = 256, BK = 64, HALF = 128, HTB = HALF * BK * 2, STAGE_BYTES = 8 * HTB, NXCD = 8, WGM = 8;
__host__ __device__ __forceinline__ int lds_byte(int r, int c) { const int st = (r >> 4) * 2 + (c >> 5), rr = r & 15, cc = c & 31, ob = rr * 64 + cc * 2; return st * 1024 + (ob ^ (((ob >> 9) & 1) << 5)); }
__host__ __device__ __forceinline__ void stage_rc(int b, int& R, int& C) { const int st = b / 1024, sb = b % 1024, swz = sb ^ (((sb >> 9) & 1) << 5); R = (st >> 1) * 16 + swz / 64; C = (st & 1) * 32 + (swz % 64) / 2; }
__host__ __device__ __forceinline__ int perm32(int rho) { const int n = rho >> 4, i = rho & 15; return 8 * (i >> 2) + 4 * n + (i & 3); }
struct Unit { int pm, pn, e, cnt; };
__device__ __forceinline__ unsigned cvt_pk_bf16(float lo, float hi) { unsigned r; asm volatile("v_cvt_pk_bf16_f32 %0, %1, %2" : "=v"(r) : "v"(lo), "v"(hi)); return r; }

struct StaticOrder {
    int nM, nN, nwg, G, c; const char* A; const char* Bt; size_t tstepA, tstepB; int ks;
    __device__ void init(int M_, int N_, int G_, int c_, const void* A_, int lda, const void* Bt_, int ldb, int nt) { nM = M_ / BM; nN = N_ / BM; nwg = nM * nN; G = G_; c = c_; A = (const char*)A_; Bt = (const char*)Bt_; tstepA = (size_t)BM * lda * 2; tstepB = (size_t)BM * ldb * 2; ks = nt; }
    __device__ bool next(int i, Unit& u) const {
        const long L = (long)i * G + c; if (L >= nwg) return false;
        int wgid = (int)L; { const int q = nwg / NXCD, r = nwg % NXCD, xcd = wgid % NXCD, off = wgid / NXCD; wgid = (xcd < r ? xcd * (q + 1) : r * (q + 1) + (xcd - r) * q) + off; }
        const int nig = WGM * nN, gid = wgid / nig, fm = gid * WGM, gsz = (nM - fm) < WGM ? (nM - fm) : WGM;
        u.pm = fm + ((wgid % nig) % gsz); u.pn = (wgid % nig) / gsz; u.e = 0; u.cnt = 0; return true;
    }
    __device__ __forceinline__ const char* a_base(const Unit& u) const { return A + (size_t)u.pm * tstepA; }
    __device__ __forceinline__ const char* b_lo(const Unit& u) const { return Bt + (size_t)u.pn * tstepB; }
    __device__ __forceinline__ const char* b_hi(const Unit& u) const { return Bt + (size_t)u.pn * tstepB; }
    __device__ __forceinline__ int row(const Unit&, int) const { return 0; }
};
struct MoeOrder {
    int G, c, nl, ntn, ks, mode; const char* A; const char* B; const int* lists; const LAS int* tab;
    __device__ bool next(int i, Unit& u) const {
        const int L = i * G + c, total = __builtin_amdgcn_readfirstlane(tab[nl]) * ntn; if (L >= total) return false;
        const int rt = L / ntn; int e = 0;
        for (int k = 1; k < nl; ++k) e = (tab[k] <= rt) ? k : e;
        u.e = __builtin_amdgcn_readfirstlane(e); u.pm = __builtin_amdgcn_readfirstlane(rt - tab[e]); u.pn = L % ntn; u.cnt = __builtin_amdgcn_readfirstlane(tab[32 + e]); return true;
    }
    __device__ __forceinline__ const char* a_base(const Unit&) const { return A; }
    __device__ __forceinline__ const char* b_lo(const Unit& u) const {
        if (mode == 1) return B + ((size_t)u.e * 512 + (size_t)u.pn * 256) * 1024 * 2;
        const int g = u.e / 6, p = u.e % 6, a = p < 3 ? 0 : (p < 5 ? 1 : 2);
        return B + ((size_t)(g * 4 + a) * 1024 + (size_t)u.pn * 256) * 256 * 2; }
    __device__ __forceinline__ const char* b_hi(const Unit& u) const {
        if (mode == 1) return b_lo(u);
        const int g = u.e / 6, p = u.e % 6, b = p < 3 ? p + 1 : (p < 5 ? p - 1 : 3);
        return B + ((size_t)(g * 4 + b) * 1024 + (size_t)u.pn * 256) * 256 * 2; }
    __device__ __forceinline__ int row(const Unit& u, int r) const { int idx = u.pm * 256 + r; idx = idx < u.cnt ? idx : u.cnt - 1; return lists[(size_t)u.e * 16384 + idx]; }
};

struct EpiQKV {
    static constexpr bool PERM = true;
    bf16_t* Qo; const float* qg; const float* kg;
    __device__ __forceinline__ void operator()(const f32x4 (&acc)[2][2][4][2], const Unit& u, int wr, int wc, int fr, int fq) const {
        const int t = u.pn >> 2, hcol = (u.pn & 3) * 256 + wc * 64;
        bf16_t* base = Qo + (size_t)t * ((WS_K - WS_Q) / 2) + hcol + 8 * fq;
        f32x4 gv[2][2];
        const float* gp = qg + (t == 1 ? (kg - qg) : 0) + 8 * fq;
#pragma unroll
        for (int bj = 0; bj < 2; ++bj)
#pragma unroll
            for (int n = 0; n < 2; ++n) gv[bj][n] = (t < 2) ? *(const f32x4*)(gp + 32 * bj + 4 * n) : (f32x4){1.f, 1.f, 1.f, 1.f};
        const float sc = (t == 0) ? C2 : 1.0f;
#pragma unroll
        for (int ai = 0; ai < 2; ++ai)
#pragma unroll
            for (int m = 0; m < 4; ++m) {
                float rs = sc;
                if (t < 2) { float ss = 0.f;
#pragma unroll
                    for (int bj = 0; bj < 2; ++bj)
#pragma unroll
                        for (int n = 0; n < 2; ++n) { const f32x4 x = acc[ai][bj][m][n]; ss += (x[0] * x[0] + x[1] * x[1]) + (x[2] * x[2] + x[3] * x[3]); }
                    ss += __shfl_xor(ss, 16); ss += __shfl_xor(ss, 32);
                    rs = sc / sqrtf(ss * (1.0f / 64.0f) + EPS); }
                bf16_t* rowp = base + (size_t)(u.pm * BM + ai * HALF + wr * 64 + m * 16 + fr) * 1024;
#pragma unroll
                for (int bj = 0; bj < 2; ++bj) { const f32x4 v0 = acc[ai][bj][m][0] * rs * gv[bj][0], v1 = acc[ai][bj][m][1] * rs * gv[bj][1];
                    u32x4 w; w.x = cvt_pk_bf16(v0[0], v0[1]); w.y = cvt_pk_bf16(v0[2], v0[3]); w.z = cvt_pk_bf16(v1[0], v1[1]); w.w = cvt_pk_bf16(v1[2], v1[3]);
                    *(u32x4*)(rowp + 32 * bj) = w; } }
    }
};
struct EpiOut {
    static constexpr bool PERM = false;
    const float* xin; float* xout; const float* gvec;
    __device__ __forceinline__ void operator()(const f32x4 (&acc)[2][2][4][2], const Unit& u, int wr, int wc, int fr, int fq) const {
        const int col0 = u.pn * BM + wc * 32 + 4 * fq, b = (u.pm * BM) / SEQ;
        f32x4 g[2][2];
#pragma unroll
        for (int bj = 0; bj < 2; ++bj)
#pragma unroll
            for (int n = 0; n < 2; ++n) g[bj][n] = *(const f32x4*)(gvec + (size_t)b * 6144 + col0 + bj * HALF + n * 16);
#pragma unroll
        for (int ai = 0; ai < 2; ++ai)
#pragma unroll
            for (int m = 0; m < 4; ++m) { const size_t off = (size_t)(u.pm * BM + ai * HALF + wr * 64 + m * 16 + fr) * D + col0;
#pragma unroll
                for (int bj = 0; bj < 2; ++bj)
#pragma unroll
                    for (int n = 0; n < 2; ++n) { const f32x4 xi = *(const f32x4*)(xin + off + bj * HALF + n * 16); *(f32x4*)(xout + off + bj * HALF + n * 16) = xi + g[bj][n] * acc[ai][bj][m][n]; }
                if (m == 3) asm volatile("" ::: "memory"); }
    }
};
struct EpiMoe1 {
    static constexpr bool PERM = true;
    const int* lists; const v4u* tokrec; bf16_t* HID2; int skip;
    __device__ __forceinline__ void operator()(const f32x4 (&acc)[2][2][4][2], const Unit& u, int wr, int wc, int fr, int fq) const {
        if (skip) return;
        const int f = u.pn * 128 + wc * 32 + 8 * fq;
        int tok[2][4]; v4u rec[2][4];
#pragma unroll
        for (int ai = 0; ai < 2; ++ai)
#pragma unroll
            for (int m = 0; m < 4; ++m) { int idx = u.pm * BM + ai * HALF + wr * 64 + m * 16 + fr; idx = idx < u.cnt ? idx : u.cnt - 1; tok[ai][m] = lists[(size_t)u.e * 16384 + idx]; }
#pragma unroll
        for (int ai = 0; ai < 2; ++ai)
#pragma unroll
            for (int m = 0; m < 4; ++m) rec[ai][m] = tokrec[tok[ai][m]];
#pragma unroll
        for (int ai = 0; ai < 2; ++ai)
#pragma unroll
            for (int m = 0; m < 4; ++m) { const int idx = u.pm * BM + ai * HALF + wr * 64 + m * 16 + fr;
                const int slot = ((int)(rec[ai][m].x & 0xffu) == u.e) ? 0 : 1; const float w = __uint_as_float(slot ? rec[ai][m].z : rec[ai][m].y);
                float h[8];
#pragma unroll
                for (int n = 0; n < 2; ++n)
#pragma unroll
                    for (int j = 0; j < 4; ++j) { const float g = acc[ai][0][m][n][j], up = acc[ai][1][m][n][j]; h[n * 4 + j] = g * __builtin_amdgcn_rcpf(1.0f + __expf(-g)) * up * w; }
                u32x4 o; o.x = cvt_pk_bf16(h[0], h[1]); o.y = cvt_pk_bf16(h[2], h[3]); o.z = cvt_pk_bf16(h[4], h[5]); o.w = cvt_pk_bf16(h[6], h[7]);
                if (idx < u.cnt) *(u32x4*)(HID2 + (size_t)tok[ai][m] * 512 + slot * 256 + f) = o; }
    }
};
struct EpiMoe2 {
    static constexpr bool PERM = false;
    const int* lists; float* x; const LAS float* gtab; int skip;
    __device__ __forceinline__ void operator()(const f32x4 (&acc)[2][2][4][2], const Unit& u, int wr, int wc, int fr, int fq) const {
        if (skip) return;
        const int col0 = u.pn * BM + wc * 32 + 4 * fq;
        int tok[2][4];
#pragma unroll
        for (int ai = 0; ai < 2; ++ai)
#pragma unroll
            for (int m = 0; m < 4; ++m) { int idx = u.pm * BM + ai * HALF + wr * 64 + m * 16 + fr; idx = idx < u.cnt ? idx : u.cnt - 1; tok[ai][m] = lists[(size_t)u.e * 16384 + idx]; }
#pragma unroll
        for (int ai = 0; ai < 2; ++ai) {
            f32x4 xi[4][2][2];
#pragma unroll
            for (int m = 0; m < 4; ++m) { const float* xp = x + (size_t)tok[ai][m] * D + col0;
#pragma unroll
                for (int bj = 0; bj < 2; ++bj)
#pragma unroll
                    for (int n = 0; n < 2; ++n) xi[m][bj][n] = *(const f32x4*)(xp + bj * HALF + n * 16); }
#pragma unroll
            for (int m = 0; m < 4; ++m) { const int idx = u.pm * BM + ai * HALF + wr * 64 + m * 16 + fr; const int t = tok[ai][m];
                const LAS float* gp = gtab + (t / SEQ) * D + col0; float* xp = x + (size_t)t * D + col0;
#pragma unroll
                for (int bj = 0; bj < 2; ++bj)
#pragma unroll
                    for (int n = 0; n < 2; ++n) { const f32x4 g = *(const LAS f32x4*)(gp + bj * HALF + n * 16); const f32x4 o = xi[m][bj][n] + g * acc[ai][bj][m][n];
                        if (idx < u.cnt) *(f32x4*)(xp + bj * HALF + n * 16) = o; } }
            asm volatile("" ::: "memory"); }
    }
};

template <class Epi, class Sched, bool GATHER, bool ALIGN_EPI>
__device__ __forceinline__ void gemm_phase(LAS unsigned char* lds, const int lda, const int ldb, const int K, const Sched& S, const Epi& E) {
    int tid_ = threadIdx.x; asm volatile("" : "+v"(tid_));
    const int tid = tid_, wid = __builtin_amdgcn_readfirstlane(tid >> 6), lane = tid & 63, wr = wid >> 2, wc = wid & 3, fr = lane & 15, fq = lane >> 4;
    const int nt = K / BK, ks = S.ks;
    unsigned voffA[2][2], voffB[2], nvA[2][2];
#pragma unroll
    for (int i = 0; i < 2; ++i) { int R, C; stage_rc(tid * 16 + i * 8192, R, C); const int Rb = Epi::PERM ? ((R & ~31) + perm32(R & 31)) : R;
        voffB[i] = (unsigned)(Rb * ldb + C) * 2u; voffA[0][i] = (unsigned)(R * lda + C) * 2u; voffA[1][i] = 0u; nvA[0][i] = 0u; nvA[1][i] = 0u; }
    const size_t kstep = (size_t)(BK * 2);
    const size_t hstepA = GATHER ? (size_t)0 : (size_t)HALF * lda * 2, hstepB = (size_t)HALF * ldb * 2;
    const unsigned ldsw = (unsigned)wid * 1024u;
    const int aoff = lds_byte(wr * 64 + fr, fq * 8), boff = lds_byte(wc * 32 + fr, fq * 8);
#define PG8_SA(b, h) (((b) * 2 + (h)) * HTB)
#define PG8_SB(b, h) ((4 + (b) * 2 + (h)) * HTB)
#define PG8_STAGE(bufoff, gbase, voff) do { _Pragma("unroll") for (int _i = 0; _i < 2; ++_i) \
        __builtin_amdgcn_global_load_lds((const unsigned*)((const char*)(gbase) + (voff)[_i]), (LAS unsigned*)(lds + (bufoff) + ldsw + _i * 8192), 16, 0, 0); } while (0)
#define PG8_STAGE_A(bufoff, gbase, h) do { if constexpr (GATHER) { PG8_STAGE(bufoff, gbase, voffA[h]); } else { PG8_STAGE(bufoff, (gbase) + (h) * hstepA, voffA[0]); } } while (0)
#define PG8_STAGE_B(bufoff, gbase, h) PG8_STAGE(bufoff, (gbase) + (h) * hstepB, voffB)
#define PG8_GATHER_OFFS(dst, u) do { _Pragma("unroll") for (int _h = 0; _h < 2; ++_h) _Pragma("unroll") for (int _i = 0; _i < 2; ++_i) { int _R, _C; stage_rc(tid * 16 + _i * 8192, _R, _C); \
        dst[_h][_i] = (unsigned)(S.row(u, _h * HALF + _R) * lda + _C) * 2u; } } while (0)
#define PG8_LDA(dst, b, h) do { _Pragma("unroll") for (int m = 0; m < 4; ++m) _Pragma("unroll") for (int k = 0; k < 2; ++k) dst[m][k] = *(const LAS bf16x8*)(lds + PG8_SA(b, h) + aoff + m * 2048 + k * 1024); } while (0)
#define PG8_LDB(dst, b, h) do { _Pragma("unroll") for (int n = 0; n < 2; ++n) _Pragma("unroll") for (int k = 0; k < 2; ++k) dst[n][k] = *(const LAS bf16x8*)(lds + PG8_SB(b, h) + boff + n * 2048 + k * 1024); } while (0)
#define PG8_MMA(ai, bj, At, Bt) do { __builtin_amdgcn_s_setprio(1); _Pragma("unroll") for (int m = 0; m < 4; ++m) _Pragma("unroll") for (int n = 0; n < 2; ++n) _Pragma("unroll") for (int k = 0; k < 2; ++k) \
        acc[ai][bj][m][n] = __builtin_amdgcn_mfma_f32_16x16x32_bf16(Bt[n][k], At[m][k], acc[ai][bj][m][n], 0, 0, 0); __builtin_amdgcn_s_setprio(0); } while (0)
#define PG8_WAIT_V(n) asm volatile("s_waitcnt vmcnt(" #n ")" ::: "memory")
#define PG8_WAIT_L(n) asm volatile("s_waitcnt lgkmcnt(" #n ")" ::: "memory")
#define PG8_BAR __builtin_amdgcn_s_barrier()
#define PG8_SCHED __builtin_amdgcn_sched_barrier(0)
#define PG8_BPTR(blo, bhi, t) (((t) < ks) ? (blo) + (size_t)(t) * kstep : (bhi) + (size_t)((t) - ks) * kstep)
    Unit cur, nxt; int ui = 0;
    if (!S.next(0, cur)) return;
    f32x4 acc[2][2][4][2];
#pragma unroll
    for (int a = 0; a < 2; ++a)
#pragma unroll
        for (int b = 0; b < 2; ++b)
#pragma unroll
            for (int m = 0; m < 4; ++m)
#pragma unroll
                for (int n = 0; n < 2; ++n) acc[a][b][m][n] = (f32x4){0.f, 0.f, 0.f, 0.f};
    bf16x8 At[4][2], B0[2][2], B1[2][2];
    const char* cA = S.a_base(cur); const char* cBlo = S.b_lo(cur); const char* cBhi = S.b_hi(cur);
    if constexpr (GATHER) { PG8_GATHER_OFFS(voffA, cur); }
    PG8_STAGE_B(PG8_SB(0, 0), cBlo, 0); PG8_STAGE_B(PG8_SB(0, 1), cBlo, 1); PG8_STAGE_A(PG8_SA(0, 0), cA, 0); PG8_STAGE_A(PG8_SA(0, 1), cA, 1);
    if (wr == 1) PG8_BAR;
    PG8_WAIT_V(2); PG8_BAR;
    PG8_STAGE_B(PG8_SB(1, 0), cBlo + kstep, 0); PG8_STAGE_A(PG8_SA(1, 0), cA + kstep, 0); PG8_STAGE_B(PG8_SB(1, 1), cBlo + kstep, 1);
    PG8_WAIT_V(6); PG8_BAR;
    for (;;) {
        const bool has_next = S.next(ui + 1, nxt);
        const char* nA = has_next ? S.a_base(nxt) : cA; const char* nBlo = has_next ? S.b_lo(nxt) : cBlo; const char* nBhi = has_next ? S.b_hi(nxt) : cBhi;
        if constexpr (GATHER) { if (has_next) { PG8_GATHER_OFFS(nvA, nxt); } else {
#pragma unroll
            for (int h = 0; h < 2; ++h)
#pragma unroll
                for (int i = 0; i < 2; ++i) nvA[h][i] = voffA[h][i]; } }
#pragma unroll 1
        for (int t = 0; t < nt; t += 2) {
            const bool last = (t == nt - 2);
            const char* a1 = cA + (size_t)(t + 1) * kstep;
            const char* a2 = last ? nA : cA + (size_t)(t + 2) * kstep; const char* b2 = last ? nBlo : PG8_BPTR(cBlo, cBhi, t + 2);
            const char* a3 = a2 + kstep; const char* b3 = b2 + kstep;
            PG8_LDB(B0, 0, 0); PG8_LDB(B1, 0, 1); PG8_SCHED; PG8_LDA(At, 0, 0); PG8_STAGE_A(PG8_SA(1, 1), a1, 1);
            if constexpr (GATHER) { if (last) {
#pragma unroll
                for (int h = 0; h < 2; ++h)
#pragma unroll
                    for (int i = 0; i < 2; ++i) voffA[h][i] = nvA[h][i]; } }
            PG8_WAIT_V(8); PG8_WAIT_L(0); PG8_BAR; PG8_MMA(0, 0, At, B0); PG8_MMA(0, 1, At, B1); PG8_BAR; PG8_SCHED;
            PG8_LDA(At, 0, 1); PG8_STAGE_B(PG8_SB(0, 0), b2, 0); PG8_STAGE_B(PG8_SB(0, 1), b2, 1); PG8_STAGE_A(PG8_SA(0, 0), a2, 0);
            PG8_WAIT_V(8); PG8_WAIT_L(0); PG8_BAR; PG8_MMA(1, 0, At, B0); PG8_MMA(1, 1, At, B1); PG8_BAR; PG8_SCHED;
            PG8_LDB(B0, 1, 0); PG8_LDB(B1, 1, 1); PG8_SCHED; PG8_LDA(At, 1, 0); PG8_STAGE_A(PG8_SA(0, 1), a2, 1);
            PG8_WAIT_V(8); PG8_WAIT_L(0); PG8_BAR; PG8_MMA(0, 0, At, B0); PG8_MMA(0, 1, At, B1); PG8_BAR; PG8_SCHED;
            PG8_LDA(At, 1, 1); PG8_STAGE_B(PG8_SB(1, 0), b3, 0); PG8_STAGE_B(PG8_SB(1, 1), b3, 1); PG8_STAGE_A(PG8_SA(1, 0), a3, 0);
            PG8_WAIT_V(8); PG8_WAIT_L(0); PG8_BAR; PG8_MMA(1, 0, At, B0); PG8_MMA(1, 1, At, B1); PG8_BAR; PG8_SCHED;
        }
        if constexpr (ALIGN_EPI) { if (wr == 0) PG8_BAR; }
        E(acc, cur, wr, wc, fr, fq);
        if (!has_next) break;
#pragma unroll
        for (int a = 0; a < 2; ++a)
#pragma unroll
            for (int b = 0; b < 2; ++b)
#pragma unroll
                for (int m = 0; m < 4; ++m)
#pragma unroll
                    for (int n = 0; n < 2; ++n) acc[a][b][m][n] = (f32x4){0.f, 0.f, 0.f, 0.f};
        cur = nxt; cA = nA; cBlo = nBlo; cBhi = nBhi; ++ui;
        if constexpr (ALIGN_EPI) { if (wr == 1) PG8_BAR; }
    }
    PG8_WAIT_V(0);
    if constexpr (!ALIGN_EPI) { if (wr == 0) PG8_BAR; }
    PG8_BAR;
#undef PG8_SA
#undef PG8_SB
#undef PG8_STAGE
#undef PG8_STAGE_A
#undef PG8_STAGE_B
#undef PG8_GATHER_OFFS
#undef PG8_LDA
#undef PG8_LDB
#undef PG8_MMA
#undef PG8_WAIT_V
#undef PG8_WAIT_L
#undef PG8_BAR
#undef PG8_SCHED
#undef PG8_BPTR
}
}

namespace attn_body {
using bf16=__hip_bfloat16;
using bf16x8=__attribute__((ext_vector_type(8)))short;
using s16x4=__attribute__((ext_vector_type(4)))short;
using f32x16=__attribute__((ext_vector_type(16)))float;
using u32x4=__attribute__((ext_vector_type(4)))unsigned;
constexpr int BATCH=4,NHEAD=16,SEQ=4096,D=64,DM=NHEAD*D;
constexpr int NW=8,QBLK=32,QB=QBLK*NW,KVBLK=64,NQB=SEQ/QB;
constexpr int ATTN_PITCH=DM, ATTN_UNIT_ROWS=QB;
__device__ __forceinline__ int crow(int r,int hi){return (r&3)+8*(r>>2)+4*hi;}
#define SBAR() __builtin_amdgcn_sched_barrier(0)
__device__ __forceinline__ void cmask(f32x16&p0,f32x16&p1,int jb,int qrel,int hi){
  const float NEG=-INFINITY; int kb=64*jb+4*hi;
  #pragma unroll
  for(int r=0;r<16;++r){int kv=kb+(r&3)+8*(r>>2); if(kv>qrel)p0[r]=NEG; if(kv+32>qrel)p1[r]=NEG;}
}

constexpr int NSLOT=3, SLOTB=8192;
constexpr int LDS_K=0, LDS_V=NSLOT*SLOTB, LDS_WS=2*NSLOT*SLOTB, LDS_OST=LDS_WS+NW*64*4, LDS_BYTES=LDS_OST+NW*4096;
constexpr float C2=0.125f*1.4426950408889634f;
__device__ __forceinline__ void glds16(const void*gsrc,unsigned lds_dst){unsigned keep;
  asm volatile("s_mov_b32 %0, m0\n\ts_mov_b32 m0, %2\n\ts_nop 0\n\tglobal_load_lds_dwordx4 %1, off\n\ts_mov_b32 m0, %0":"=&s"(keep):"v"(gsrc),"s"(lds_dst):"memory");}
__device__ __forceinline__ float max3f(float a,float b,float c){float r;asm("v_max3_f32 %0, %1, %2, %3":"=v"(r):"v"(a),"v"(b),"v"(c));return r;}
__device__ __forceinline__ float max2f(float a,float b){float r;asm("v_max_f32_e32 %0, %1, %2":"=v"(r):"v"(a),"v"(b));return r;}
__device__ __forceinline__ float fadd_s(float a,float b){float r;asm("v_add_f32_e32 %0, %1, %2":"=v"(r):"v"(a),"v"(b));return r;}
__device__ __forceinline__ float fsub_s(float a,float b){float r;asm("v_sub_f32_e32 %0, %1, %2":"=v"(r):"v"(a),"v"(b));return r;}
typedef float f32x2_t __attribute__((ext_vector_type(2))); typedef float f32x4_t __attribute__((ext_vector_type(4))); typedef __bf16 bf16x2_t __attribute__((ext_vector_type(2)));
__device__ __forceinline__ unsigned cvtpk_s(float lo,float hi){f32x2_t v={lo,hi};bf16x2_t b=__builtin_convertvector(v,bf16x2_t);return __builtin_bit_cast(unsigned,b);}
#define WAIT_BAR(N) asm volatile("s_waitcnt vmcnt(" #N ") lgkmcnt(0)\n\ts_barrier":::"memory")

__device__ __forceinline__ void qkt(f32x16&p0,f32x16&p1,const char*Kslot,const bf16x8*qr,const f32x16&negm,int r32,int hi){
  const char*kb=Kslot+hi*1024+r32*16;
  #pragma unroll
  for(int d0=0;d0<4;++d0){
    const bf16x8 b0=*reinterpret_cast<const bf16x8*>(kb+d0*2048);
    const bf16x8 b1=*reinterpret_cast<const bf16x8*>(kb+d0*2048+512);
    if(d0==0){p0=__builtin_amdgcn_mfma_f32_32x32x16_bf16(b0,qr[0],negm,0,0,0);p1=__builtin_amdgcn_mfma_f32_32x32x16_bf16(b1,qr[0],negm,0,0,0);}
    else{p0=__builtin_amdgcn_mfma_f32_32x32x16_bf16(b0,qr[d0],p0,0,0,0);p1=__builtin_amdgcn_mfma_f32_32x32x16_bf16(b1,qr[d0],p1,0,0,0);}}
}
typedef __attribute__((address_space(3))) const char* lds_cptr;
typedef short v4i16_t __attribute__((ext_vector_type(4)));
__device__ __forceinline__ void kload8(bf16x8*kf,lds_cptr kp){
  kf[0]=*(const __attribute__((address_space(3))) bf16x8*)(kp);      kf[1]=*(const __attribute__((address_space(3))) bf16x8*)(kp+512);
  kf[2]=*(const __attribute__((address_space(3))) bf16x8*)(kp+2048); kf[3]=*(const __attribute__((address_space(3))) bf16x8*)(kp+2560);
  kf[4]=*(const __attribute__((address_space(3))) bf16x8*)(kp+4096); kf[5]=*(const __attribute__((address_space(3))) bf16x8*)(kp+4608);
  kf[6]=*(const __attribute__((address_space(3))) bf16x8*)(kp+6144); kf[7]=*(const __attribute__((address_space(3))) bf16x8*)(kp+6656);
}
__device__ __forceinline__ void kload2(bf16x8*kf,lds_cptr kp,int j){ kf[2*j]=*(const __attribute__((address_space(3))) bf16x8*)(kp+j*2048); kf[2*j+1]=*(const __attribute__((address_space(3))) bf16x8*)(kp+j*2048+512); }
__device__ __forceinline__ s16x4 vtr(lds_cptr p){ return __builtin_bit_cast(s16x4,__builtin_amdgcn_ds_read_tr16_b64_v4i16((__attribute__((address_space(3))) v4i16_t*)p)); }
__device__ __forceinline__ float rowmax(const f32x16&p0,const f32x16&p1){
  float a=max3f(p0[0],p0[1],p1[0]),b=max3f(p0[2],p0[3],p1[1]);a=max3f(a,p1[2],p1[3]);
  #pragma unroll
  for(int r=4;r<16;r+=4){a=max3f(a,p0[r],p0[r+1]);b=max3f(b,p0[r+2],p0[r+3]);a=max3f(a,p1[r],p1[r+1]);b=max3f(b,p1[r+2],p1[r+3]);}
  const float m=max2f(a,b);
  auto rr=__builtin_amdgcn_permlane32_swap(__float_as_uint(m),__float_as_uint(m),false,false);
  return max2f(__uint_as_float(rr[0]),__uint_as_float(rr[1]));
}
__device__ __forceinline__ void pv(f32x16*o,int vb,bf16x8 pa0,bf16x8 pa1,bf16x8 pa2,bf16x8 pa3){
  #pragma unroll
  for(int d0=0;d0<2;++d0){s16x4 lo[4],hi[4];
    #pragma unroll
    for(int ks=0;ks<4;++ks){
      asm volatile("ds_read_b64_tr_b16 %0,%1 offset:%c2":"=&v"(lo[ks]):"v"(vb),"i"(d0*4096+ks*1024):"memory");
      asm volatile("ds_read_b64_tr_b16 %0,%1 offset:%c2":"=&v"(hi[ks]):"v"(vb),"i"(d0*4096+ks*1024+512):"memory");}
    asm volatile("s_waitcnt lgkmcnt(0)":::"memory");SBAR();
    #define PK(k) (bf16x8){lo[k][0],lo[k][1],lo[k][2],lo[k][3],hi[k][0],hi[k][1],hi[k][2],hi[k][3]}
    o[d0]=__builtin_amdgcn_mfma_f32_32x32x16_bf16(pa0,PK(0),o[d0],0,0,0);
    o[d0]=__builtin_amdgcn_mfma_f32_32x32x16_bf16(pa1,PK(1),o[d0],0,0,0);
    o[d0]=__builtin_amdgcn_mfma_f32_32x32x16_bf16(pa2,PK(2),o[d0],0,0,0);
    o[d0]=__builtin_amdgcn_mfma_f32_32x32x16_bf16(pa3,PK(3),o[d0],0,0,0);
    #undef PK
  }
}

#ifndef ATTN_STORE16
#define ATTN_STORE16(p,v) (*(u32x4*)(p)=(v))
#endif
template<int THRL> __device__ __forceinline__ void attn_unit(int b,int h,int qb,int t0,const bf16*Q,const bf16*__restrict__ K,const bf16*__restrict__ V,bf16*O,char*shm,const __attribute__((address_space(3))) float*ncum){
  int tid_=threadIdx.x; asm volatile("":"+v"(tid_)); const int tid=tid_,lane=tid&63,r32=lane&31,hi=lane>>5; const int wid=__builtin_amdgcn_readfirstlane(tid>>6);
  const long rowbase=(long)b*SEQ; const int q0=qb*QB;
  const bf16*Qw=Q+(rowbase+q0+wid*QBLK)*DM+h*D;
  const bf16*Kh=K+(rowbase+(long)t0*KVBLK)*DM+h*D,*Vh=V+(rowbase+(long)t0*KVBLK)*DM+h*D;
  const unsigned lds0=(unsigned)(uintptr_t)shm;
  float*wsf=(float*)(shm+LDS_WS)+wid*64;
  const bf16*ksrc=Kh+(long)lane*DM+wid*8;
  const bf16*vsrc=Vh+(long)(16*(wid&3)+(lane>>2))*DM+(wid>>2)*32+(lane&3)*8;
  const unsigned kdst=lds0+LDS_K+wid*1024, vdst=lds0+LDS_V+wid*1024;
  #define DMA_K(t,slot) glds16(ksrc+(long)(t)*KVBLK*DM,(unsigned)__builtin_amdgcn_readfirstlane(kdst+(slot)))
  #define DMA_V(t,slot) glds16(vsrc+(long)(t)*KVBLK*DM,(unsigned)__builtin_amdgcn_readfirstlane(vdst+(slot)))
  const int vb0=(int)(lds0+LDS_V)+((lane>>4)&1)*32+(lane&3)*8+(4*hi+((lane&15)>>2))*64;
  const char*Kbase=shm+LDS_K; bf16x8 kf[8];
  const lds_cptr shm3=(lds_cptr)shm; const lds_cptr kp0=shm3+LDS_K+hi*1024+r32*16; const lds_cptr vp0=shm3+LDS_V+((lane>>4)&1)*32+(lane&3)*8+(4*hi+((lane&15)>>2))*64;
  const int NT=(q0+QB)/KVBLK-t0;
  DMA_K(0,0);DMA_V(0,0);DMA_K(1,SLOTB);
  bf16x8 qr[4];
  #pragma unroll
  for(int d0=0;d0<4;++d0)qr[d0]=*reinterpret_cast<const bf16x8*>(&Qw[(long)r32*DM+d0*16+hi*8]);
  float mhat=ncum[q0-t0*KVBLK+wid*QBLK+r32],l_reg=0.f;f32x16 o[2];o[0]=f32x16{};o[1]=f32x16{};f32x16 negm; { float z_=-mhat; asm volatile("":"+v"(z_)); _Pragma("unroll") for(int r=0;r<16;++r)negm[r]=z_; } asm volatile("":"+v"(negm));
  const int qrel=wid*QBLK+r32;
  #define CMASK(P0,P1,t) do{int jb_=(t)-(NT-4); if(jb_>=0)cmask(P0,P1,jb_,qrel,hi);}while(0)
  #define CBIAS(P0,P1,t) do{ const __attribute__((address_space(3))) float*cb_=ncum+64*(t)+4*hi; \
    _Pragma("unroll") for(int g4=0;g4<4;++g4){ const f32x4_t b0_=*(const __attribute__((address_space(3))) f32x4_t*)(cb_+8*g4); const f32x4_t b1_=*(const __attribute__((address_space(3))) f32x4_t*)(cb_+32+8*g4); \
      P0[4*g4]+=b0_[0];P0[4*g4+1]+=b0_[1];P0[4*g4+2]+=b0_[2];P0[4*g4+3]+=b0_[3]; P1[4*g4]+=b1_[0];P1[4*g4+1]+=b1_[1];P1[4*g4+2]+=b1_[2];P1[4*g4+3]+=b1_[3]; } }while(0)
  bool resc=false;
  #define START(P0,P1) do{ const float rm=rowmax(P0,P1); resc=false; \
    { const float dl=max2f(rm,0.f); mhat=fadd_s(mhat,dl); \
      _Pragma("unroll") for(int r=0;r<16;++r){P0[r]=fsub_s(P0[r],dl);P1[r]=fsub_s(P1[r],dl);} \
      _Pragma("unroll") for(int r=0;r<16;++r)negm[r]=-mhat; asm volatile("":"+v"(negm)); } \
    _Pragma("unroll") for(int r=0;r<16;++r)P0[r]=__builtin_amdgcn_exp2f(P0[r]); }while(0)
  #define RESC() do{ if(resc){ asm volatile("s_waitcnt lgkmcnt(0)":::"memory"); \
      _Pragma("unroll") for(int d_=0;d_<2;++d_) _Pragma("unroll") for(int r=0;r<16;++r)o[d_][r]*=wsf[crow(r,hi)]; } }while(0)
  f32x16 pA0,pA1,pB0,pB1;
  int sl_prev=0,sl_cur=0,sl_next=SLOTB;
  #define ROT() do{sl_prev=sl_cur;sl_cur=sl_next;sl_next=(sl_next==(NSLOT-1)*SLOTB)?0:sl_next+SLOTB;}while(0)
  DMA_K(2,2*SLOTB);
  WAIT_BAR(3);
  qkt(pA0,pA1,Kbase,qr,negm,r32,hi);asm volatile("s_nop 15\n\ts_nop 7":"+v"(pA0),"+v"(pA1));CBIAS(pA0,pA1,0);CMASK(pA0,pA1,0);
  START(pA0,pA1);
  _Pragma("unroll") for(int r=0;r<16;++r)pA1[r]=__builtin_amdgcn_exp2f(pA1[r]);
  WAIT_BAR(0);
  DMA_K(3,0);DMA_V(1,SLOTB);
  ROT();
  kload8(kf,kp0+sl_cur);
  WAIT_BAR(2);
  s16x4 vlo[8],vhi[8]; u32x4 pw0,pw1,pw2,pw3;
  #define PKW(P,B) cvtpk_s(P[B],P[B+1])
  #define PAF(k) __builtin_bit_cast(bf16x8,pw##k)
  #define VFR(i) (bf16x8){vlo[i][0],vlo[i][1],vlo[i][2],vlo[i][3],vhi[i][0],vhi[i][1],vhi[i][2],vhi[i][3]}
  #define PIN(x) asm volatile("":"+v"(x))
  #define MX3(a,b,c) __builtin_fmaxf(__builtin_fmaxf((a),(b)),(c))
  #define GAPA(MF,A0,A1,A2,A3,W0,W1,PW) do{ MF; sacc+=A0; sacc+=A1; sacc+=A2; sacc+=A3; PIN(sacc); W0; W1; PIN(PW); SBAR(); }while(0)
  #define EX(v) __builtin_amdgcn_exp2f(v)
  #define GAPB(MF,X,B) do{ MF; X[B]=EX(X[B]); X[B+1]=EX(X[B+1]); X[B+2]=EX(X[B+2]); X[B+3]=EX(X[B+3]); PIN(X); SBAR(); }while(0)
  #define VRD(i) do{ vlo[i]=vtr(vp_+(((i)>>2)*4096+((i)&3)*1024)); vhi[i]=vtr(vp_+(((i)>>2)*4096+((i)&3)*1024+512)); }while(0)
  #define KRD(G,j) do{ if(G){ kload2(kf,kp0+sl_next,j); SBAR(); } }while(0)
  #define STEP(C0,C1,P0,P1,t,GK,GV,GL) do{ SBAR(); \
    const lds_cptr vp_=vp0+sl_prev; \
    VRD(0); SBAR(); float sacc=(P0[0]+P0[1]); \
    GAPA(C0=__builtin_amdgcn_mfma_f32_32x32x16_bf16(kf[0],qr[0],negm,0,0,0), P0[2],P0[3],P0[4],P0[5],     pw0[0]=PKW(P0,0), pw0[1]=PKW(P0,2), pw0); \
    VRD(4); SBAR(); GAPA(C1=__builtin_amdgcn_mfma_f32_32x32x16_bf16(kf[1],qr[0],negm,0,0,0), P0[6],P0[7],P0[8],P0[9],     pw0[2]=PKW(P0,4), pw0[3]=PKW(P0,6), pw0); \
    VRD(1); SBAR(); GAPA(C0=__builtin_amdgcn_mfma_f32_32x32x16_bf16(kf[2],qr[1],C0,0,0,0),   P0[10],P0[11],P0[12],P0[13], pw1[0]=PKW(P0,8), pw1[1]=PKW(P0,10), pw1); \
    VRD(5); SBAR(); GAPA(C1=__builtin_amdgcn_mfma_f32_32x32x16_bf16(kf[3],qr[1],C1,0,0,0),   P0[14],P0[15],P1[0],P1[1],   pw1[2]=PKW(P0,12),pw1[3]=PKW(P0,14), pw1); \
    VRD(2); SBAR(); GAPA(C0=__builtin_amdgcn_mfma_f32_32x32x16_bf16(kf[4],qr[2],C0,0,0,0),   P1[2],P1[3],P1[4],P1[5],     pw2[0]=PKW(P1,0), pw2[1]=PKW(P1,2), pw2); \
    VRD(6); SBAR(); GAPA(C1=__builtin_amdgcn_mfma_f32_32x32x16_bf16(kf[5],qr[2],C1,0,0,0),   P1[6],P1[7],P1[8],P1[9],     pw2[2]=PKW(P1,4), pw2[3]=PKW(P1,6), pw2); \
    VRD(3); SBAR(); GAPA(C0=__builtin_amdgcn_mfma_f32_32x32x16_bf16(kf[6],qr[3],C0,0,0,0),   P1[10],P1[11],P1[12],P1[13], pw3[0]=PKW(P1,8), pw3[1]=PKW(P1,10), pw3); \
    VRD(7); SBAR(); GAPA(C1=__builtin_amdgcn_mfma_f32_32x32x16_bf16(kf[7],qr[3],C1,0,0,0),   P1[14],P1[15],0.f,0.f,       pw3[2]=PKW(P1,12),pw3[3]=PKW(P1,14), pw3); \
    l_reg+=sacc; \
    if(GK){DMA_K((t)+3,sl_cur);} if(GV){DMA_V((t)+1,sl_next);} \
    CBIAS(C0,C1,t); CMASK(C0,C1,t); \
    { float a=MX3(C0[0],C0[1],C1[0]),b=MX3(C0[2],C0[3],C1[1]); a=MX3(a,C1[2],C1[3]); \
      _Pragma("unroll") for(int r=4;r<16;r+=4){a=MX3(a,C0[r],C0[r+1]);b=MX3(b,C0[r+2],C0[r+3]);a=MX3(a,C1[r],C1[r+1]);b=MX3(b,C1[r+2],C1[r+3]);} \
      float rm=__builtin_fmaxf(a,b); { auto rr=__builtin_amdgcn_permlane32_swap(__float_as_uint(rm),__float_as_uint(rm),false,false); rm=__builtin_fmaxf(__uint_as_float(rr[0]),__uint_as_float(rr[1])); } \
      resc=false; \
      if(__builtin_expect(__any(rm>(float)THRL),0)){ const float dl=__builtin_fmaxf(rm,0.f); mhat+=dl; \
        _Pragma("unroll") for(int r=0;r<16;++r){C0[r]-=dl;C1[r]-=dl;} \
        _Pragma("unroll") for(int r=0;r<16;++r)negm[r]=-mhat; asm volatile("":"+v"(negm)); \
        const float f=__builtin_amdgcn_exp2f(-dl); l_reg*=f; if(hi==0)wsf[r32]=f; resc=true; } } \
    SBAR(); \
    GAPB(o[0]=__builtin_amdgcn_mfma_f32_32x32x16_bf16(PAF(0),VFR(0),o[0],0,0,0), C0,0); \
    GAPB(o[1]=__builtin_amdgcn_mfma_f32_32x32x16_bf16(PAF(0),VFR(4),o[1],0,0,0), C0,4); \
    KRD(GL,0); GAPB(o[0]=__builtin_amdgcn_mfma_f32_32x32x16_bf16(PAF(1),VFR(1),o[0],0,0,0), C0,8); \
    KRD(GL,1); GAPB(o[1]=__builtin_amdgcn_mfma_f32_32x32x16_bf16(PAF(1),VFR(5),o[1],0,0,0), C0,12); \
    KRD(GL,2); GAPB(o[0]=__builtin_amdgcn_mfma_f32_32x32x16_bf16(PAF(2),VFR(2),o[0],0,0,0), C1,0); \
    KRD(GL,3); GAPB(o[1]=__builtin_amdgcn_mfma_f32_32x32x16_bf16(PAF(2),VFR(6),o[1],0,0,0), C1,4); \
    GAPB(o[0]=__builtin_amdgcn_mfma_f32_32x32x16_bf16(PAF(3),VFR(3),o[0],0,0,0), C1,8); \
    GAPB(o[1]=__builtin_amdgcn_mfma_f32_32x32x16_bf16(PAF(3),VFR(7),o[1],0,0,0), C1,12); \
    }while(0)
  int t=1;
  #undef CMASK
  #define CMASK(P0,P1,t) do{}while(0)
  for(;t+5<NT;t+=2){
    STEP(pB0,pB1,pA0,pA1,t,true,true,true);     WAIT_BAR(2); RESC(); ROT();
    STEP(pA0,pA1,pB0,pB1,t+1,true,true,true);   WAIT_BAR(2); RESC(); ROT();
  }
  #undef CMASK
  #define CMASK(P0,P1,t) do{int jb_=(t)-(NT-4); if(jb_>=0)cmask(P0,P1,jb_,qrel,hi);}while(0)
  #define ENDW(tt) do{ if((tt)+3<NT){WAIT_BAR(2);} else if((tt)+2<NT){WAIT_BAR(1);} else {WAIT_BAR(0);} }while(0)
  for(;t+1<NT;t+=2){
    STEP(pB0,pB1,pA0,pA1,t,(t+3<NT),(t+1<NT),(t+1<NT));       ENDW(t);   RESC(); ROT();
    STEP(pA0,pA1,pB0,pB1,t+1,(t+4<NT),(t+2<NT),(t+2<NT));     ENDW(t+1); RESC(); ROT();
  }
  STEP(pB0,pB1,pA0,pA1,NT-1,false,false,false); RESC();
  { float sacc=pB0[0]+pB0[1]; _Pragma("unroll") for(int r=2;r<16;++r)sacc+=pB0[r]; _Pragma("unroll") for(int r=0;r<16;++r)sacc+=pB1[r]; l_reg+=sacc;
    pw0=(u32x4){PKW(pB0,0),PKW(pB0,2),PKW(pB0,4),PKW(pB0,6)};pw1=(u32x4){PKW(pB0,8),PKW(pB0,10),PKW(pB0,12),PKW(pB0,14)};pw2=(u32x4){PKW(pB1,0),PKW(pB1,2),PKW(pB1,4),PKW(pB1,6)};pw3=(u32x4){PKW(pB1,8),PKW(pB1,10),PKW(pB1,12),PKW(pB1,14)};
    SBAR(); pv(o,vb0+sl_cur,PAF(0),PAF(1),PAF(2),PAF(3)); }
  #undef PKW
  #undef PAF
  #undef VFR
  #undef PIN
  #undef MX3
  #undef GAPA
  #undef GAPB
  #undef EX
  #undef VRD
  #undef KRD
  #undef STEP
  #undef ENDW
  {auto rr=__builtin_amdgcn_permlane32_swap(__float_as_uint(l_reg),__float_as_uint(l_reg),false,false);l_reg=__uint_as_float(rr[0])+__uint_as_float(rr[1]);}
  if(hi==0)wsf[32+r32]=l_reg;asm volatile("s_waitcnt lgkmcnt(0)":::"memory");
  float rli[16];
  #pragma unroll
  for(int r=0;r<16;++r)rli[r]=__builtin_amdgcn_rcpf(wsf[32+crow(r,hi)]);
  bf16*Ow=O+(rowbase+q0+wid*QBLK)*DM+h*D;
  { bf16*stg=(bf16*)(shm+LDS_OST)+wid*2048;
    #pragma unroll
    for(int r=0;r<16;++r){const int orow=crow(r,hi);
      #pragma unroll
      for(int d0=0;d0<2;++d0)stg[orow*64+d0*32+r32]=__float2bfloat16(o[d0][r]*rli[r]);}
    asm volatile("s_waitcnt lgkmcnt(0)":::"memory");
    #pragma unroll
    for(int i=0;i<4;++i){const int row=i*8+(lane>>3),ch=lane&7; const u32x4 v=*(const u32x4*)(stg+row*64+ch*8); ATTN_STORE16(Ow+(long)row*DM+ch*8,v);} }
  asm volatile("s_waitcnt lgkmcnt(0)\n\ts_barrier":::"memory");
  #undef DMA_K
  #undef DMA_V
  #undef CMASK
  #undef CBIAS
  #undef START
  #undef RESC
  #undef ROT
}
constexpr int ATTN_LDS_BYTES=LDS_BYTES;
struct AttnTensors { const bf16* Q; const bf16* K; const bf16* V; bf16* O; };
__device__ __forceinline__ void fox_phase(char*lds,const bf16*Q,const bf16*K,const bf16*V,bf16*O,const float*CUM,const float*qg,const float*kg,int grid,int block){
  const int vcu=(grid%8==0)?(block%8)*(grid/8)+block/8:block; const int bh=vcu>>2, s=vcu&3;
  if(bh>=BATCH*NHEAD)return;
  float*nc=(float*)(lds+98304);
  for(int i=threadIdx.x;i<SEQ;i+=512)nc[i]=CUM[(size_t)bh*SEQ+i];
  const int lane=threadIdx.x&63;
  float gq=fabsf(qg[lane]),gk=fabsf(kg[lane]);
  #pragma unroll
  for(int o=1;o<64;o<<=1){gq=fmaxf(gq,__shfl_xor(gq,o));gk=fmaxf(gk,__shfl_xor(gk,o));}
  const float thresh=2.0f*(8.0f*gq*C2)*(8.0f*gk)*1.02f+32.0f;
  __syncthreads();
  const __attribute__((address_space(3))) float*ncum=(const __attribute__((address_space(3))) float*)(nc);
  for(int i=0;i<4;++i){ const int qb=(i==0)?s:(i==1)?7-s:(i==2)?8+s:15-s; const int NTf=4*qb+4;
    const bool ok=(lane<NTf-4)&&(ncum[qb*QB]-ncum[64*lane+63]>=thresh);
    int t0=__builtin_popcountll(__ballot(ok))&~1; t0=__builtin_amdgcn_readfirstlane(t0);
    attn_unit<8>(bh/NHEAD,bh%NHEAD,qb,t0,Q,K,V,O,lds,ncum+64*t0); }
}
template<int H> __device__ __forceinline__ void qkt_half(f32x16&p,const char*Kslot,const bf16x8*qr,int r32,int hi){
  const char*kb=Kslot+hi*1024+r32*16+H*512;
  #pragma unroll
  for(int d0=0;d0<4;++d0){ const bf16x8 b=*reinterpret_cast<const bf16x8*>(kb+d0*2048);
    if(d0==0){ f32x16 z=f32x16{}; p=__builtin_amdgcn_mfma_f32_32x32x16_bf16(b,qr[0],z,0,0,0); } else p=__builtin_amdgcn_mfma_f32_32x32x16_bf16(b,qr[d0],p,0,0,0); }
}
template<int H> __device__ __forceinline__ void pv_half(f32x16*o,int vb,bf16x8 pa0,bf16x8 pa1){
  #pragma unroll
  for(int d0=0;d0<2;++d0){s16x4 lo[2],hi[2];
    #pragma unroll
    for(int ks=0;ks<2;++ks){
      asm volatile("ds_read_b64_tr_b16 %0,%1 offset:%c2":"=&v"(lo[ks]):"v"(vb),"i"(d0*4096+(2*H+ks)*1024):"memory");
      asm volatile("ds_read_b64_tr_b16 %0,%1 offset:%c2":"=&v"(hi[ks]):"v"(vb),"i"(d0*4096+(2*H+ks)*1024+512):"memory");}
    asm volatile("s_waitcnt lgkmcnt(0)":::"memory");SBAR();
    #define PK(k) (bf16x8){lo[k][0],lo[k][1],lo[k][2],lo[k][3],hi[k][0],hi[k][1],hi[k][2],hi[k][3]}
    o[d0]=__builtin_amdgcn_mfma_f32_32x32x16_bf16(pa0,PK(0),o[d0],0,0,0);
    o[d0]=__builtin_amdgcn_mfma_f32_32x32x16_bf16(pa1,PK(1),o[d0],0,0,0);
    #undef PK
  }
}
template<int SKIP> __device__ __forceinline__ void dil_core(f32x16*o,float&mx_out,float&l_out,const char*Kh,const bf16x8*qr,const __attribute__((address_space(3))) float*eb,int nb,int ktlo,int rot,int vb0,int r32,int hi){
  f32x16 s[6];
  #pragma unroll
  for(int hh=0;hh<6;++hh){ if(hh==SKIP)continue; const int i=hh>>1,hf=hh&1,kt=ktlo+i;
    if(hf==0)qkt_half<0>(s[hh],Kh+(kt^rot)*8192,qr,r32,hi); else qkt_half<1>(s[hh],Kh+(kt^rot)*8192,qr,r32,hi);
    if(nb==0&&kt<2){
      #pragma unroll
      for(int r=0;r<16;++r)s[hh][r]=-1e30f; }
    else {
      #pragma unroll
      for(int r=0;r<16;++r){ const int c=(r&3)+8*(r>>2); s[hh][r]+=eb[59-c-32*hf+128-64*i]; } } }
  float mx=-1e30f;
  #pragma unroll
  for(int hh=0;hh<6;++hh){ if(hh==SKIP)continue;
    #pragma unroll
    for(int r=0;r<16;++r)mx=fmaxf(mx,s[hh][r]); }
  { auto rr=__builtin_amdgcn_permlane32_swap(__float_as_uint(mx),__float_as_uint(mx),false,false); mx=fmaxf(__uint_as_float(rr[0]),__uint_as_float(rr[1])); }
  float l=0.f;
  #pragma unroll
  for(int hh=0;hh<6;++hh){ if(hh==SKIP)continue;
    #pragma unroll
    for(int r=0;r<16;++r){ s[hh][r]=__builtin_amdgcn_exp2f(s[hh][r]-mx); l+=s[hh][r]; } }
  { auto rr=__builtin_amdgcn_permlane32_swap(__float_as_uint(l),__float_as_uint(l),false,false); l=__uint_as_float(rr[0])+__uint_as_float(rr[1]); }
  #define PKW(P,B) cvtpk_s(P[B],P[B+1])
  #pragma unroll
  for(int hh=0;hh<6;++hh){ if(hh==SKIP)continue; const int i=hh>>1,hf=hh&1,kt=ktlo+i;
    const u32x4 pwa=(u32x4){PKW(s[hh],0),PKW(s[hh],2),PKW(s[hh],4),PKW(s[hh],6)},pwb=(u32x4){PKW(s[hh],8),PKW(s[hh],10),PKW(s[hh],12),PKW(s[hh],14)};
    if(hf==0)pv_half<0>(o,vb0+(kt^rot)*8192,__builtin_bit_cast(bf16x8,pwa),__builtin_bit_cast(bf16x8,pwb)); else pv_half<1>(o,vb0+(kt^rot)*8192,__builtin_bit_cast(bf16x8,pwa),__builtin_bit_cast(bf16x8,pwb)); }
  #undef PKW
  mx_out=mx; l_out=l;
}
template<int R> __device__ __forceinline__ void dil_unit(int g,int b,int j,int nb,int hp,int u,const bf16*Q,const bf16*__restrict__ K,const bf16*__restrict__ V,const float*__restrict__ BIASV,bf16*ORUN,float*LSE,char*shm,char*aux){
  typedef __attribute__((address_space(3))) char* lptr;
  int tid_=threadIdx.x; asm volatile("":"+v"(tid_)); const int tid=tid_,lane=tid&63,r32=lane&31,hi=lane>>5; const int wid=__builtin_amdgcn_readfirstlane(tid>>6);
  const int hl=wid>>2,qs=wid&3,h=2*hp+hl;
  const unsigned lds0=(unsigned)(uintptr_t)shm;
  float*bvl=(float*)aux;
  float*wsf=(float*)(aux+2048)+wid*64;
  const long rowbase=(long)b*SEQ;
  const int rot=(u&1)*2;
  { const int wv=tid>>6, rowK=(lane&15)+16*(wv&3), chK=(lane>>4)+4*(wv>>2), rowV=(lane>>2)+16*(wv&3), chV=(lane&3)+4*(wv>>2); u32x4 val[16];
    #pragma unroll
    for(int it=0;it<16;++it){ const int kt=it&3,kv=(it>>2)&1,hh=it>>3; val[it]=(u32x4){0u,0u,0u,0u}; const int row=kv?rowV:rowK, ch=kv?chV:chK;
      const bool need=(kt>=2)||(u==0&&nb>0);
      if(need){ const int kp=nb*128-128+kt*64+row; const bf16*src=(kv?V:K)+(rowbase+(long)kp*R+j)*DM+(2*hp+hh)*D+ch*8; val[it]=*reinterpret_cast<const u32x4*>(src); } }
    { const int hh=tid>>8, x=tid&255, dd=x-64; bvl[hh*256+x]=(dd>=0&&dd<=128)?BIASV[(g*16+2*hp+hh)*132+dd]:-1e30f; }
    #pragma unroll
    for(int it=0;it<16;++it){ const int kt=it&3,kv=(it>>2)&1,hh=it>>3; const int row=kv?rowV:rowK, ch=kv?chV:chK;
      const bool need=(kt>=2)||(u==0&&nb>0), zfill=(kv==1)&&(u==0)&&(nb==0)&&(kt<2);
      const int off=hh*65536+kv*32768+(kt^rot)*8192+(kv?((ch>>2)*4096+row*64+(ch&3)*16):(ch*1024+row*16));
      if(need||zfill) *reinterpret_cast<__attribute__((address_space(3))) u32x4*>((lptr)shm+off)=val[it]; }
  }
  const int p0q=nb*128+32*qs;
  const bf16*Qw=Q+(rowbase+(long)(p0q+r32)*R+j)*DM+h*D;
  bf16x8 qr[4];
  #pragma unroll
  for(int d0=0;d0<4;++d0)qr[d0]=*reinterpret_cast<const bf16x8*>(&Qw[d0*16+hi*8]);
  const long orow=rowbase+(long)(p0q+r32)*R+j;
  float lr_old=0.f; u32x4 ov_old[4];
  #pragma unroll
  for(int i=0;i<4;++i)ov_old[i]=(u32x4){0u,0u,0u,0u};
  if(g>0){ lr_old=LSE[orow*16+h];
    #pragma unroll
    for(int i=0;i<4;++i){const int row=i*8+(lane>>3),ch=lane&7; ov_old[i]=*(const u32x4*)(ORUN+(rowbase+(long)(p0q+row)*R+j)*DM+h*D+ch*8);} }
  asm volatile("s_waitcnt vmcnt(0) lgkmcnt(0)\n\ts_barrier":::"memory");
  const int ktlo=(qs>=2)?1:0;
  const char*Kh=shm+hl*65536;
  const __attribute__((address_space(3))) float*eb=(const __attribute__((address_space(3))) float*)((lptr)aux)+hl*256+(32*qs+128-64*ktlo)+r32-4*hi-123;
  f32x16 o[2]; o[0]=f32x16{}; o[1]=f32x16{};
  const int vb0=(int)lds0+hl*65536+32768+((lane>>4)&1)*32+(lane&3)*8+(4*hi+((lane&15)>>2))*64;
  float mx,l;
  if(qs&1) dil_core<0>(o,mx,l,Kh,qr,eb,nb,ktlo,rot,vb0,r32,hi); else dil_core<5>(o,mx,l,Kh,qr,eb,nb,ktlo,rot,vb0,r32,hi);
  float lse=mx*0.6931471805599453f+__logf(l), a=1.0f/l, bco=0.f;
  if(g>0){ const float lr=lr_old; const float mxl=fmaxf(lr,lse), nl=mxl+__logf(__expf(lr-mxl)+__expf(lse-mxl)); a=__expf(lse-nl)/l; bco=__expf(lr-nl); lse=nl; }
  if(hi==0){ wsf[r32]=a; wsf[32+r32]=bco; LSE[orow*16+h]=lse; }
  asm volatile("s_waitcnt lgkmcnt(0)\n\ts_barrier":::"memory");
  float av[16];
  #pragma unroll
  for(int r=0;r<16;++r)av[r]=wsf[crow(r,hi)];
  { bf16*stg=(bf16*)(shm+(wid>>2)*65536+(rot+((wid>>1)&1))*8192+(wid&1)*4096);
    #pragma unroll
    for(int r=0;r<16;++r){const int orw=crow(r,hi);
      #pragma unroll
      for(int d0=0;d0<2;++d0)stg[orw*64+d0*32+r32]=__float2bfloat16(o[d0][r]*av[r]);}
    asm volatile("s_waitcnt lgkmcnt(0)":::"memory");
    #pragma unroll
    for(int i=0;i<4;++i){const int row=i*8+(lane>>3),ch=lane&7; u32x4 v=*(const u32x4*)(stg+row*64+ch*8);
      bf16*dst=ORUN+(rowbase+(long)(p0q+row)*R+j)*DM+h*D+ch*8;
      if(g>0){ const float bc=wsf[32+row]; const u32x4 ov=ov_old[i]; u32x4 w;
        #pragma unroll
        for(int q=0;q<4;++q){ const float n0=__uint_as_float(v[q]<<16)+bc*__uint_as_float(ov[q]<<16), n1=__uint_as_float(v[q]&0xffff0000u)+bc*__uint_as_float(ov[q]&0xffff0000u); w[q]=cvtpk_s(n0,n1); }
        v=w; }
      *(u32x4*)dst=v; } }
  asm volatile("s_waitcnt lgkmcnt(0)\n\ts_barrier":::"memory");
}
template<int R> __device__ __forceinline__ void dil_phase(int g,char*lds,char*aux,const bf16*Q,const bf16*K,const bf16*V,const float*BIASV,bf16*ORUN,float*LSE,int grid,int block){
  constexpr int NBK=32/R, CL=NBK<4?NBK:4, CPZ=NBK/CL, NCH=1024/CL;
  for(int ch=block;ch<NCH;ch+=grid){ const int hp=ch&7,t=ch>>3,nb0=(t%CPZ)*CL,z=t/CPZ;
    #pragma unroll 1
    for(int u=0;u<CL;++u) dil_unit<R>(g,z/R,z%R,nb0+u,hp,u,Q,K,V,BIASV,ORUN,LSE,lds,aux); }
}
#undef SBAR
#undef WAIT_BAR
}

__device__ __forceinline__ LAS int* moe_tables(Frame& F, int layer, bool combo) {
    LAS int* tab = (LAS int*)(F.lds + LDSCTL_OFF + 1024);
    const int nl = combo ? 24 : 16;
    if (F.tid < nl) tab[32 + F.tid] = (int)__hip_atomic_load(F.ctl + CW_CNT + (layer * 40 + (combo ? 16 : 0) + F.tid) * 64, RLX_AGENT);
    __syncthreads();
    if (F.tid == 0) { int run = 0;
        for (int k = 0; k < nl; ++k) { tab[k] = run; run += (tab[32 + k] + 255) >> 8; }
        tab[nl] = run; }
    __syncthreads();
    return tab;
}

#define MOE_PHASES(layer, P1, P2) \
    PHASE(P1) { LAS int* tab = moe_tables(F, layer, false); \
        pg8::MoeOrder S{F.G, (int)blockIdx.x, 16, 2, 16, 1, (const char*)(F.ws + WS_HM), (const char*)(F.ws + WS_MOE1 + (size_t)(layer) * 16 * 512 * 1024 * 2), (const int*)(F.ws + WS_ELIST), tab}; \
        pg8::EpiMoe1 E{(const int*)(F.ws + WS_ELIST), (const v4u*)(F.ws + WS_TOKREC), (bf16*)(F.ws + WS_HID2), F.flags & 4}; \
        pg8::gemm_phase<pg8::EpiMoe1, pg8::MoeOrder, true, true>(F.lds + RING_OFF, 1024, 1024, 1024, S, E); SEAM(P1); } \
    PHASE(P2) { LAS int* tab = moe_tables(F, layer, true); \
        { LAS float* gt = (LAS float*)(F.lds + GTAB_OFF); const float* gv = (const float*)(F.ws + WS_MOD) + (size_t)(layer) * 4 * 6144 + 5 * D; const float gs = (F.flags & 1) ? 0.5f : 1.0f; \
          for (int i = F.tid; i < 4 * D; i += NWAVES * 64) gt[i] = gv[(size_t)(i >> 10) * 6144 + (i & 1023)] * gs; __syncthreads(); } \
        pg8::MoeOrder S{F.G, (int)blockIdx.x, 24, 4, 4, 2, (const char*)(F.ws + WS_HID2), (const char*)(F.ws + WS_MOE2 + (size_t)(layer) * 16 * 1024 * 256 * 2), (const int*)(F.ws + WS_CLIST), tab}; \
        pg8::EpiMoe2 E{(const int*)(F.ws + WS_CLIST), F.out, (const LAS float*)(F.lds + GTAB_OFF), F.flags & 4}; \
        pg8::gemm_phase<pg8::EpiMoe2, pg8::MoeOrder, true, true>(F.lds + RING_OFF, 512, 256, 512, S, E); SEAM(P2); }

__global__ void __launch_bounds__(NWAVES * 64, 2) mk_fwd(Args args) {
    extern __shared__ __attribute__((aligned(16))) unsigned char lds[];
    Frame F;
    F.lds = (LAS unsigned char*)lds;
    F.MISC = (volatile LAS unsigned*)(F.lds + MISC_OFF);
    F.tid = threadIdx.x; F.lane = F.tid & 63; F.wave = __builtin_amdgcn_readfirstlane(F.tid >> 6);
    F.G = gridDim.x; { const int bx = blockIdx.x; F.vcu = (F.G % 8 == 0) ? (bx % 8) * (F.G / 8) + bx / 8 : bx; }
    F.ws = args.ws; F.ctl = (gu32*)(args.ws + WS_CTL); F.in = args.in; F.out = args.out; F.flags = args.flags;
    for (int u = F.tid; u < (LDS_BYTES - LDSCTL_OFF) / 4; u += NWAVES * 64) ((LAS unsigned*)(F.lds + LDSCTL_OFF))[u] = 0u;
    __syncthreads();
    XcdBarrier bar; bar.bar = (unsigned*)(F.ctl + CW_BAR); bar.x = 0; bar.st = nullptr;
    if (MK_MODE == 0) bar = xcd_barrier_post((unsigned*)(F.ctl + CW_BAR), F.MISC + 8);
    const int lo = args.ph_lo, hi = args.ph_hi;
#define IN(k) (lo <= (k) && (k) < hi && frame_refresh(F))
#define PHASE(k) if (IN(k)) for (int rep_ = 0; rep_ < ((((DUP_MASK) >> (k)) & 1u) ? 2 : 1); ++rep_)
#define SEAM(k) do { if (MK_MODE == 0 && lo <= (k) + 1 && (k) + 1 < hi) xcd_barrier(bar); } while (0)

    PHASE(PH_PRO) { p0_prologue(F); SEAM(PH_PRO); }
    PHASE(PH_ROW_A) { rowpass<0>(F, F.in[I_X], F.in[I_NMIX], 0, 0, 1); SEAM(PH_ROW_A); }
    {
#pragma unroll
        for (int g = 0; g < 3; ++g) {
            PHASE(PH_QKV_A0 + 2 * g) {
                pg8::StaticOrder S; S.init(M, 3072, F.G, (int)blockIdx.x, F.ws + WS_HM, 1024, F.ws + WS_WAIN + (size_t)g * 3072 * 1024 * 2, 1024, 16);
                pg8::EpiQKV E{(bf16*)(F.ws + WS_Q), F.in[I_AQN], F.in[I_AKN]};
                pg8::gemm_phase<pg8::EpiQKV, pg8::StaticOrder, false, true>(F.lds + RING_OFF, 1024, 1024, 1024, S, E);
                SEAM(PH_QKV_A0 + 2 * g);
            }
            PHASE(PH_ATT_A0 + 2 * g) {
                typedef attn_body::bf16 ab16;
                if (g == 0) attn_body::dil_phase<1>(0, (char*)lds + RING_OFF, (char*)lds + LDSCTL_OFF + 2048, (const ab16*)(F.ws + WS_Q), (const ab16*)(F.ws + WS_K), (const ab16*)(F.ws + WS_V), (const float*)(F.ws + WS_BIASV), (ab16*)(F.ws + WS_ORUN), (float*)(F.ws + WS_LSE), F.G, (int)blockIdx.x);
                if (g == 1) attn_body::dil_phase<4>(1, (char*)lds + RING_OFF, (char*)lds + LDSCTL_OFF + 2048, (const ab16*)(F.ws + WS_Q), (const ab16*)(F.ws + WS_K), (const ab16*)(F.ws + WS_V), (const float*)(F.ws + WS_BIASV), (ab16*)(F.ws + WS_ORUN), (float*)(F.ws + WS_LSE), F.G, (int)blockIdx.x);
                if (g == 2) attn_body::dil_phase<16>(2, (char*)lds + RING_OFF, (char*)lds + LDSCTL_OFF + 2048, (const ab16*)(F.ws + WS_Q), (const ab16*)(F.ws + WS_K), (const ab16*)(F.ws + WS_V), (const float*)(F.ws + WS_BIASV), (ab16*)(F.ws + WS_ORUN), (float*)(F.ws + WS_LSE), F.G, (int)blockIdx.x);
                SEAM(PH_ATT_A0 + 2 * g);
            }
        }
    }
    PHASE(PH_OUT_A) {
        pg8::StaticOrder S; S.init(M, 1024, F.G, (int)blockIdx.x, F.ws + WS_ORUN, 1024, F.ws + WS_WAOUT, 1024, 16);
        pg8::EpiOut E{F.in[I_X], F.out, (const float*)(F.ws + WS_MOD) + 2 * D};
        pg8::gemm_phase<pg8::EpiOut, pg8::StaticOrder, false, false>(F.lds + RING_OFF, 1024, 1024, 1024, S, E);
        SEAM(PH_OUT_A);
    }
    PHASE(PH_ROW_F0) { rowpass<2>(F, F.out, F.in[I_NFFN], 0, 3, 4); SEAM(PH_ROW_F0); }
    MOE_PHASES(0, PH_MOE1_0, PH_MOE2_0)
    PHASE(PH_ROW_B) { rowpass<1>(F, F.out, F.in[I_NMIX] + D, 1, 0, 1); SEAM(PH_ROW_B); }
    PHASE(PH_CUM) { cumsum_phase(F); }
    PHASE(PH_QKV_B) {
        pg8::StaticOrder S; S.init(M, 3072, F.G, (int)blockIdx.x, F.ws + WS_HM, 1024, F.ws + WS_WBIN, 1024, 16);
        pg8::EpiQKV E{(bf16*)(F.ws + WS_Q), F.in[I_BQN], F.in[I_BKN]};
        pg8::gemm_phase<pg8::EpiQKV, pg8::StaticOrder, false, true>(F.lds + RING_OFF, 1024, 1024, 1024, S, E);
        SEAM(PH_QKV_B);
    }
    PHASE(PH_ATT_B) {
        typedef attn_body::bf16 ab16;
        attn_body::fox_phase((char*)lds + RING_OFF, (const ab16*)(F.ws + WS_Q), (const ab16*)(F.ws + WS_K), (const ab16*)(F.ws + WS_V), (ab16*)(F.ws + WS_ORUN), (const float*)(F.ws + WS_CUM), F.in[I_BQN], F.in[I_BKN], F.G, (int)blockIdx.x);
        SEAM(PH_ATT_B);
    }
    PHASE(PH_OUT_B) {
        pg8::StaticOrder S; S.init(M, 1024, F.G, (int)blockIdx.x, F.ws + WS_ORUN, 1024, F.ws + WS_WBOUT, 1024, 16);
        pg8::EpiOut E{F.out, F.out, (const float*)(F.ws + WS_MOD) + (size_t)4 * 6144 + 2 * D};
        pg8::gemm_phase<pg8::EpiOut, pg8::StaticOrder, false, false>(F.lds + RING_OFF, 1024, 1024, 1024, S, E);
        SEAM(PH_OUT_B);
    }
    PHASE(PH_ROW_F1) { rowpass<2>(F, F.out, F.in[I_NFFN] + D, 1, 3, 4); SEAM(PH_ROW_F1); }
    MOE_PHASES(1, PH_MOE1_1, PH_MOE2_1)
#undef IN
#undef PHASE
#undef SEAM
}

__global__ void __launch_bounds__(256) nk_qkv(const bf16* __restrict__ A, const float* __restrict__ W, int ldw, int col0, const float* __restrict__ qg, const float* __restrict__ kg,
                                              bf16* Qo, bf16* Ko, bf16* Vo) {
    const long gw = ((long)blockIdx.x * blockDim.x + threadIdx.x) >> 6; const int lane = threadIdx.x & 63;
    if (gw >= (long)M * 48) return;
    const int m = (int)(gw / 48), ch = (int)(gw % 48), t = ch / 16, h = ch % 16;
    const bf16* a = A + (size_t)m * D; const float* w = W + col0 + ch * 64 + lane;
    float acc = 0.f;
    for (int k = 0; k < D; ++k) acc += bf2f(a[k]) * w[(size_t)k * ldw];
    if (t < 2) { const float ss = wave_sum(acc * acc) * (1.f / 64.f); const float g = (t == 0 ? qg : kg)[lane]; acc = acc * (1.0f / sqrtf(ss + EPS)) * g; if (t == 0) acc *= C2; }
    bf16* o = (t == 0 ? Qo : (t == 1 ? Ko : Vo)); o[(size_t)m * D + h * 64 + lane] = (bf16)f2bf(acc);
}
__global__ void __launch_bounds__(256) nk_out(const bf16* __restrict__ A, const float* __restrict__ W, const float* xin, const float* __restrict__ gvec, float* xout) {
    const long gw = ((long)blockIdx.x * blockDim.x + threadIdx.x) >> 6; const int lane = threadIdx.x & 63;
    if (gw >= (long)M * 16) return;
    const int m = (int)(gw / 16), c = (int)(gw % 16) * 64 + lane, b = m / SEQ;
    const bf16* a = A + (size_t)m * D; float acc = 0.f;
    for (int k = 0; k < D; ++k) acc += bf2f(a[k]) * W[(size_t)k * D + c];
    xout[(size_t)m * D + c] = xin[(size_t)m * D + c] + gvec[(size_t)b * 6144 + c] * acc;
}
__global__ void __launch_bounds__(256) nk_moe1(const bf16* __restrict__ HF, const v4u* __restrict__ tokrec, const float* __restrict__ Wg, const float* __restrict__ Wu, bf16* HID2) {
    const long gw = ((long)blockIdx.x * blockDim.x + threadIdx.x) >> 6; const int lane = threadIdx.x & 63;
    if (gw >= (long)M * 8) return;
    const int m = (int)(gw / 8), rest = (int)(gw % 8), slot = rest / 4, f = (rest % 4) * 64 + lane;
    const v4u rec = tokrec[m]; const int e = slot ? (rec.x >> 8) & 0xff : rec.x & 0xff; const float w = __uint_as_float(slot ? rec.z : rec.y);
    const bf16* a = HF + (size_t)m * D; const float* wg = Wg + (size_t)e * D * FF + f; const float* wu = Wu + (size_t)e * D * FF + f;
    float g = 0.f, u = 0.f;
    for (int k = 0; k < D; ++k) { const float av = bf2f(a[k]); g += av * wg[(size_t)k * FF]; u += av * wu[(size_t)k * FF]; }
    HID2[(size_t)m * 512 + slot * 256 + f] = (bf16)f2bf(g / (1.0f + expf(-g)) * u * w);
}
__global__ void __launch_bounds__(256) nk_moe2(const bf16* __restrict__ HID2, const v4u* __restrict__ tokrec, const float* __restrict__ Wd, const float* __restrict__ gvec, float* x) {
    const long gw = ((long)blockIdx.x * blockDim.x + threadIdx.x) >> 6; const int lane = threadIdx.x & 63;
    if (gw >= (long)M * 16) return;
    const int m = (int)(gw / 16), c = (int)(gw % 16) * 64 + lane, b = m / SEQ;
    const v4u rec = tokrec[m]; float y = 0.f;
    for (int slot = 0; slot < 2; ++slot) { const int e = slot ? (rec.x >> 8) & 0xff : rec.x & 0xff;
        const bf16* a = HID2 + (size_t)m * 512 + slot * 256; const float* wd = Wd + (size_t)e * FF * D + c;
        for (int f = 0; f < FF; ++f) y += bf2f(a[f]) * wd[(size_t)f * D]; }
    x[(size_t)m * D + c] += gvec[(size_t)b * 6144 + c] * y;
}
__global__ void __launch_bounds__(256) nk_attnA(int g, const bf16* __restrict__ Q, const bf16* __restrict__ K, const bf16* __restrict__ V, const float* __restrict__ biasv, bf16* ORUN, float* LSE) {
    const long gw = ((long)blockIdx.x * blockDim.x + threadIdx.x) >> 6; const int lane = threadIdx.x & 63;
    if (gw >= (long)M * 16) return;
    const int m = (int)(gw / 16), h = (int)(gw % 16), b = m / SEQ, t = m % SEQ, r = dil_of(g);
    const bf16* q = Q + (size_t)m * D + h * 64;
    float s[3]; bool ok[3];
#pragma unroll
    for (int i = 0; i < 3; ++i) { const int mm = lane + 64 * i; ok[i] = (mm <= 128) && (t - mm * r >= 0); s[i] = -1e30f;
        if (ok[i]) { const bf16* k = K + ((size_t)b * SEQ + (t - mm * r)) * D + h * 64; float d = 0.f;
            for (int dd = 0; dd < 64; ++dd) d += bf2f(q[dd]) * bf2f(k[dd]);
            s[i] = d + biasv[(g * 16 + h) * BV_PITCH + mm]; } }
    const float mx = wave_max(fmaxf(s[0], fmaxf(s[1], s[2])));
    float p[3]; float l = 0.f;
#pragma unroll
    for (int i = 0; i < 3; ++i) { p[i] = ok[i] ? exp2f(s[i] - mx) : 0.f; l += p[i]; }
    l = wave_sum(l);
    float o = 0.f;
#pragma unroll
    for (int i = 0; i < 3; ++i) for (int j = 0; j < 64; ++j) { const int mm = j + 64 * i; const float pj = __shfl(p[i], j);
        if (mm <= 128 && t - mm * r >= 0) o += pj * bf2f(V[((size_t)b * SEQ + (t - mm * r)) * D + h * 64 + lane]); }
    o /= l; float lse = mx * LN2 + logf(l);
    if (g > 0) { const float lr = LSE[(size_t)m * 16 + h], orun = bf2f(ORUN[(size_t)m * D + h * 64 + lane]);
        const float mxl = fmaxf(lr, lse), nl = mxl + logf(expf(lr - mxl) + expf(lse - mxl));
        o = expf(lr - nl) * orun + expf(lse - nl) * o; lse = nl; }
    ORUN[(size_t)m * D + h * 64 + lane] = (bf16)f2bf(o);
    if (lane == 0) LSE[(size_t)m * 16 + h] = lse;
}
__global__ void __launch_bounds__(256) nk_attnB(const bf16* __restrict__ Q, const bf16* __restrict__ K, const bf16* __restrict__ V, const float* __restrict__ CUM, bf16* O) {
    const long gw = ((long)blockIdx.x * blockDim.x + threadIdx.x) >> 6; const int lane = threadIdx.x & 63;
    if (gw >= (long)M * 16) return;
    const int m = (int)(gw / 16), h = (int)(gw % 16), b = m / SEQ, t = m % SEQ;
    const bf16* q = Q + (size_t)m * D + h * 64; const float* cum = CUM + (size_t)(b * 16 + h) * SEQ;
    float qv[64];
#pragma unroll
    for (int dd = 0; dd < 64; ++dd) qv[dd] = bf2f(q[dd]);
    const int nch = t / 64 + 1;
    float mx = -1e30f;
    for (int ch = 0; ch < nch; ++ch) { const int sidx = ch * 64 + lane;
        if (sidx <= t) { const bf16* k = K + ((size_t)b * SEQ + sidx) * D + h * 64; float d = 0.f;
#pragma unroll
            for (int dd = 0; dd < 64; ++dd) d += qv[dd] * bf2f(k[dd]);
            mx = fmaxf(mx, d + cum[sidx]); } }
    mx = wave_max(mx);
    float l = 0.f, o = 0.f;
    for (int ch = 0; ch < nch; ++ch) { const int sidx = ch * 64 + lane; float p = 0.f;
        if (sidx <= t) { const bf16* k = K + ((size_t)b * SEQ + sidx) * D + h * 64; float d = 0.f;
#pragma unroll
            for (int dd = 0; dd < 64; ++dd) d += qv[dd] * bf2f(k[dd]);
            p = exp2f(d + cum[sidx] - mx); }
        l += p;
        const int jn = (t - ch * 64 + 1) < 64 ? (t - ch * 64 + 1) : 64;
        for (int j = 0; j < jn; ++j) o += __shfl(p, j) * bf2f(V[((size_t)b * SEQ + ch * 64 + j) * D + h * 64 + lane]); }
    l = wave_sum(l);
    O[(size_t)m * D + h * 64 + lane] = (bf16)f2bf(o / l);
}

static void launch_mk(const Args& a0, int lo, int hi, int grid, hipStream_t stream, int flags = 0) {
    Args a = a0; a.ph_lo = lo; a.ph_hi = hi; a.flags = flags;
    hipLaunchKernelGGL(mk_fwd, dim3(grid), dim3(NWAVES * 64), LDS_BYTES, stream, a);
}
extern "C" void kernel_launch(void* const* d_in, const int* in_sizes, int n_in, void* d_out, int out_size, void* d_ws, size_t ws_size, hipStream_t stream) {
    static int grid = 0;
    if (grid == 0) {
        if (n_in != 23 || in_sizes[0] != M * D || out_size != M * D || ws_size < WS_END) { fprintf(stderr, "kernel_launch: unexpected shapes (n_in %d, in0 %d, out %d, ws %zu)\n", n_in, n_in > 0 ? in_sizes[0] : -1, out_size, ws_size); grid = -1; return; }
        int dev = 0, cus = 0;
        if (hipGetDevice(&dev) != hipSuccess || hipDeviceGetAttribute(&cus, hipDeviceAttributeMultiprocessorCount, dev) != hipSuccess) { grid = -1; return; }
        if (hipFuncSetAttribute((const void*)mk_fwd, hipFuncAttributeMaxDynamicSharedMemorySize, LDS_BYTES) != hipSuccess) { fprintf(stderr, "kernel_launch: hipFuncSetAttribute failed\n"); grid = -1; return; }
        int per_cu = 0;
        if (hipOccupancyMaxActiveBlocksPerMultiprocessor(&per_cu, (const void*)mk_fwd, NWAVES * 64, LDS_BYTES) != hipSuccess || per_cu < 1) fprintf(stderr, "kernel_launch: occupancy query reports %d\n", per_cu);
        (void)hipGetLastError();
        grid = cus;
    }
    if (grid < 0) return;
    if (hipMemsetAsync((char*)d_ws + WS_CTL, 0, CTL_ZERO_BYTES, stream) != hipSuccess) return;
    Args a{};
    for (int i = 0; i < 23; ++i) a.in[i] = (const float*)d_in[i];
    a.out = (float*)d_out; a.ws = (unsigned char*)d_ws;
#if MK_MODE == 0
    launch_mk(a, 0, NPH, grid, stream);
#else
    unsigned char* ws = (unsigned char*)d_ws;
    const float* const* in = a.in;
    bf16 *HM = (bf16*)(ws + WS_HM), *Qb = (bf16*)(ws + WS_Q), *Kb = (bf16*)(ws + WS_K), *Vb = (bf16*)(ws + WS_V), *OR = (bf16*)(ws + WS_ORUN), *HID2 = (bf16*)(ws + WS_HID2);
    float *MOD = (float*)(ws + WS_MOD), *LSE = (float*)(ws + WS_LSE), *BV = (float*)(ws + WS_BIASV), *CUM = (float*)(ws + WS_CUM);
    const v4u* TR = (const v4u*)(ws + WS_TOKREC);
    float* out = (float*)d_out;
    for (int ph = 0; ph < NPH; ++ph) {
        if (!((NAIVE_MASK >> ph) & 1u)) {
            const bool dup = (HOST_DUP_MASK >> ph) & 1u, moe2 = (ph == PH_MOE2_0 || ph == PH_MOE2_1), rowf = (ph == PH_ROW_F0 || ph == PH_ROW_F1);
            if (dup) launch_mk(a, ph, ph + 1, grid, stream, HOST_DUP_FLAGS >= 0 ? HOST_DUP_FLAGS : (moe2 ? 1 : (rowf ? 2 : 0)));
            launch_mk(a, ph, ph + 1, grid, stream, (dup && moe2 && HOST_DUP_FLAGS < 0) ? 1 : 0); continue; }
        switch (ph) {
            case PH_QKV_A0: case PH_QKV_A1: case PH_QKV_A2: { const int g = (ph - PH_QKV_A0) / 2;
                hipLaunchKernelGGL(nk_qkv, dim3(M * 48 / 4), dim3(256), 0, stream, HM, in[I_AWIN], 9216, g * 3072, in[I_AQN], in[I_AKN], Qb, Kb, Vb); break; }
            case PH_ATT_A0: case PH_ATT_A1: case PH_ATT_A2: { const int g = (ph - PH_ATT_A0) / 2;
                hipLaunchKernelGGL(nk_attnA, dim3(M * 16 / 4), dim3(256), 0, stream, g, Qb, Kb, Vb, BV, OR, LSE); break; }
            case PH_OUT_A: hipLaunchKernelGGL(nk_out, dim3(M * 16 / 4), dim3(256), 0, stream, OR, in[I_AWOUT], in[I_X], MOD + 2 * D, out); break;
            case PH_MOE1_0: hipLaunchKernelGGL(nk_moe1, dim3(M * 8 / 4), dim3(256), 0, stream, HM, TR, in[I_WG], in[I_WU], HID2); break;
            case PH_MOE2_0: hipLaunchKernelGGL(nk_moe2, dim3(M * 16 / 4), dim3(256), 0, stream, HID2, TR, in[I_WD], MOD + 5 * D, out); break;
            case PH_QKV_B: hipLaunchKernelGGL(nk_qkv, dim3(M * 48 / 4), dim3(256), 0, stream, HM, in[I_BWIN], 3088, 0, in[I_BQN], in[I_BKN], Qb, Kb, Vb); break;
            case PH_ATT_B: hipLaunchKernelGGL(nk_attnB, dim3(M * 16 / 4), dim3(256), 0, stream, Qb, Kb, Vb, CUM, OR); break;
            case PH_OUT_B: hipLaunchKernelGGL(nk_out, dim3(M * 16 / 4), dim3(256), 0, stream, OR, in[I_BWOUT], out, MOD + 4 * 6144 + 2 * D, out); break;
            case PH_MOE1_1: hipLaunchKernelGGL(nk_moe1, dim3(M * 8 / 4), dim3(256), 0, stream, HM, TR, in[I_WG] + (size_t)NE * D * FF, in[I_WU] + (size_t)NE * D * FF, HID2); break;
            case PH_MOE2_1: hipLaunchKernelGGL(nk_moe2, dim3(M * 16 / 4), dim3(256), 0, stream, HID2, TR, in[I_WD] + (size_t)NE * FF * D, MOD + 4 * 6144 + 5 * D, out); break;
            default: launch_mk(a, ph, ph + 1, grid, stream); break;
        }
    }
#endif
}
```

```cpp
#include <hip/hip_runtime.h>
#include <hip/hip_bf16.h>
#include <cstdio>
#include <cstdint>
#include <cmath>

#ifndef MK_MODE
#define MK_MODE 0
#endif
#ifndef DUP_MASK
#define DUP_MASK 0u
#endif
#ifndef HOST_DUP_MASK
#define HOST_DUP_MASK 0u
#endif
#ifndef HOST_DUP_FLAGS
#define HOST_DUP_FLAGS -1
#endif
#ifndef NAIVE_MASK
#define NAIVE_MASK 0u
#endif

constexpr int BATCH = 4, SEQ = 4096, D = 1024, H = 16, HD = 64, M = BATCH * SEQ;
constexpr int NE = 16, FF = 256, NCOMBO = 24;
constexpr float EPS = 1e-6f, LOG2E = 1.4426950408889634f, LN2 = 0.6931471805599453f;
constexpr float C2 = 0.125f * LOG2E;
constexpr int BV_PITCH = 132;
constexpr int NPH = 20;
enum Phase { PH_PRO = 0, PH_ROW_A = 1, PH_QKV_A0 = 2, PH_ATT_A0 = 3, PH_QKV_A1 = 4, PH_ATT_A1 = 5, PH_QKV_A2 = 6, PH_ATT_A2 = 7, PH_OUT_A = 8, PH_ROW_F0 = 9, PH_MOE1_0 = 10, PH_MOE2_0 = 11,
             PH_ROW_B = 12, PH_CUM = 13, PH_QKV_B = 14, PH_ATT_B = 15, PH_OUT_B = 16, PH_ROW_F1 = 17, PH_MOE1_1 = 18, PH_MOE2_1 = 19 };

constexpr size_t MiB = 1u << 20;
constexpr size_t WS_CTL = 0, CTL_ZERO_BYTES = 1 * MiB;
constexpr size_t WS_MOD = 1 * MiB;
constexpr size_t WS_BIASV = 1 * MiB + 256 * 1024;
constexpr size_t WS_TOKREC = 1 * MiB + 512 * 1024;
constexpr size_t WS_CUM = 2 * MiB;
constexpr size_t WS_LOGF = 3 * MiB;
constexpr size_t WS_LSE = 4 * MiB;
constexpr size_t WS_MODP = 4 * MiB;
constexpr size_t WS_ELIST = 5 * MiB;
constexpr size_t WS_CLIST = 6 * MiB;
constexpr size_t WS_WAIN = 8 * MiB;
constexpr size_t WS_WAOUT = 26 * MiB;
constexpr size_t WS_WBIN = 28 * MiB;
constexpr size_t WS_WBOUT = 34 * MiB;
constexpr size_t WS_MOE1 = 36 * MiB;
constexpr size_t WS_MOE2 = 68 * MiB;
constexpr size_t WS_HM = 84 * MiB;
constexpr size_t WS_Q = 116 * MiB, WS_K = 148 * MiB, WS_V = 180 * MiB;
constexpr size_t WS_ORUN = 212 * MiB;
constexpr size_t WS_HID2 = 116 * MiB;
constexpr size_t WS_END = 244 * MiB;
constexpr int CW_TMO = 0, CW_CODE = 1, CW_BAR = 4096, CW_CNT = 16384;

constexpr int RING_OFF = 0, RING_BYTES = 131072;
constexpr int LDSCTL_OFF = RING_BYTES, MISC_OFF = LDSCTL_OFF + 320;
constexpr int LDS_BYTES = 163840;
constexpr int GTAB_OFF = LDSCTL_OFF + 8192;

#define GAS __attribute__((address_space(1)))
#define LAS __attribute__((address_space(3)))
typedef unsigned short bf16;
typedef unsigned v4u __attribute__((ext_vector_type(4)));
typedef unsigned v2u __attribute__((ext_vector_type(2)));
typedef float f32x4 __attribute__((ext_vector_type(4)));
typedef short bf16x8 __attribute__((ext_vector_type(8)));
typedef GAS unsigned gu32;
#define RLX_AGENT __ATOMIC_RELAXED, __HIP_MEMORY_SCOPE_AGENT
#define LDS_WAIT() asm volatile("s_waitcnt lgkmcnt(0)" ::: "memory")
#define VM_WAIT() asm volatile("s_waitcnt vmcnt(0)" ::: "memory")
__device__ __forceinline__ unsigned f2bf(float f) { unsigned u = __builtin_bit_cast(unsigned, f); return (u + 0x7fffu + ((u >> 16) & 1u)) >> 16; }
__device__ __forceinline__ unsigned pk2(float lo, float hi) { return f2bf(lo) | (f2bf(hi) << 16); }
__device__ __forceinline__ float bf2f(unsigned u) { return __uint_as_float(u << 16); }
__device__ __forceinline__ float wave_sum(float v) {
#pragma unroll
    for (int o = 1; o < 64; o <<= 1) v += __shfl_xor(v, o);
    return v;
}
__device__ __forceinline__ float wave_max(float v) {
#pragma unroll
    for (int o = 1; o < 64; o <<= 1) v = fmaxf(v, __shfl_xor(v, o));
    return v;
}
__host__ __device__ __forceinline__ int dil_of(int g) { return g == 0 ? 1 : (g == 1 ? 4 : 16); }

#define XB_TMO      128
#define XB_XCNT(j)  (256  + 64 * (j))
#define XB_XSUB(j)  (1280 + 64 * (j))
#define XB_XGEN(j)  (2304 + 64 * (j))
#define XB_TOP      3328
#define XB_TOPGEN   3392
#define XCD_BAR_WORDS 3456
#define XB_SPIN_CAP (1u << 18)
__device__ __forceinline__ unsigned xb_ld(unsigned* p)              { return __hip_atomic_load(p, __ATOMIC_RELAXED, __HIP_MEMORY_SCOPE_AGENT); }
__device__ __forceinline__ unsigned xb_add(unsigned* p, unsigned v) { return __hip_atomic_fetch_add(p, v, __ATOMIC_RELAXED, __HIP_MEMORY_SCOPE_AGENT); }
__device__ __forceinline__ unsigned xb_xcc_id() { return (unsigned)__builtin_amdgcn_s_getreg((3 << 11) | 20) & 0xFu; }
#define XB_SPIN(cond, bar) do { unsigned _sp = 0; while (cond) { __builtin_amdgcn_s_sleep(1); \
    if ((++_sp & 255u) == 0u) { if (xb_ld(&(bar)[XB_TMO])) break; if (_sp > XB_SPIN_CAP) { atomicAdd(&(bar)[XB_TMO], 1u); break; } } } } while (0)
struct XcdBarrier { unsigned* bar; unsigned x; volatile LAS unsigned* st; };
__device__ __forceinline__ XcdBarrier xcd_barrier_post(unsigned* bar, volatile LAS unsigned* st) {
    XcdBarrier b; b.bar = bar; b.x = xb_xcc_id(); b.st = st;
    if (threadIdx.x == 0) (void)xb_add(&bar[XB_XCNT(b.x)], 1u);
    return b;
}
__device__ __forceinline__ void xcd_barrier_complete(unsigned* bar, unsigned x, unsigned& nloc, unsigned& nx) {
    const unsigned G = gridDim.x * gridDim.y * gridDim.z;
    unsigned sum, cnt, mine, sp = 0u;
    for (;;) {
        sum = 0u; cnt = 0u; mine = 0u;
#pragma unroll
        for (unsigned j = 0; j < 16; ++j) { const unsigned c = xb_ld(&bar[XB_XCNT(j)]); sum += c; cnt += (c > 0u) ? 1u : 0u; mine = (j == x) ? c : mine; }
        if (sum == G) break;
        __builtin_amdgcn_s_sleep(1);
        if ((++sp & 255u) == 0u) { if (xb_ld(&bar[XB_TMO])) break; if (sp > XB_SPIN_CAP) { atomicAdd(&bar[XB_TMO], 1u); break; } }
    }
    nloc = mine > 0u ? mine : 1u; nx = cnt > 0u ? cnt : 1u;
}
__device__ __forceinline__ void xcd_barrier(const XcdBarrier& b) {
    asm volatile("s_waitcnt vmcnt(0)" ::: "memory");
    __syncthreads();
    if (threadIdx.x == 0) {
        unsigned* bar = b.bar;
        __builtin_amdgcn_s_waitcnt(0);
        unsigned nloc = b.st[0], nx = b.st[1];
        if (nloc == 0u) { xcd_barrier_complete(bar, b.x, nloc, nx); b.st[0] = nloc; b.st[1] = nx; }
        const unsigned old = xb_add(&bar[XB_XSUB(b.x)], 1u);
        const unsigned gen = old / nloc;
        if (old + 1u == (gen + 1u) * nloc) {
            __builtin_amdgcn_fence(__ATOMIC_RELEASE, "agent");
            asm volatile("s_waitcnt vmcnt(0)" ::: "memory");
            const unsigned og = xb_add(&bar[XB_TOP], 1u);
            const unsigned tg = og / nx;
            if (og + 1u == (tg + 1u) * nx) xb_add(&bar[XB_TOPGEN], 1u);
            else XB_SPIN(xb_ld(&bar[XB_TOPGEN]) == tg, bar);
            __builtin_amdgcn_fence(__ATOMIC_ACQUIRE, "agent");
            xb_add(&bar[XB_XGEN(b.x)], 1u);
            asm volatile("s_waitcnt vmcnt(0)" ::: "memory");
        } else {
            XB_SPIN(xb_ld(&bar[XB_XGEN(b.x)]) == gen, bar);
            __builtin_amdgcn_fence(__ATOMIC_ACQUIRE, "agent");
            asm volatile("s_waitcnt vmcnt(0)" ::: "memory");
        }
    }
    __syncthreads();
}

constexpr int NWAVES = 8;
struct Args { const float* in[23]; float* out; unsigned char* ws; int ph_lo, ph_hi, flags, pad; };
__device__ __forceinline__ bool frame_refresh(struct Frame& F);
struct Frame {
    LAS unsigned char* lds;
    volatile LAS unsigned* MISC;
    gu32* ctl;
    int tid, lane, wave, vcu, G;
    unsigned char* ws;
    const float* const* in;
    float* out;
    int flags;
};
__device__ __forceinline__ bool frame_refresh(Frame& F) { int t = threadIdx.x; asm volatile("" : "+v"(t)); F.tid = t; F.lane = t & 63; F.wave = __builtin_amdgcn_readfirstlane(t >> 6); return true; }
enum In { I_X = 0, I_C, I_WADA, I_BADA, I_NMIX, I_NFFN, I_RELB, I_AWIN, I_AWOUT, I_AQN, I_AKN, I_BWIN, I_BFB, I_BWOUT, I_BQN, I_BKN, I_RGW, I_RGB, I_REW, I_REB, I_WG, I_WU, I_WD };

__device__ __forceinline__ void pro_mod_wave_item(Frame& F, int item, LAS float* scr) {
    const int kq = item & 7, cc = (item >> 3) % 96, layer = item / 768, col = cc * 64 + F.lane, k0 = kq * 128;
    const float* c = F.in[I_C];
#pragma unroll
    for (int q = 0; q < 8; ++q) { const int i = F.lane + 64 * q, bq = i >> 7, kk = i & 127; const float v = c[bq * D + k0 + kk]; scr[i] = v / (1.f + __expf(-v)); }
    LDS_WAIT(); asm volatile("" ::: "memory");
    const float* W = F.in[I_WADA] + (size_t)layer * D * 6144 + (size_t)k0 * 6144 + col;
    float a0 = 0.f, a1 = 0.f, a2 = 0.f, a3 = 0.f;
#pragma unroll 1
    for (int kb = 0; kb < 128; kb += 32) { float w[32];
#pragma unroll
        for (int i = 0; i < 32; ++i) w[i] = W[(size_t)(kb + i) * 6144];
#pragma unroll
        for (int i = 0; i < 32; ++i) { a0 += scr[kb + i] * w[i]; a1 += scr[128 + kb + i] * w[i]; a2 += scr[256 + kb + i] * w[i]; a3 += scr[384 + kb + i] * w[i]; } }
    if (kq == 0) { const float bb = F.in[I_BADA][layer * 6144 + col]; a0 += bb; a1 += bb; a2 += bb; a3 += bb; }
    float* P = (float*)(F.ws + WS_MODP) + (size_t)(layer * 8 + kq) * 4 * 6144 + col;
    P[0] = a0; P[6144] = a1; P[2 * 6144] = a2; P[3 * 6144] = a3;
    LDS_WAIT(); asm volatile("" ::: "memory");
}
__device__ __forceinline__ void pro_biasv(Frame& F) {
    float* BV = (float*)(F.ws + WS_BIASV);
    for (int i = F.tid; i < 48 * 129; i += NWAVES * 64) {
        const int gh = i / 129, dist = i % 129, g = gh / 16, d = dist * dil_of(g);
        int bucket;
        if (d < 16) bucket = d;
        else { const float v = logf((float)d / 16.0f) / 4.852030263919617f * 16.0f; bucket = 16 + (int)v; if (bucket > 31) bucket = 31; }
        BV[gh * BV_PITCH + dist] = F.in[I_RELB][bucket * 48 + gh] * LOG2E;
    }
}
__device__ __forceinline__ int rowmap(int mode, int n) {
    if (mode == 0) return n;
    if (mode == 1) return (n & ~255) + 128 * ((n >> 5) & 1) + 32 * ((n >> 6) & 3) + (n & 31);
    return 256 * (n >> 7) + (n & 127) + (mode == 3 ? 128 : 0);
}
__device__ __forceinline__ void transpose_item(const float* W, int ldw, bf16* WT, int ldt, int k0, int n0, int mode, LAS float* scr, int lane) {
    float tv[32];
#pragma unroll
    for (int i = 0; i < 32; ++i) { const int kk = 2 * i + (lane >> 5); tv[i] = W[(size_t)(k0 + kk) * ldw + n0 + (lane & 31)]; }
#pragma unroll
    for (int i = 0; i < 32; ++i) { const int kk = 2 * i + (lane >> 5); scr[kk * 33 + (lane & 31)] = tv[i]; }
    LDS_WAIT(); asm volatile("" ::: "memory");
    const int c = lane & 7;
#pragma unroll
    for (int j = 0; j < 4; ++j) { const int n = (lane >> 3) + 8 * j; const LAS float* s = scr + (8 * c) * 33 + n;
        v4u o; o.x = pk2(s[0 * 33], s[1 * 33]); o.y = pk2(s[2 * 33], s[3 * 33]); o.z = pk2(s[4 * 33], s[5 * 33]); o.w = pk2(s[6 * 33], s[7 * 33]);
        *(GAS v4u*)(WT + (size_t)rowmap(mode, n0 + n) * ldt + k0 + 8 * c) = o; }
    LDS_WAIT(); asm volatile("" ::: "memory");
}
constexpr int CV_A = 16 * 288, CV_AO = 16 * 32, CV_B = 16 * 96, CV_BO = 16 * 32, CV_E = 16 * 128;
constexpr int CV_NOW = CV_A + CV_AO + 3 * CV_E, CV_LATER = CV_B + CV_BO + 3 * CV_E;
__device__ __forceinline__ void convert_moe_item(Frame& F, int r, int le0, LAS float* scr) {
    const int fam = r / CV_E, le = le0 + (r % CV_E) / 128, q = r % 128;
    if (fam == 0) transpose_item(F.in[I_WG] + (size_t)le * D * FF, FF, (bf16*)(F.ws + WS_MOE1) + (size_t)le * 512 * D, 1024, 64 * (q / 8), 32 * (q % 8), 2, scr, F.lane);
    else if (fam == 1) transpose_item(F.in[I_WU] + (size_t)le * D * FF, FF, (bf16*)(F.ws + WS_MOE1) + (size_t)le * 512 * D, 1024, 64 * (q / 8), 32 * (q % 8), 3, scr, F.lane);
    else transpose_item(F.in[I_WD] + (size_t)le * FF * D, D, (bf16*)(F.ws + WS_MOE2) + (size_t)le * D * FF, 256, 64 * (q / 32), 32 * (q % 32), 0, scr, F.lane);
}
__device__ __forceinline__ void convert_now(Frame& F, int worker, int nworkers) {
    LAS float* scr = (LAS float*)(F.lds + RING_OFF + F.wave * 16384);
    for (int it = worker; it < CV_NOW; it += nworkers) {
        int r = it;
        if (r < CV_A) { transpose_item(F.in[I_AWIN], 9216, (bf16*)(F.ws + WS_WAIN), 1024, 64 * (r / 288), 32 * (r % 288), 1, scr, F.lane); continue; } r -= CV_A;
        if (r < CV_AO) { transpose_item(F.in[I_AWOUT], 1024, (bf16*)(F.ws + WS_WAOUT), 1024, 64 * (r / 32), 32 * (r % 32), 0, scr, F.lane); continue; } r -= CV_AO;
        convert_moe_item(F, r, 0, scr);
    }
}
__device__ __forceinline__ void convert_later(Frame& F, int worker, int nworkers) {
    LAS float* scr = (LAS float*)(F.lds + RING_OFF + F.wave * 16384);
    for (int it = worker; it < CV_LATER; it += nworkers) {
        int r = it;
        if (r < CV_B) { transpose_item(F.in[I_BWIN], 3088, (bf16*)(F.ws + WS_WBIN), 1024, 64 * (r / 96), 32 * (r % 96), 1, scr, F.lane); continue; } r -= CV_B;
        if (r < CV_BO) { transpose_item(F.in[I_BWOUT], 1024, (bf16*)(F.ws + WS_WBOUT), 1024, 64 * (r / 32), 32 * (r % 32), 0, scr, F.lane); continue; } r -= CV_BO;
        convert_moe_item(F, r, 16, scr);
    }
}
__device__ __forceinline__ void p0_prologue(Frame& F) {
    if (blockIdx.x == F.G - 1) pro_biasv(F);
    const int gw = F.vcu * NWAVES + F.wave, NGW = F.G * NWAVES;
    LAS float* scr = (LAS float*)(F.lds + RING_OFF + F.wave * 16384);
    for (int it = gw; it < 1536; it += NGW) pro_mod_wave_item(F, it, scr);
    convert_now(F, (gw + NGW - (1536 % NGW)) % NGW, NGW);
}

template <int N> __device__ __forceinline__ void reduce_scatter(float (&a)[64], int lane) {
    if constexpr (N >= 1) {
        const bool up = (lane & N) != 0;
#pragma unroll
        for (int i = 0; i < N; ++i) { const float keep = up ? a[i + N] : a[i], send = up ? a[i] : a[i + N]; a[i] = keep + __shfl_xor(send, N); }
        reduce_scatter<N / 2>(a, lane);
    }
}
template <int MODE, bool PART = false> __device__ __forceinline__ void rowpass(Frame& F, const float* xin, const float* gain, int layer, int sh_idx, int sc_idx) {
    constexpr int NW = MODE == 1 ? 16 : (MODE == 2 ? 20 : 0), NWP = MODE == 1 ? 16 : 32, RPG = MODE == 1 ? 4 : 2;
    LAS float* Wl = (LAS float*)(F.lds + RING_OFF);
    LAS int* rowinfo = (LAS int*)(F.lds + RING_OFF + 98304);
    LAS float* wsum = (LAS float*)(F.lds + RING_OFF + 98304 + 1024) + F.wave * 64;
    const float* MOD = (const float*)(F.ws + WS_MOD) + (size_t)layer * 4 * 6144;
    bf16* HM = (bf16*)(F.ws + WS_HM);
    if constexpr (MODE == 1) { const float* W = F.in[I_BWIN] + 3072; f32x4 t[8];
#pragma unroll
        for (int q = 0; q < 8; ++q) { const int i = F.tid + q * 512, c = i >> 2, j4 = i & 3; t[q] = *(const f32x4*)(W + (size_t)c * 3088 + 4 * j4); }
#pragma unroll
        for (int q = 0; q < 8; ++q) { const int i = F.tid + q * 512, c = i >> 2, j4 = i & 3; Wl[(4 * j4 + 0) * D + c] = t[q].x; Wl[(4 * j4 + 1) * D + c] = t[q].y; Wl[(4 * j4 + 2) * D + c] = t[q].z; Wl[(4 * j4 + 3) * D + c] = t[q].w; } }
    if constexpr (MODE == 2) { const float* Wg = F.in[I_RGW] + (size_t)layer * D * 4; const float* We = F.in[I_REW] + (size_t)layer * D * 16; f32x4 t[10];
#pragma unroll
        for (int q = 0; q < 8; ++q) { const int i = F.tid + q * 512; t[q] = *(const f32x4*)(We + 4 * (size_t)i); }
#pragma unroll
        for (int q = 0; q < 2; ++q) { const int i = F.tid + q * 512; t[8 + q] = *(const f32x4*)(Wg + 4 * (size_t)i); }
#pragma unroll
        for (int q = 0; q < 8; ++q) { const int i = F.tid + q * 512, c = i >> 2, j4 = i & 3; Wl[(4 + 4 * j4 + 0) * D + c] = t[q].x; Wl[(4 + 4 * j4 + 1) * D + c] = t[q].y; Wl[(4 + 4 * j4 + 2) * D + c] = t[q].z; Wl[(4 + 4 * j4 + 3) * D + c] = t[q].w; }
#pragma unroll
        for (int q = 0; q < 2; ++q) { const int c = F.tid + q * 512; Wl[0 * D + c] = t[8 + q].x; Wl[1 * D + c] = t[8 + q].y; Wl[2 * D + c] = t[8 + q].z; Wl[3 * D + c] = t[8 + q].w; } }
    __syncthreads();
    for (int rb = blockIdx.x; rb < M / 64; rb += F.G) {
        const int b = (rb * 64) / SEQ;
        f32x4 Gv[4], Sv[4];
#pragma unroll
        for (int j = 0; j < 4; ++j) { const int c = 4 * F.lane + 256 * j;
            const f32x4 gv = *(const f32x4*)(gain + c); f32x4 sc, sh;
            if constexpr (PART) { const float* P = (const float*)(F.ws + WS_MODP) + (size_t)layer * 8 * 4 * 6144 + (size_t)b * 6144 + c; sc = (f32x4){0.f, 0.f, 0.f, 0.f}; sh = sc;
#pragma unroll
                for (int q = 0; q < 8; ++q) { sc += *(const f32x4*)(P + (size_t)q * 4 * 6144 + sc_idx * D); sh += *(const f32x4*)(P + (size_t)q * 4 * 6144 + sh_idx * D); } }
            else { sc = *(const f32x4*)(MOD + (size_t)b * 6144 + sc_idx * D + c); sh = *(const f32x4*)(MOD + (size_t)b * 6144 + sh_idx * D + c); }
            Gv[j] = gv * (sc + 1.0f); Sv[j] = sh; }
        constexpr bool PF = (RPG == 2);
        f32x4 vn[RPG][4];
        if constexpr (PF) {
#pragma unroll
            for (int r = 0; r < RPG; ++r) { const GAS f32x4* xr = (const GAS f32x4*)(xin + (size_t)(rb * 64 + F.wave * 8 + r) * D) + F.lane;
#pragma unroll
                for (int j = 0; j < 4; ++j) vn[r][j] = xr[64 * j]; } }
#pragma unroll 1
        for (int grp = 0; grp < 8 / RPG; ++grp) {
            const int m0 = rb * 64 + F.wave * 8 + grp * RPG;
            f32x4 v[RPG][4];
            if constexpr (PF) {
#pragma unroll
                for (int r = 0; r < RPG; ++r)
#pragma unroll
                    for (int j = 0; j < 4; ++j) v[r][j] = vn[r][j];
                if (grp + 1 < 8 / RPG) {
#pragma unroll
                    for (int r = 0; r < RPG; ++r) { const GAS f32x4* xr = (const GAS f32x4*)(xin + (size_t)(m0 + RPG + r) * D) + F.lane;
#pragma unroll
                        for (int j = 0; j < 4; ++j) vn[r][j] = xr[64 * j]; } }
            } else {
#pragma unroll
                for (int r = 0; r < RPG; ++r) { const GAS f32x4* xr = (const GAS f32x4*)(xin + (size_t)(m0 + r) * D) + F.lane;
#pragma unroll
                    for (int j = 0; j < 4; ++j) v[r][j] = xr[64 * j]; }
            }
#pragma unroll
            for (int r = 0; r < RPG; ++r) { float ss = 0.f;
#pragma unroll
                for (int j = 0; j < 4; ++j) ss += (v[r][j].x * v[r][j].x + v[r][j].y * v[r][j].y) + (v[r][j].z * v[r][j].z + v[r][j].w * v[r][j].w);
                const float rstd = 1.0f / sqrtf(wave_sum(ss) * (1.f / D) + EPS);
                GAS unsigned long long* o8 = (GAS unsigned long long*)(HM + (size_t)(m0 + r) * D) + F.lane;
#pragma unroll
                for (int j = 0; j < 4; ++j) { v[r][j] = v[r][j] * rstd * Gv[j] + Sv[j];
                    o8[64 * j] = (unsigned long long)pk2(v[r][j].x, v[r][j].y) | ((unsigned long long)pk2(v[r][j].z, v[r][j].w) << 32); } }
            if constexpr (NW > 0) {
                float a[64];
#pragma unroll
                for (int i = 0; i < 64; ++i) a[i] = 0.f;
#pragma unroll
                for (int jj = 0; jj < NW; ++jj) {
                    asm volatile("" ::: "memory");
                    typedef float f32x2 __attribute__((ext_vector_type(2)));
                    f32x2 p2[RPG];
#pragma unroll
                    for (int r = 0; r < RPG; ++r) p2[r] = (f32x2){0.f, 0.f};
#pragma unroll
                    for (int j = 0; j < 4; ++j) { const f32x4 w = *(const LAS f32x4*)(Wl + jj * D + 4 * F.lane + 256 * j); const f32x2 wlo = {w.x, w.y}, whi = {w.z, w.w};
#pragma unroll
                        for (int r = 0; r < RPG; ++r) { const f32x2 vlo = {v[r][j].x, v[r][j].y}, vhi = {v[r][j].z, v[r][j].w}; p2[r] = __builtin_elementwise_fma(vlo, wlo, p2[r]); p2[r] = __builtin_elementwise_fma(vhi, whi, p2[r]); } }
#pragma unroll
                    for (int r = 0; r < RPG; ++r) a[r * NWP + jj] = p2[r].x + p2[r].y;
                }
                reduce_scatter<32>(a, F.lane);
                const float tot = a[0];
                if constexpr (MODE == 1) {
                    float* LOGF = (float*)(F.ws + WS_LOGF);
                    const float z = tot + F.in[I_BFB][F.lane & 15];
                    LOGF[(size_t)m0 * 16 + F.lane] = fminf(z, 0.f) - log1pf(expf(-fabsf(z)));
                }
                if constexpr (MODE == 2) {
                    wsum[F.lane] = tot; LDS_WAIT();
                    if (F.lane < RPG) {
                        const float* bg = F.in[I_RGB] + layer * 4; const float* be = F.in[I_REB] + layer * 16;
                        v4u* TOKREC = (v4u*)(F.ws + ((F.flags & 2) ? WS_END : WS_TOKREC));
                        const LAS float* dr = wsum + F.lane * NWP;
                        const float g0 = dr[0] + bg[0], g1 = dr[1] + bg[1], g2 = dr[2] + bg[2], g3 = dr[3] + bg[3];
                        int gi = 0; float gm = g0; if (g1 > gm) { gm = g1; gi = 1; } if (g2 > gm) { gm = g2; gi = 2; } if (g3 > gm) { gm = g3; gi = 3; }
                        const float gw = 1.0f / (expf(g0 - gm) + expf(g1 - gm) + expf(g2 - gm) + expf(g3 - gm));
                        float es[4];
#pragma unroll
                        for (int i = 0; i < 4; ++i) es[i] = dr[4 + gi * 4 + i] + be[gi * 4 + i];
                        int i1 = 0; float v1 = es[0];
#pragma unroll
                        for (int i = 1; i < 4; ++i) if (es[i] > v1) { v1 = es[i]; i1 = i; }
                        int i2 = -1; float v2 = -INFINITY;
#pragma unroll
                        for (int i = 0; i < 4; ++i) if (i != i1 && es[i] > v2) { v2 = es[i]; i2 = i; }
                        const float ex = expf(v2 - v1), w1 = gw / (1.0f + ex), w2 = gw * ex / (1.0f + ex);
                        const int aa = i1 < i2 ? i1 : i2, bb = i1 < i2 ? i2 : i1;
                        const float wlo = i1 < i2 ? w1 : w2, whi = i1 < i2 ? w2 : w1;
                        const int pidx = aa == 0 ? bb - 1 : (aa == 1 ? bb + 1 : 5);
                        const int lo = gi * 4 + aa, hi = gi * 4 + bb, combo = gi * 6 + pidx;
                        v4u rec; rec.x = (unsigned)(lo | (hi << 8) | (combo << 16)); rec.y = __float_as_uint(wlo); rec.z = __float_as_uint(whi); rec.w = 0u;
                        TOKREC[m0 + F.lane] = rec; rowinfo[F.wave * 8 + grp * RPG + F.lane] = lo | (hi << 8) | (combo << 16);
                    }
                    LDS_WAIT();
                }
            }
        }
        if (MODE == 2) {
            __syncthreads();
            if (F.tid < 40) {
                const int t = F.tid; int n = 0;
#pragma unroll 8
                for (int r = 0; r < 64; ++r) { const int ri = rowinfo[r]; const bool mem = t < 16 ? ((ri & 0xff) == t || ((ri >> 8) & 0xff) == t) : ((ri >> 16) == t - 16); n += mem ? 1 : 0; }
                gu32* cnt = F.ctl + CW_CNT + (((F.flags & 2) ? 2 : layer) * 40 + t) * 64;
                const int base = (int)__hip_atomic_fetch_add(cnt, (unsigned)n, RLX_AGENT);
                int* list = (int*)(F.ws + ((F.flags & 2) ? WS_END + MiB : (t < 16 ? WS_ELIST : WS_CLIST))) + (t < 16 ? t : ((F.flags & 2) ? t : t - 16)) * M;
                int kk = 0;
                for (int r = 0; r < 64; ++r) { const int ri = rowinfo[r]; const bool mem = t < 16 ? ((ri & 0xff) == t || ((ri >> 8) & 0xff) == t) : ((ri >> 16) == t - 16);
                    if (mem) { list[base + kk] = rb * 64 + r; ++kk; } }
            }
            __syncthreads();
        }
    }
}

__device__ __forceinline__ void cumsum_phase(Frame& F) {
    LAS float* wt = (LAS float*)(F.lds + RING_OFF);
    for (int bh = blockIdx.x; bh < BATCH * H; bh += F.G) {
        const int b = bh / H, h = bh % H;
        const float* LOGF = (const float*)(F.ws + WS_LOGF) + (size_t)b * SEQ * 16 + h;
        float v[8]; float run = 0.f;
#pragma unroll
        for (int i = 0; i < 8; ++i) { run += LOGF[(size_t)(F.tid * 8 + i) * 16]; v[i] = run; }
        float inc = run;
#pragma unroll
        for (int o = 1; o < 64; o <<= 1) { const float n = __shfl_up(inc, o); if (F.lane >= o) inc += n; }
        if (F.lane == 63) wt[F.wave] = inc;
        __syncthreads();
        float base = inc - run;
        for (int w = 0; w < F.wave; ++w) base += wt[w];
        float* CUM = (float*)(F.ws + WS_CUM) + (size_t)bh * SEQ + F.tid * 8;
#pragma unroll
        for (int i = 0; i < 8; ++i) CUM[i] = -(base + v[i]) * LOG2E;
        __syncthreads();
    }
}

namespace pg8 {
typedef unsigned short bf16_t;
typedef unsigned u32x4 __attribute__((ext_vector_type(4)));
constexpr int BM = 256, BK = 64, HALF = 128, HTB = HALF * BK * 2, STAGE_BYTES = 8 * HTB, NXCD = 8, WGM = 8;
__host__ __device__ __forceinline__ int lds_byte(int r, int c) { const int st = (r >> 4) * 2 + (c >> 5), rr = r & 15, cc = c & 31, ob = rr * 64 + cc * 2; return st * 1024 + (ob ^ (((ob >> 9) & 1) << 5)); }
__host__ __device__ __forceinline__ void stage_rc(int b, int& R, int& C) { const int st = b / 1024, sb = b % 1024, swz = sb ^ (((sb >> 9) & 1) << 5); R = (st >> 1) * 16 + swz / 64; C = (st & 1) * 32 + (swz % 64) / 2; }
__host__ __device__ __forceinline__ int perm32(int rho) { const int n = rho >> 4, i = rho & 15; return 8 * (i >> 2) + 4 * n + (i & 3); }
struct Unit { int pm, pn, e, cnt; };
__device__ __forceinline__ unsigned cvt_pk_bf16(float lo, float hi) { unsigned r; asm volatile("v_cvt_pk_bf16_f32 %0, %1, %2" : "=v"(r) : "v"(lo), "v"(hi)); return r; }

struct StaticOrder {
    int nM, nN, nwg, G, c; const char* A; const char* Bt; size_t tstepA, tstepB; int ks;
    __device__ void init(int M_, int N_, int G_, int c_, const void* A_, int lda, const void* Bt_, int ldb, int nt) { nM = M_ / BM; nN = N_ / BM; nwg = nM * nN; G = G_; c = c_; A = (const char*)A_; Bt = (const char*)Bt_; tstepA = (size_t)BM * lda * 2; tstepB = (size_t)BM * ldb * 2; ks = nt; }
    __device__ bool next(int i, Unit& u) const {
        const long L = (long)i * G + c; if (L >= nwg) return false;
        int wgid = (int)L; { const int q = nwg / NXCD, r = nwg % NXCD, xcd = wgid % NXCD, off = wgid / NXCD; wgid = (xcd < r ? xcd * (q + 1) : r * (q + 1) + (xcd - r) * q) + off; }
        const int nig = WGM * nN, gid = wgid / nig, fm = gid * WGM, gsz = (nM - fm) < WGM ? (nM - fm) : WGM;
        u.pm = fm + ((wgid % nig) % gsz); u.pn = (wgid % nig) / gsz; u.e = 0; u.cnt = 0; return true;
    }
    __device__ __forceinline__ const char* a_base(const Unit& u) const { return A + (size_t)u.pm * tstepA; }
    __device__ __forceinline__ const char* b_lo(const Unit& u) const { return Bt + (size_t)u.pn * tstepB; }
    __device__ __forceinline__ const char* b_hi(const Unit& u) const { return Bt + (size_t)u.pn * tstepB; }
    __device__ __forceinline__ int row(const Unit&, int) const { return 0; }
};
struct MoeOrder {
    int G, c, nl, ntn, ks, mode; const char* A; const char* B; const int* lists; const LAS int* tab;
    __device__ bool next(int i, Unit& u) const {
        const int L = i * G + c, total = __builtin_amdgcn_readfirstlane(tab[nl]) * ntn; if (L >= total) return false;
        const int rt = L / ntn; int e = 0;
        for (int k = 1; k < nl; ++k) e = (tab[k] <= rt) ? k : e;
        u.e = __builtin_amdgcn_readfirstlane(e); u.pm = __builtin_amdgcn_readfirstlane(rt - tab[e]); u.pn = L % ntn; u.cnt = __builtin_amdgcn_readfirstlane(tab[32 + e]); return true;
    }
    __device__ __forceinline__ const char* a_base(const Unit&) const { return A; }
    __device__ __forceinline__ const char* b_lo(const Unit& u) const {
        if (mode == 1) return B + ((size_t)u.e * 512 + (size_t)u.pn * 256) * 1024 * 2;
        const int g = u.e / 6, p = u.e % 6, a = p < 3 ? 0 : (p < 5 ? 1 : 2);
        return B + ((size_t)(g * 4 + a) * 1024 + (size_t)u.pn * 256) * 256 * 2; }
    __device__ __forceinline__ const char* b_hi(const Unit& u) const {
        if (mode == 1) return b_lo(u);
        const int g = u.e / 6, p = u.e % 6, b = p < 3 ? p + 1 : (p < 5 ? p - 1 : 3);
        return B + ((size_t)(g * 4 + b) * 1024 + (size_t)u.pn * 256) * 256 * 2; }
    __device__ __forceinline__ int row(const Unit& u, int r) const { int idx = u.pm * 256 + r; idx = idx < u.cnt ? idx : u.cnt - 1; return lists[(size_t)u.e * 16384 + idx]; }
};

struct EpiQKV {
    static constexpr bool PERM = true;
    bf16_t* Qo; const float* qg; const float* kg;
    __device__ __forceinline__ void operator()(const f32x4 (&acc)[2][2][4][2], const Unit& u, int wr, int wc, int fr, int fq) const {
        const int t = u.pn >> 2, hcol = (u.pn & 3) * 256 + wc * 64;
        bf16_t* base = Qo + (size_t)t * ((WS_K - WS_Q) / 2) + hcol + 8 * fq;
        f32x4 gv[2][2];
        const float* gp = qg + (t == 1 ? (kg - qg) : 0) + 8 * fq;
#pragma unroll
        for (int bj = 0; bj < 2; ++bj)
#pragma unroll
            for (int n = 0; n < 2; ++n) gv[bj][n] = (t < 2) ? *(const f32x4*)(gp + 32 * bj + 4 * n) : (f32x4){1.f, 1.f, 1.f, 1.f};
        const float sc = (t == 0) ? C2 : 1.0f;
#pragma unroll
        for (int ai = 0; ai < 2; ++ai)
#pragma unroll
            for (int m = 0; m < 4; ++m) {
                float rs = sc;
                if (t < 2) { float ss = 0.f;
#pragma unroll
                    for (int bj = 0; bj < 2; ++bj)
#pragma unroll
                        for (int n = 0; n < 2; ++n) { const f32x4 x = acc[ai][bj][m][n]; ss += (x[0] * x[0] + x[1] * x[1]) + (x[2] * x[2] + x[3] * x[3]); }
                    ss += __shfl_xor(ss, 16); ss += __shfl_xor(ss, 32);
                    rs = sc / sqrtf(ss * (1.0f / 64.0f) + EPS); }
                bf16_t* rowp = base + (size_t)(u.pm * BM + ai * HALF + wr * 64 + m * 16 + fr) * 1024;
#pragma unroll
                for (int bj = 0; bj < 2; ++bj) { const f32x4 v0 = acc[ai][bj][m][0] * rs * gv[bj][0], v1 = acc[ai][bj][m][1] * rs * gv[bj][1];
                    u32x4 w; w.x = cvt_pk_bf16(v0[0], v0[1]); w.y = cvt_pk_bf16(v0[2], v0[3]); w.z = cvt_pk_bf16(v1[0], v1[1]); w.w = cvt_pk_bf16(v1[2], v1[3]);
                    *(u32x4*)(rowp + 32 * bj) = w; } }
    }
};
struct EpiOut {
    static constexpr bool PERM = false;
    const float* xin; float* xout; const float* gvec;
    __device__ __forceinline__ void operator()(const f32x4 (&acc)[2][2][4][2], const Unit& u, int wr, int wc, int fr, int fq) const {
        const int col0 = u.pn * BM + wc * 32 + 4 * fq, b = (u.pm * BM) / SEQ;
        f32x4 g[2][2];
#pragma unroll
        for (int bj = 0; bj < 2; ++bj)
#pragma unroll
            for (int n = 0; n < 2; ++n) g[bj][n] = *(const f32x4*)(gvec + (size_t)b * 6144 + col0 + bj * HALF + n * 16);
#pragma unroll
        for (int ai = 0; ai < 2; ++ai)
#pragma unroll
            for (int m = 0; m < 4; ++m) { const size_t off = (size_t)(u.pm * BM + ai * HALF + wr * 64 + m * 16 + fr) * D + col0;
#pragma unroll
                for (int bj = 0; bj < 2; ++bj)
#pragma unroll
                    for (int n = 0; n < 2; ++n) { const f32x4 xi = *(const f32x4*)(xin + off + bj * HALF + n * 16); *(f32x4*)(xout + off + bj * HALF + n * 16) = xi + g[bj][n] * acc[ai][bj][m][n]; }
                if (m == 3) asm volatile("" ::: "memory"); }
    }
};
struct EpiMoe1 {
    static constexpr bool PERM = true;
    const int* lists; const v4u* tokrec; bf16_t* HID2; int skip;
    __device__ __forceinline__ void operator()(const f32x4 (&acc)[2][2][4][2], const Unit& u, int wr, int wc, int fr, int fq) const {
        if (skip) return;
        const int f = u.pn * 128 + wc * 32 + 8 * fq;
        int tok[2][4]; v4u rec[2][4];
#pragma unroll
        for (int ai = 0; ai < 2; ++ai)
#pragma unroll
            for (int m = 0; m < 4; ++m) { int idx = u.pm * BM + ai * HALF + wr * 64 + m * 16 + fr; idx = idx < u.cnt ? idx : u.cnt - 1; tok[ai][m] = lists[(size_t)u.e * 16384 + idx]; }
#pragma unroll
        for (int ai = 0; ai < 2; ++ai)
#pragma unroll
            for (int m = 0; m < 4; ++m) rec[ai][m] = tokrec[tok[ai][m]];
#pragma unroll
        for (int ai = 0; ai < 2; ++ai)
#pragma unroll
            for (int m = 0; m < 4; ++m) { const int idx = u.pm * BM + ai * HALF + wr * 64 + m * 16 + fr;
                const int slot = ((int)(rec[ai][m].x & 0xffu) == u.e) ? 0 : 1; const float w = __uint_as_float(slot ? rec[ai][m].z : rec[ai][m].y);
                float h[8];
#pragma unroll
                for (int n = 0; n < 2; ++n)
#pragma unroll
                    for (int j = 0; j < 4; ++j) { const float g = acc[ai][0][m][n][j], up = acc[ai][1][m][n][j]; h[n * 4 + j] = g * __builtin_amdgcn_rcpf(1.0f + __expf(-g)) * up * w; }
                u32x4 o; o.x = cvt_pk_bf16(h[0], h[1]); o.y = cvt_pk_bf16(h[2], h[3]); o.z = cvt_pk_bf16(h[4], h[5]); o.w = cvt_pk_bf16(h[6], h[7]);
                if (idx < u.cnt) *(u32x4*)(HID2 + (size_t)tok[ai][m] * 512 + slot * 256 + f) = o; }
    }
};
struct EpiMoe2 {
    static constexpr bool PERM = false;
    const int* lists; float* x; const LAS float* gtab; int skip;
    __device__ __forceinline__ void operator()(const f32x4 (&acc)[2][2][4][2], const Unit& u, int wr, int wc, int fr, int fq) const {
        if (skip) return;
        const int col0 = u.pn * BM + wc * 32 + 4 * fq;
        int tok[2][4];
#pragma unroll
        for (int ai = 0; ai < 2; ++ai)
#pragma unroll
            for (int m = 0; m < 4; ++m) { int idx = u.pm * BM + ai * HALF + wr * 64 + m * 16 + fr; idx = idx < u.cnt ? idx : u.cnt - 1; tok[ai][m] = lists[(size_t)u.e * 16384 + idx]; }
#pragma unroll
        for (int ai = 0; ai < 2; ++ai) {
            f32x4 xi[4][2][2];
#pragma unroll
            for (int m = 0; m < 4; ++m) { const float* xp = x + (size_t)tok[ai][m] * D + col0;
#pragma unroll
                for (int bj = 0; bj < 2; ++bj)
#pragma unroll
                    for (int n = 0; n < 2; ++n) xi[m][bj][n] = *(const f32x4*)(xp + bj * HALF + n * 16); }
#pragma unroll
            for (int m = 0; m < 4; ++m) { const int idx = u.pm * BM + ai * HALF + wr * 64 + m * 16 + fr; const int t = tok[ai][m];
                const LAS float* gp = gtab + (t / SEQ) * D + col0; float* xp = x + (size_t)t * D + col0;
#pragma unroll
                for (int bj = 0; bj < 2; ++bj)
#pragma unroll
                    for (int n = 0; n < 2; ++n) { const f32x4 g = *(const LAS f32x4*)(gp + bj * HALF + n * 16); const f32x4 o = xi[m][bj][n] + g * acc[ai][bj][m][n];
                        if (idx < u.cnt) *(f32x4*)(xp + bj * HALF + n * 16) = o; } }
            asm volatile("" ::: "memory"); }
    }
};

template <class Epi, class Sched, bool GATHER, bool ALIGN_EPI>
__device__ __forceinline__ void gemm_phase(LAS unsigned char* lds, const int lda, const int ldb, const int K, const Sched& S, const Epi& E) {
    int tid_ = threadIdx.x; asm volatile("" : "+v"(tid_));
    const int tid = tid_, wid = __builtin_amdgcn_readfirstlane(tid >> 6), lane = tid & 63, wr = wid >> 2, wc = wid & 3, fr = lane & 15, fq = lane >> 4;
    const int nt = K / BK, ks = S.ks;
    unsigned voffA[2][2], voffB[2], nvA[2][2];
#pragma unroll
    for (int i = 0; i < 2; ++i) { int R, C; stage_rc(tid * 16 + i * 8192, R, C); const int Rb = Epi::PERM ? ((R & ~31) + perm32(R & 31)) : R;
        voffB[i] = (unsigned)(Rb * ldb + C) * 2u; voffA[0][i] = (unsigned)(R * lda + C) * 2u; voffA[1][i] = 0u; nvA[0][i] = 0u; nvA[1][i] = 0u; }
    const size_t kstep = (size_t)(BK * 2);
    const size_t hstepA = GATHER ? (size_t)0 : (size_t)HALF * lda * 2, hstepB = (size_t)HALF * ldb * 2;
    const unsigned ldsw = (unsigned)wid * 1024u;
    const int aoff = lds_byte(wr * 64 + fr, fq * 8), boff = lds_byte(wc * 32 + fr, fq * 8);
#define PG8_SA(b, h) (((b) * 2 + (h)) * HTB)
#define PG8_SB(b, h) ((4 + (b) * 2 + (h)) * HTB)
#define PG8_STAGE(bufoff, gbase, voff) do { _Pragma("unroll") for (int _i = 0; _i < 2; ++_i) \
        __builtin_amdgcn_global_load_lds((const unsigned*)((const char*)(gbase) + (voff)[_i]), (LAS unsigned*)(lds + (bufoff) + ldsw + _i * 8192), 16, 0, 0); } while (0)
#define PG8_STAGE_A(bufoff, gbase, h) do { if constexpr (GATHER) { PG8_STAGE(bufoff, gbase, voffA[h]); } else { PG8_STAGE(bufoff, (gbase) + (h) * hstepA, voffA[0]); } } while (0)
#define PG8_STAGE_B(bufoff, gbase, h) PG8_STAGE(bufoff, (gbase) + (h) * hstepB, voffB)
#define PG8_GATHER_OFFS(dst, u) do { _Pragma("unroll") for (int _h = 0; _h < 2; ++_h) _Pragma("unroll") for (int _i = 0; _i < 2; ++_i) { int _R, _C; stage_rc(tid * 16 + _i * 8192, _R, _C); \
        dst[_h][_i] = (unsigned)(S.row(u, _h * HALF + _R) * lda + _C) * 2u; } } while (0)
#define PG8_LDA(dst, b, h) do { _Pragma("unroll") for (int m = 0; m < 4; ++m) _Pragma("unroll") for (int k = 0; k < 2; ++k) dst[m][k] = *(const LAS bf16x8*)(lds + PG8_SA(b, h) + aoff + m * 2048 + k * 1024); } while (0)
#define PG8_LDB(dst, b, h) do { _Pragma("unroll") for (int n = 0; n < 2; ++n) _Pragma("unroll") for (int k = 0; k < 2; ++k) dst[n][k] = *(const LAS bf16x8*)(lds + PG8_SB(b, h) + boff + n * 2048 + k * 1024); } while (0)
#define PG8_MMA(ai, bj, At, Bt) do { __builtin_amdgcn_s_setprio(1); _Pragma("unroll") for (int m = 0; m < 4; ++m) _Pragma("unroll") for (int n = 0; n < 2; ++n) _Pragma("unroll") for (int k = 0; k < 2; ++k) \
        acc[ai][bj][m][n] = __builtin_amdgcn_mfma_f32_16x16x32_bf16(Bt[n][k], At[m][k], acc[ai][bj][m][n], 0, 0, 0); __builtin_amdgcn_s_setprio(0); } while (0)
#define PG8_WAIT_V(n) asm volatile("s_waitcnt vmcnt(" #n ")" ::: "memory")
#define PG8_WAIT_L(n) asm volatile("s_waitcnt lgkmcnt(" #n ")" ::: "memory")
#define PG8_BAR __builtin_amdgcn_s_barrier()
#define PG8_SCHED __builtin_amdgcn_sched_barrier(0)
#define PG8_BPTR(blo, bhi, t) (((t) < ks) ? (blo) + (size_t)(t) * kstep : (bhi) + (size_t)((t) - ks) * kstep)
    Unit cur, nxt; int ui = 0;
    if (!S.next(0, cur)) return;
    f32x4 acc[2][2][4][2];
#pragma unroll
    for (int a = 0; a < 2; ++a)
#pragma unroll
        for (int b = 0; b < 2; ++b)
#pragma unroll
            for (int m = 0; m < 4; ++m)
#pragma unroll
                for (int n = 0; n < 2; ++n) acc[a][b][m][n] = (f32x4){0.f, 0.f, 0.f, 0.f};
    bf16x8 At[4][2], B0[2][2], B1[2][2];
    const char* cA = S.a_base(cur); const char* cBlo = S.b_lo(cur); const char* cBhi = S.b_hi(cur);
    if constexpr (GATHER) { PG8_GATHER_OFFS(voffA, cur); }
    PG8_STAGE_B(PG8_SB(0, 0), cBlo, 0); PG8_STAGE_B(PG8_SB(0, 1), cBlo, 1); PG8_STAGE_A(PG8_SA(0, 0), cA, 0); PG8_STAGE_A(PG8_SA(0, 1), cA, 1);
    if (wr == 1) PG8_BAR;
    PG8_WAIT_V(2); PG8_BAR;
    PG8_STAGE_B(PG8_SB(1, 0), cBlo + kstep, 0); PG8_STAGE_A(PG8_SA(1, 0), cA + kstep, 0); PG8_STAGE_B(PG8_SB(1, 1), cBlo + kstep, 1);
    PG8_WAIT_V(6); PG8_BAR;
    for (;;) {
        const bool has_next = S.next(ui + 1, nxt);
        const char* nA = has_next ? S.a_base(nxt) : cA; const char* nBlo = has_next ? S.b_lo(nxt) : cBlo; const char* nBhi = has_next ? S.b_hi(nxt) : cBhi;
        if constexpr (GATHER) { if (has_next) { PG8_GATHER_OFFS(nvA, nxt); } else {
#pragma unroll
            for (int h = 0; h < 2; ++h)
#pragma unroll
                for (int i = 0; i < 2; ++i) nvA[h][i] = voffA[h][i]; } }
#pragma unroll 1
        for (int t = 0; t < nt; t += 2) {
            const bool last = (t == nt - 2);
            const char* a1 = cA + (size_t)(t + 1) * kstep;
            const char* a2 = last ? nA : cA + (size_t)(t + 2) * kstep; const char* b2 = last ? nBlo : PG8_BPTR(cBlo, cBhi, t + 2);
            const char* a3 = a2 + kstep; const char* b3 = b2 + kstep;
            PG8_LDB(B0, 0, 0); PG8_LDB(B1, 0, 1); PG8_SCHED; PG8_LDA(At, 0, 0); PG8_STAGE_A(PG8_SA(1, 1), a1, 1);
            if constexpr (GATHER) { if (last) {
#pragma unroll
                for (int h = 0; h < 2; ++h)
#pragma unroll
                    for (int i = 0; i < 2; ++i) voffA[h][i] = nvA[h][i]; } }
            PG8_WAIT_V(8); PG8_WAIT_L(0); PG8_BAR; PG8_MMA(0, 0, At, B0); PG8_MMA(0, 1, At, B1); PG8_BAR; PG8_SCHED;
            PG8_LDA(At, 0, 1); PG8_STAGE_B(PG8_SB(0, 0), b2, 0); PG8_STAGE_B(PG8_SB(0, 1), b2, 1); PG8_STAGE_A(PG8_SA(0, 0), a2, 0);
            PG8_WAIT_V(8); PG8_WAIT_L(0); PG8_BAR; PG8_MMA(1, 0, At, B0); PG8_MMA(1, 1, At, B1); PG8_BAR; PG8_SCHED;
            PG8_LDB(B0, 1, 0); PG8_LDB(B1, 1, 1); PG8_SCHED; PG8_LDA(At, 1, 0); PG8_STAGE_A(PG8_SA(0, 1), a2, 1);
            PG8_WAIT_V(8); PG8_WAIT_L(0); PG8_BAR; PG8_MMA(0, 0, At, B0); PG8_MMA(0, 1, At, B1); PG8_BAR; PG8_SCHED;
            PG8_LDA(At, 1, 1); PG8_STAGE_B(PG8_SB(1, 0), b3, 0); PG8_STAGE_B(PG8_SB(1, 1), b3, 1); PG8_STAGE_A(PG8_SA(1, 0), a3, 0);
            PG8_WAIT_V(8); PG8_WAIT_L(0); PG8_BAR; PG8_MMA(1, 0, At, B0); PG8_MMA(1, 1, At, B1); PG8_BAR; PG8_SCHED;
        }
        if constexpr (ALIGN_EPI) { if (wr == 0) PG8_BAR; }
        E(acc, cur, wr, wc, fr, fq);
        if (!has_next) break;
#pragma unroll
        for (int a = 0; a < 2; ++a)
#pragma unroll
            for (int b = 0; b < 2; ++b)
#pragma unroll
                for (int m = 0; m < 4; ++m)
#pragma unroll
                    for (int n = 0; n < 2; ++n) acc[a][b][m][n] = (f32x4){0.f, 0.f, 0.f, 0.f};
        cur = nxt; cA = nA; cBlo = nBlo; cBhi = nBhi; ++ui;
        if constexpr (ALIGN_EPI) { if (wr == 1) PG8_BAR; }
    }
    PG8_WAIT_V(0);
    if constexpr (!ALIGN_EPI) { if (wr == 0) PG8_BAR; }
    PG8_BAR;
#undef PG8_SA
#undef PG8_SB
#undef PG8_STAGE
#undef PG8_STAGE_A
#undef PG8_STAGE_B
#undef PG8_GATHER_OFFS
#undef PG8_LDA
#undef PG8_LDB
#undef PG8_MMA
#undef PG8_WAIT_V
#undef PG8_WAIT_L
#undef PG8_BAR
#undef PG8_SCHED
#undef PG8_BPTR
}
}

namespace attn_body {
using bf16=__hip_bfloat16;
using bf16x8=__attribute__((ext_vector_type(8)))short;
using s16x4=__attribute__((ext_vector_type(4)))short;
using f32x16=__attribute__((ext_vector_type(16)))float;
using u32x4=__attribute__((ext_vector_type(4)))unsigned;
constexpr int BATCH=4,NHEAD=16,SEQ=4096,D=64,DM=NHEAD*D;
constexpr int NW=8,QBLK=32,QB=QBLK*NW,KVBLK=64,NQB=SEQ/QB;
constexpr int ATTN_PITCH=DM, ATTN_UNIT_ROWS=QB;
__device__ __forceinline__ int crow(int r,int hi){return (r&3)+8*(r>>2)+4*hi;}
#define SBAR() __builtin_amdgcn_sched_barrier(0)
__device__ __forceinline__ void cmask(f32x16&p0,f32x16&p1,int jb,int qrel,int hi){
  const float NEG=-INFINITY; int kb=64*jb+4*hi;
  #pragma unroll
  for(int r=0;r<16;++r){int kv=kb+(r&3)+8*(r>>2); if(kv>qrel)p0[r]=NEG; if(kv+32>qrel)p1[r]=NEG;}
}

constexpr int NSLOT=3, SLOTB=8192;
constexpr int LDS_K=0, LDS_V=NSLOT*SLOTB, LDS_WS=2*NSLOT*SLOTB, LDS_OST=LDS_WS+NW*64*4, LDS_BYTES=LDS_OST+NW*4096;
constexpr float C2=0.125f*1.4426950408889634f;
__device__ __forceinline__ void glds16(const void*gsrc,unsigned lds_dst){unsigned keep;
  asm volatile("s_mov_b32 %0, m0\n\ts_mov_b32 m0, %2\n\ts_nop 0\n\tglobal_load_lds_dwordx4 %1, off\n\ts_mov_b32 m0, %0":"=&s"(keep):"v"(gsrc),"s"(lds_dst):"memory");}
__device__ __forceinline__ float max3f(float a,float b,float c){float r;asm("v_max3_f32 %0, %1, %2, %3":"=v"(r):"v"(a),"v"(b),"v"(c));return r;}
__device__ __forceinline__ float max2f(float a,float b){float r;asm("v_max_f32_e32 %0, %1, %2":"=v"(r):"v"(a),"v"(b));return r;}
__device__ __forceinline__ float fadd_s(float a,float b){float r;asm("v_add_f32_e32 %0, %1, %2":"=v"(r):"v"(a),"v"(b));return r;}
__device__ __forceinline__ float fsub_s(float a,float b){float r;asm("v_sub_f32_e32 %0, %1, %2":"=v"(r):"v"(a),"v"(b));return r;}
typedef float f32x2_t __attribute__((ext_vector_type(2))); typedef float f32x4_t __attribute__((ext_vector_type(4))); typedef __bf16 bf16x2_t __attribute__((ext_vector_type(2)));
__device__ __forceinline__ unsigned cvtpk_s(float lo,float hi){f32x2_t v={lo,hi};bf16x2_t b=__builtin_convertvector(v,bf16x2_t);return __builtin_bit_cast(unsigned,b);}
#define WAIT_BAR(N) asm volatile("s_waitcnt vmcnt(" #N ") lgkmcnt(0)\n\ts_barrier":::"memory")

__device__ __forceinline__ void qkt(f32x16&p0,f32x16&p1,const char*Kslot,const bf16x8*qr,const f32x16&negm,int r32,int hi){
  const char*kb=Kslot+hi*1024+r32*16;
  #pragma unroll
  for(int d0=0;d0<4;++d0){
    const bf16x8 b0=*reinterpret_cast<const bf16x8*>(kb+d0*2048);
    const bf16x8 b1=*reinterpret_cast<const bf16x8*>(kb+d0*2048+512);
    if(d0==0){p0=__builtin_amdgcn_mfma_f32_32x32x16_bf16(b0,qr[0],negm,0,0,0);p1=__builtin_amdgcn_mfma_f32_32x32x16_bf16(b1,qr[0],negm,0,0,0);}
    else{p0=__builtin_amdgcn_mfma_f32_32x32x16_bf16(b0,qr[d0],p0,0,0,0);p1=__builtin_amdgcn_mfma_f32_32x32x16_bf16(b1,qr[d0],p1,0,0,0);}}
}
typedef __attribute__((address_space(3))) const char* lds_cptr;
typedef short v4i16_t __attribute__((ext_vector_type(4)));
__device__ __forceinline__ void kload8(bf16x8*kf,lds_cptr kp){
  kf[0]=*(const __attribute__((address_space(3))) bf16x8*)(kp);      kf[1]=*(const __attribute__((address_space(3))) bf16x8*)(kp+512);
  kf[2]=*(const __attribute__((address_space(3))) bf16x8*)(kp+2048); kf[3]=*(const __attribute__((address_space(3))) bf16x8*)(kp+2560);
  kf[4]=*(const __attribute__((address_space(3))) bf16x8*)(kp+4096); kf[5]=*(const __attribute__((address_space(3))) bf16x8*)(kp+4608);
  kf[6]=*(const __attribute__((address_space(3))) bf16x8*)(kp+6144); kf[7]=*(const __attribute__((address_space(3))) bf16x8*)(kp+6656);
}
__device__ __forceinline__ void kload2(bf16x8*kf,lds_cptr kp,int j){ kf[2*j]=*(const __attribute__((address_space(3))) bf16x8*)(kp+j*2048); kf[2*j+1]=*(const __attribute__((address_space(3))) bf16x8*)(kp+j*2048+512); }
__device__ __forceinline__ s16x4 vtr(lds_cptr p){ return __builtin_bit_cast(s16x4,__builtin_amdgcn_ds_read_tr16_b64_v4i16((__attribute__((address_space(3))) v4i16_t*)p)); }
__device__ __forceinline__ float rowmax(const f32x16&p0,const f32x16&p1){
  float a=max3f(p0[0],p0[1],p1[0]),b=max3f(p0[2],p0[3],p1[1]);a=max3f(a,p1[2],p1[3]);
  #pragma unroll
  for(int r=4;r<16;r+=4){a=max3f(a,p0[r],p0[r+1]);b=max3f(b,p0[r+2],p0[r+3]);a=max3f(a,p1[r],p1[r+1]);b=max3f(b,p1[r+2],p1[r+3]);}
  const float m=max2f(a,b);
  auto rr=__builtin_amdgcn_permlane32_swap(__float_as_uint(m),__float_as_uint(m),false,false);
  return max2f(__uint_as_float(rr[0]),__uint_as_float(rr[1]));
}
__device__ __forceinline__ void pv(f32x16*o,int vb,bf16x8 pa0,bf16x8 pa1,bf16x8 pa2,bf16x8 pa3){
  #pragma unroll
  for(int d0=0;d0<2;++d0){s16x4 lo[4],hi[4];
    #pragma unroll
    for(int ks=0;ks<4;++ks){
      asm volatile("ds_read_b64_tr_b16 %0,%1 offset:%c2":"=&v"(lo[ks]):"v"(vb),"i"(d0*4096+ks*1024):"memory");
      asm volatile("ds_read_b64_tr_b16 %0,%1 offset:%c2":"=&v"(hi[ks]):"v"(vb),"i"(d0*4096+ks*1024+512):"memory");}
    asm volatile("s_waitcnt lgkmcnt(0)":::"memory");SBAR();
    #define PK(k) (bf16x8){lo[k][0],lo[k][1],lo[k][2],lo[k][3],hi[k][0],hi[k][1],hi[k][2],hi[k][3]}
    o[d0]=__builtin_amdgcn_mfma_f32_32x32x16_bf16(pa0,PK(0),o[d0],0,0,0);
    o[d0]=__builtin_amdgcn_mfma_f32_32x32x16_bf16(pa1,PK(1),o[d0],0,0,0);
    o[d0]=__builtin_amdgcn_mfma_f32_32x32x16_bf16(pa2,PK(2),o[d0],0,0,0);
    o[d0]=__builtin_amdgcn_mfma_f32_32x32x16_bf16(pa3,PK(3),o[d0],0,0,0);
    #undef PK
  }
}

#ifndef ATTN_STORE16
#define ATTN_STORE16(p,v) (*(u32x4*)(p)=(v))
#endif
template<int THRL> __device__ __forceinline__ void attn_unit(int b,int h,int qb,int t0,const bf16*Q,const bf16*__restrict__ K,const bf16*__restrict__ V,bf16*O,char*shm,const __attribute__((address_space(3))) float*ncum){
  int tid_=threadIdx.x; asm volatile("":"+v"(tid_)); const int tid=tid_,lane=tid&63,r32=lane&31,hi=lane>>5; const int wid=__builtin_amdgcn_readfirstlane(tid>>6);
  const long rowbase=(long)b*SEQ; const int q0=qb*QB;
  const bf16*Qw=Q+(rowbase+q0+wid*QBLK)*DM+h*D;
  const bf16*Kh=K+(rowbase+(long)t0*KVBLK)*DM+h*D,*Vh=V+(rowbase+(long)t0*KVBLK)*DM+h*D;
  const unsigned lds0=(unsigned)(uintptr_t)shm;
  float*wsf=(float*)(shm+LDS_WS)+wid*64;
  const bf16*ksrc=Kh+(long)lane*DM+wid*8;
  const bf16*vsrc=Vh+(long)(16*(wid&3)+(lane>>2))*DM+(wid>>2)*32+(lane&3)*8;
  const unsigned kdst=lds0+LDS_K+wid*1024, vdst=lds0+LDS_V+wid*1024;
  #define DMA_K(t,slot) glds16(ksrc+(long)(t)*KVBLK*DM,(unsigned)__builtin_amdgcn_readfirstlane(kdst+(slot)))
  #define DMA_V(t,slot) glds16(vsrc+(long)(t)*KVBLK*DM,(unsigned)__builtin_amdgcn_readfirstlane(vdst+(slot)))
  const int vb0=(int)(lds0+LDS_V)+((lane>>4)&1)*32+(lane&3)*8+(4*hi+((lane&15)>>2))*64;
  const char*Kbase=shm+LDS_K; bf16x8 kf[8];
  const lds_cptr shm3=(lds_cptr)shm; const lds_cptr kp0=shm3+LDS_K+hi*1024+r32*16; const lds_cptr vp0=shm3+LDS_V+((lane>>4)&1)*32+(lane&3)*8+(4*hi+((lane&15)>>2))*64;
  const int NT=(q0+QB)/KVBLK-t0;
  DMA_K(0,0);DMA_V(0,0);DMA_K(1,SLOTB);
  bf16x8 qr[4];
  #pragma unroll
  for(int d0=0;d0<4;++d0)qr[d0]=*reinterpret_cast<const bf16x8*>(&Qw[(long)r32*DM+d0*16+hi*8]);
  float mhat=ncum[q0-t0*KVBLK+wid*QBLK+r32],l_reg=0.f;f32x16 o[2];o[0]=f32x16{};o[1]=f32x16{};f32x16 negm; { float z_=-mhat; asm volatile("":"+v"(z_)); _Pragma("unroll") for(int r=0;r<16;++r)negm[r]=z_; } asm volatile("":"+v"(negm));
  const int qrel=wid*QBLK+r32;
  #define CMASK(P0,P1,t) do{int jb_=(t)-(NT-4); if(jb_>=0)cmask(P0,P1,jb_,qrel,hi);}while(0)
  #define CBIAS(P0,P1,t) do{ const __attribute__((address_space(3))) float*cb_=ncum+64*(t)+4*hi; \
    _Pragma("unroll") for(int g4=0;g4<4;++g4){ const f32x4_t b0_=*(const __attribute__((address_space(3))) f32x4_t*)(cb_+8*g4); const f32x4_t b1_=*(const __attribute__((address_space(3))) f32x4_t*)(cb_+32+8*g4); \
      P0[4*g4]+=b0_[0];P0[4*g4+1]+=b0_[1];P0[4*g4+2]+=b0_[2];P0[4*g4+3]+=b0_[3]; P1[4*g4]+=b1_[0];P1[4*g4+1]+=b1_[1];P1[4*g4+2]+=b1_[2];P1[4*g4+3]+=b1_[3]; } }while(0)
  bool resc=false;
  #define START(P0,P1) do{ const float rm=rowmax(P0,P1); resc=false; \
    { const float dl=max2f(rm,0.f); mhat=fadd_s(mhat,dl); \
      _Pragma("unroll") for(int r=0;r<16;++r){P0[r]=fsub_s(P0[r],dl);P1[r]=fsub_s(P1[r],dl);} \
      _Pragma("unroll") for(int r=0;r<16;++r)negm[r]=-mhat; asm volatile("":"+v"(negm)); } \
    _Pragma("unroll") for(int r=0;r<16;++r)P0[r]=__builtin_amdgcn_exp2f(P0[r]); }while(0)
  #define RESC() do{ if(resc){ asm volatile("s_waitcnt lgkmcnt(0)":::"memory"); \
      _Pragma("unroll") for(int d_=0;d_<2;++d_) _Pragma("unroll") for(int r=0;r<16;++r)o[d_][r]*=wsf[crow(r,hi)]; } }while(0)
  f32x16 pA0,pA1,pB0,pB1;
  int sl_prev=0,sl_cur=0,sl_next=SLOTB;
  #define ROT() do{sl_prev=sl_cur;sl_cur=sl_next;sl_next=(sl_next==(NSLOT-1)*SLOTB)?0:sl_next+SLOTB;}while(0)
  DMA_K(2,2*SLOTB);
  WAIT_BAR(3);
  qkt(pA0,pA1,Kbase,qr,negm,r32,hi);asm volatile("s_nop 15\n\ts_nop 7":"+v"(pA0),"+v"(pA1));CBIAS(pA0,pA1,0);CMASK(pA0,pA1,0);
  START(pA0,pA1);
  _Pragma("unroll") for(int r=0;r<16;++r)pA1[r]=__builtin_amdgcn_exp2f(pA1[r]);
  WAIT_BAR(0);
  DMA_K(3,0);DMA_V(1,SLOTB);
  ROT();
  kload8(kf,kp0+sl_cur);
  WAIT_BAR(2);
  s16x4 vlo[8],vhi[8]; u32x4 pw0,pw1,pw2,pw3;
  #define PKW(P,B) cvtpk_s(P[B],P[B+1])
  #define PAF(k) __builtin_bit_cast(bf16x8,pw##k)
  #define VFR(i) (bf16x8){vlo[i][0],vlo[i][1],vlo[i][2],vlo[i][3],vhi[i][0],vhi[i][1],vhi[i][2],vhi[i][3]}
  #define PIN(x) asm volatile("":"+v"(x))
  #define MX3(a,b,c) __builtin_fmaxf(__builtin_fmaxf((a),(b)),(c))
  #define GAPA(MF,A0,A1,A2,A3,W0,W1,PW) do{ MF; sacc+=A0; sacc+=A1; sacc+=A2; sacc+=A3; PIN(sacc); W0; W1; PIN(PW); SBAR(); }while(0)
  #define EX(v) __builtin_amdgcn_exp2f(v)
  #define GAPB(MF,X,B) do{ MF; X[B]=EX(X[B]); X[B+1]=EX(X[B+1]); X[B+2]=EX(X[B+2]); X[B+3]=EX(X[B+3]); PIN(X); SBAR(); }while(0)
  #define VRD(i) do{ vlo[i]=vtr(vp_+(((i)>>2)*4096+((i)&3)*1024)); vhi[i]=vtr(vp_+(((i)>>2)*4096+((i)&3)*1024+512)); }while(0)
  #define KRD(G,j) do{ if(G){ kload2(kf,kp0+sl_next,j); SBAR(); } }while(0)
  #define STEP(C0,C1,P0,P1,t,GK,GV,GL) do{ SBAR(); \
    const lds_cptr vp_=vp0+sl_prev; \
    VRD(0); SBAR(); float sacc=(P0[0]+P0[1]); \
    GAPA(C0=__builtin_amdgcn_mfma_f32_32x32x16_bf16(kf[0],qr[0],negm,0,0,0), P0[2],P0[3],P0[4],P0[5],     pw0[0]=PKW(P0,0), pw0[1]=PKW(P0,2), pw0); \
    VRD(4); SBAR(); GAPA(C1=__builtin_amdgcn_mfma_f32_32x32x16_bf16(kf[1],qr[0],negm,0,0,0), P0[6],P0[7],P0[8],P0[9],     pw0[2]=PKW(P0,4), pw0[3]=PKW(P0,6), pw0); \
    VRD(1); SBAR(); GAPA(C0=__builtin_amdgcn_mfma_f32_32x32x16_bf16(kf[2],qr[1],C0,0,0,0),   P0[10],P0[11],P0[12],P0[13], pw1[0]=PKW(P0,8), pw1[1]=PKW(P0,10), pw1); \
    VRD(5); SBAR(); GAPA(C1=__builtin_amdgcn_mfma_f32_32x32x16_bf16(kf[3],qr[1],C1,0,0,0),   P0[14],P0[15],P1[0],P1[1],   pw1[2]=PKW(P0,12),pw1[3]=PKW(P0,14), pw1); \
    VRD(2); SBAR(); GAPA(C0=__builtin_amdgcn_mfma_f32_32x32x16_bf16(kf[4],qr[2],C0,0,0,0),   P1[2],P1[3],P1[4],P1[5],     pw2[0]=PKW(P1,0), pw2[1]=PKW(P1,2), pw2); \
    VRD(6); SBAR(); GAPA(C1=__builtin_amdgcn_mfma_f32_32x32x16_bf16(kf[5],qr[2],C1,0,0,0),   P1[6],P1[7],P1[8],P1[9],     pw2[2]=PKW(P1,4), pw2[3]=PKW(P1,6), pw2); \
    VRD(3); SBAR(); GAPA(C0=__builtin_amdgcn_mfma_f32_32x32x16_bf16(kf[6],qr[3],C0,0,0,0),   P1[10],P1[11],P1[12],P1[13], pw3[0]=PKW(P1,8), pw3[1]=PKW(P1,10), pw3); \
    VRD(7); SBAR(); GAPA(C1=__builtin_amdgcn_mfma_f32_32x32x16_bf16(kf[7],qr[3],C1,0,0,0),   P1[14],P1[15],0.f,0.f,       pw3[2]=PKW(P1,12),pw3[3]=PKW(P1,14), pw3); \
    l_reg+=sacc; \
    if(GK){DMA_K((t)+3,sl_cur);} if(GV){DMA_V((t)+1,sl_next);} \
    CBIAS(C0,C1,t); CMASK(C0,C1,t); \
    { float a=MX3(C0[0],C0[1],C1[0]),b=MX3(C0[2],C0[3],C1[1]); a=MX3(a,C1[2],C1[3]); \
      _Pragma("unroll") for(int r=4;r<16;r+=4){a=MX3(a,C0[r],C0[r+1]);b=MX3(b,C0[r+2],C0[r+3]);a=MX3(a,C1[r],C1[r+1]);b=MX3(b,C1[r+2],C1[r+3]);} \
      float rm=__builtin_fmaxf(a,b); { auto rr=__builtin_amdgcn_permlane32_swap(__float_as_uint(rm),__float_as_uint(rm),false,false); rm=__builtin_fmaxf(__uint_as_float(rr[0]),__uint_as_float(rr[1])); } \
      resc=false; \
      if(__builtin_expect(__any(rm>(float)THRL),0)){ const float dl=__builtin_fmaxf(rm,0.f); mhat+=dl; \
        _Pragma("unroll") for(int r=0;r<16;++r){C0[r]-=dl;C1[r]-=dl;} \
        _Pragma("unroll") for(int r=0;r<16;++r)negm[r]=-mhat; asm volatile("":"+v"(negm)); \
        const float f=__builtin_amdgcn_exp2f(-dl); l_reg*=f; if(hi==0)wsf[r32]=f; resc=true; } } \
    SBAR(); \
    GAPB(o[0]=__builtin_amdgcn_mfma_f32_32x32x16_bf16(PAF(0),VFR(0),o[0],0,0,0), C0,0); \
    GAPB(o[1]=__builtin_amdgcn_mfma_f32_32x32x16_bf16(PAF(0),VFR(4),o[1],0,0,0), C0,4); \
    KRD(GL,0); GAPB(o[0]=__builtin_amdgcn_mfma_f32_32x32x16_bf16(PAF(1),VFR(1),o[0],0,0,0), C0,8); \
    KRD(GL,1); GAPB(o[1]=__builtin_amdgcn_mfma_f32_32x32x16_bf16(PAF(1),VFR(5),o[1],0,0,0), C0,12); \
    KRD(GL,2); GAPB(o[0]=__builtin_amdgcn_mfma_f32_32x32x16_bf16(PAF(2),VFR(2),o[0],0,0,0), C1,0); \
    KRD(GL,3); GAPB(o[1]=__builtin_amdgcn_mfma_f32_32x32x16_bf16(PAF(2),VFR(6),o[1],0,0,0), C1,4); \
    GAPB(o[0]=__builtin_amdgcn_mfma_f32_32x32x16_bf16(PAF(3),VFR(3),o[0],0,0,0), C1,8); \
    GAPB(o[1]=__builtin_amdgcn_mfma_f32_32x32x16_bf16(PAF(3),VFR(7),o[1],0,0,0), C1,12); \
    }while(0)
  int t=1;
  #undef CMASK
  #define CMASK(P0,P1,t) do{}while(0)
  for(;t+5<NT;t+=2){
    STEP(pB0,pB1,pA0,pA1,t,true,true,true);     WAIT_BAR(2); RESC(); ROT();
    STEP(pA0,pA1,pB0,pB1,t+1,true,true,true);   WAIT_BAR(2); RESC(); ROT();
  }
  #undef CMASK
  #define CMASK(P0,P1,t) do{int jb_=(t)-(NT-4); if(jb_>=0)cmask(P0,P1,jb_,qrel,hi);}while(0)
  #define ENDW(tt) do{ if((tt)+3<NT){WAIT_BAR(2);} else if((tt)+2<NT){WAIT_BAR(1);} else {WAIT_BAR(0);} }while(0)
  for(;t+1<NT;t+=2){
    STEP(pB0,pB1,pA0,pA1,t,(t+3<NT),(t+1<NT),(t+1<NT));       ENDW(t);   RESC(); ROT();
    STEP(pA0,pA1,pB0,pB1,t+1,(t+4<NT),(t+2<NT),(t+2<NT));     ENDW(t+1); RESC(); ROT();
  }
  STEP(pB0,pB1,pA0,pA1,NT-1,false,false,false); RESC();
  { float sacc=pB0[0]+pB0[1]; _Pragma("unroll") for(int r=2;r<16;++r)sacc+=pB0[r]; _Pragma("unroll") for(int r=0;r<16;++r)sacc+=pB1[r]; l_reg+=sacc;
    pw0=(u32x4){PKW(pB0,0),PKW(pB0,2),PKW(pB0,4),PKW(pB0,6)};pw1=(u32x4){PKW(pB0,8),PKW(pB0,10),PKW(pB0,12),PKW(pB0,14)};pw2=(u32x4){PKW(pB1,0),PKW(pB1,2),PKW(pB1,4),PKW(pB1,6)};pw3=(u32x4){PKW(pB1,8),PKW(pB1,10),PKW(pB1,12),PKW(pB1,14)};
    SBAR(); pv(o,vb0+sl_cur,PAF(0),PAF(1),PAF(2),PAF(3)); }
  #undef PKW
  #undef PAF
  #undef VFR
  #undef PIN
  #undef MX3
  #undef GAPA
  #undef GAPB
  #undef EX
  #undef VRD
  #undef KRD
  #undef STEP
  #undef ENDW
  {auto rr=__builtin_amdgcn_permlane32_swap(__float_as_uint(l_reg),__float_as_uint(l_reg),false,false);l_reg=__uint_as_float(rr[0])+__uint_as_float(rr[1]);}
  if(hi==0)wsf[32+r32]=l_reg;asm volatile("s_waitcnt lgkmcnt(0)":::"memory");
  float rli[16];
  #pragma unroll
  for(int r=0;r<16;++r)rli[r]=__builtin_amdgcn_rcpf(wsf[32+crow(r,hi)]);
  bf16*Ow=O+(rowbase+q0+wid*QBLK)*DM+h*D;
  { bf16*stg=(bf16*)(shm+LDS_OST)+wid*2048;
    #pragma unroll
    for(int r=0;r<16;++r){const int orow=crow(r,hi);
      #pragma unroll
      for(int d0=0;d0<2;++d0)stg[orow*64+d0*32+r32]=__float2bfloat16(o[d0][r]*rli[r]);}
    asm volatile("s_waitcnt lgkmcnt(0)":::"memory");
    #pragma unroll
    for(int i=0;i<4;++i){const int row=i*8+(lane>>3),ch=lane&7; const u32x4 v=*(const u32x4*)(stg+row*64+ch*8); ATTN_STORE16(Ow+(long)row*DM+ch*8,v);} }
  asm volatile("s_waitcnt lgkmcnt(0)\n\ts_barrier":::"memory");
  #undef DMA_K
  #undef DMA_V
  #undef CMASK
  #undef CBIAS
  #undef START
  #undef RESC
  #undef ROT
}
constexpr int ATTN_LDS_BYTES=LDS_BYTES;
struct AttnTensors { const bf16* Q; const bf16* K; const bf16* V; bf16* O; };
__device__ __forceinline__ void fox_phase(char*lds,const bf16*Q,const bf16*K,const bf16*V,bf16*O,const float*CUM,const float*qg,const float*kg,int grid,int block){
  const int vcu=(grid%8==0)?(block%8)*(grid/8)+block/8:block; const int bh=vcu>>2, s=vcu&3;
  if(bh>=BATCH*NHEAD)return;
  float*nc=(float*)(lds+98304);
  for(int i=threadIdx.x;i<SEQ;i+=512)nc[i]=CUM[(size_t)bh*SEQ+i];
  const int lane=threadIdx.x&63;
  float gq=fabsf(qg[lane]),gk=fabsf(kg[lane]);
  #pragma unroll
  for(int o=1;o<64;o<<=1){gq=fmaxf(gq,__shfl_xor(gq,o));gk=fmaxf(gk,__shfl_xor(gk,o));}
  const float thresh=2.0f*(8.0f*gq*C2)*(8.0f*gk)*1.02f+32.0f;
  __syncthreads();
  const __attribute__((address_space(3))) float*ncum=(const __attribute__((address_space(3))) float*)(nc);
  for(int i=0;i<4;++i){ const int qb=(i==0)?s:(i==1)?7-s:(i==2)?8+s:15-s; const int NTf=4*qb+4;
    const bool ok=(lane<NTf-4)&&(ncum[qb*QB]-ncum[64*lane+63]>=thresh);
    int t0=__builtin_popcountll(__ballot(ok))&~1; t0=__builtin_amdgcn_readfirstlane(t0);
    attn_unit<8>(bh/NHEAD,bh%NHEAD,qb,t0,Q,K,V,O,lds,ncum+64*t0); }
}
template<int H> __device__ __forceinline__ void qkt_half(f32x16&p,const char*Kslot,const bf16x8*qr,int r32,int hi){
  const char*kb=Kslot+hi*1024+r32*16+H*512;
  #pragma unroll
  for(int d0=0;d0<4;++d0){ const bf16x8 b=*reinterpret_cast<const bf16x8*>(kb+d0*2048);
    if(d0==0){ f32x16 z=f32x16{}; p=__builtin_amdgcn_mfma_f32_32x32x16_bf16(b,qr[0],z,0,0,0); } else p=__builtin_amdgcn_mfma_f32_32x32x16_bf16(b,qr[d0],p,0,0,0); }
}
template<int H> __device__ __forceinline__ void pv_half(f32x16*o,int vb,bf16x8 pa0,bf16x8 pa1){
  #pragma unroll
  for(int d0=0;d0<2;++d0){s16x4 lo[2],hi[2];
    #pragma unroll
    for(int ks=0;ks<2;++ks){
      asm volatile("ds_read_b64_tr_b16 %0,%1 offset:%c2":"=&v"(lo[ks]):"v"(vb),"i"(d0*4096+(2*H+ks)*1024):"memory");
      asm volatile("ds_read_b64_tr_b16 %0,%1 offset:%c2":"=&v"(hi[ks]):"v"(vb),"i"(d0*4096+(2*H+ks)*1024+512):"memory");}
    asm volatile("s_waitcnt lgkmcnt(0)":::"memory");SBAR();
    #define PK(k) (bf16x8){lo[k][0],lo[k][1],lo[k][2],lo[k][3],hi[k][0],hi[k][1],hi[k][2],hi[k][3]}
    o[d0]=__builtin_amdgcn_mfma_f32_32x32x16_bf16(pa0,PK(0),o[d0],0,0,0);
    o[d0]=__builtin_amdgcn_mfma_f32_32x32x16_bf16(pa1,PK(1),o[d0],0,0,0);
    #undef PK
  }
}
template<int SKIP> __device__ __forceinline__ void dil_core(f32x16*o,float&mx_out,float&l_out,const char*Kh,const bf16x8*qr,const __attribute__((address_space(3))) float*eb,int nb,int ktlo,int rot,int vb0,int r32,int hi){
  f32x16 s[6];
  #pragma unroll
  for(int hh=0;hh<6;++hh){ if(hh==SKIP)continue; const int i=hh>>1,hf=hh&1,kt=ktlo+i;
    if(hf==0)qkt_half<0>(s[hh],Kh+(kt^rot)*8192,qr,r32,hi); else qkt_half<1>(s[hh],Kh+(kt^rot)*8192,qr,r32,hi);
    if(nb==0&&kt<2){
      #pragma unroll
      for(int r=0;r<16;++r)s[hh][r]=-1e30f; }
    else {
      #pragma unroll
      for(int r=0;r<16;++r){ const int c=(r&3)+8*(r>>2); s[hh][r]+=eb[59-c-32*hf+128-64*i]; } } }
  float mx=-1e30f;
  #pragma unroll
  for(int hh=0;hh<6;++hh){ if(hh==SKIP)continue;
    #pragma unroll
    for(int r=0;r<16;++r)mx=fmaxf(mx,s[hh][r]); }
  { auto rr=__builtin_amdgcn_permlane32_swap(__float_as_uint(mx),__float_as_uint(mx),false,false); mx=fmaxf(__uint_as_float(rr[0]),__uint_as_float(rr[1])); }
  float l=0.f;
  #pragma unroll
  for(int hh=0;hh<6;++hh){ if(hh==SKIP)continue;
    #pragma unroll
    for(int r=0;r<16;++r){ s[hh][r]=__builtin_amdgcn_exp2f(s[hh][r]-mx); l+=s[hh][r]; } }
  { auto rr=__builtin_amdgcn_permlane32_swap(__float_as_uint(l),__float_as_uint(l),false,false); l=__uint_as_float(rr[0])+__uint_as_float(rr[1]); }
  #define PKW(P,B) cvtpk_s(P[B],P[B+1])
  #pragma unroll
  for(int hh=0;hh<6;++hh){ if(hh==SKIP)continue; const int i=hh>>1,hf=hh&1,kt=ktlo+i;
    const u32x4 pwa=(u32x4){PKW(s[hh],0),PKW(s[hh],2),PKW(s[hh],4),PKW(s[hh],6)},pwb=(u32x4){PKW(s[hh],8),PKW(s[hh],10),PKW(s[hh],12),PKW(s[hh],14)};
    if(hf==0)pv_half<0>(o,vb0+(kt^rot)*8192,__builtin_bit_cast(bf16x8,pwa),__builtin_bit_cast(bf16x8,pwb)); else pv_half<1>(o,vb0+(kt^rot)*8192,__builtin_bit_cast(bf16x8,pwa),__builtin_bit_cast(bf16x8,pwb)); }
  #undef PKW
  mx_out=mx; l_out=l;
}
template<int R> __device__ __forceinline__ void dil_unit(int g,int b,int j,int nb,int hp,int u,const bf16*Q,const bf16*__restrict__ K,const bf16*__restrict__ V,const float*__restrict__ BIASV,bf16*ORUN,float*LSE,char*shm,char*aux){
  typedef __attribute__((address_space(3))) char* lptr;
  int tid_=threadIdx.x; asm volatile("":"+v"(tid_)); const int tid=tid_,lane=tid&63,r32=lane&31,hi=lane>>5; const int wid=__builtin_amdgcn_readfirstlane(tid>>6);
  const int hl=wid>>2,qs=wid&3,h=2*hp+hl;
  const unsigned lds0=(unsigned)(uintptr_t)shm;
  float*bvl=(float*)aux;
  float*wsf=(float*)(aux+2048)+wid*64;
  const long rowbase=(long)b*SEQ;
  const int rot=(u&1)*2;
  { const int wv=tid>>6, rowK=(lane&15)+16*(wv&3), chK=(lane>>4)+4*(wv>>2), rowV=(lane>>2)+16*(wv&3), chV=(lane&3)+4*(wv>>2); u32x4 val[16];
    #pragma unroll
    for(int it=0;it<16;++it){ const int kt=it&3,kv=(it>>2)&1,hh=it>>3; val[it]=(u32x4){0u,0u,0u,0u}; const int row=kv?rowV:rowK, ch=kv?chV:chK;
      const bool need=(kt>=2)||(u==0&&nb>0);
      if(need){ const int kp=nb*128-128+kt*64+row; const bf16*src=(kv?V:K)+(rowbase+(long)kp*R+j)*DM+(2*hp+hh)*D+ch*8; val[it]=*reinterpret_cast<const u32x4*>(src); } }
    { const int hh=tid>>8, x=tid&255, dd=x-64; bvl[hh*256+x]=(dd>=0&&dd<=128)?BIASV[(g*16+2*hp+hh)*132+dd]:-1e30f; }
    #pragma unroll
    for(int it=0;it<16;++it){ const int kt=it&3,kv=(it>>2)&1,hh=it>>3; const int row=kv?rowV:rowK, ch=kv?chV:chK;
      const bool need=(kt>=2)||(u==0&&nb>0), zfill=(kv==1)&&(u==0)&&(nb==0)&&(kt<2);
      const int off=hh*65536+kv*32768+(kt^rot)*8192+(kv?((ch>>2)*4096+row*64+(ch&3)*16):(ch*1024+row*16));
      if(need||zfill) *reinterpret_cast<__attribute__((address_space(3))) u32x4*>((lptr)shm+off)=val[it]; }
  }
  const int p0q=nb*128+32*qs;
  const bf16*Qw=Q+(rowbase+(long)(p0q+r32)*R+j)*DM+h*D;
  bf16x8 qr[4];
  #pragma unroll
  for(int d0=0;d0<4;++d0)qr[d0]=*reinterpret_cast<const bf16x8*>(&Qw[d0*16+hi*8]);
  const long orow=rowbase+(long)(p0q+r32)*R+j;
  float lr_old=0.f; u32x4 ov_old[4];
  #pragma unroll
  for(int i=0;i<4;++i)ov_old[i]=(u32x4){0u,0u,0u,0u};
  if(g>0){ lr_old=LSE[orow*16+h];
    #pragma unroll
    for(int i=0;i<4;++i){const int row=i*8+(lane>>3),ch=lane&7; ov_old[i]=*(const u32x4*)(ORUN+(rowbase+(long)(p0q+row)*R+j)*DM+h*D+ch*8);} }
  asm volatile("s_waitcnt vmcnt(0) lgkmcnt(0)\n\ts_barrier":::"memory");
  const int ktlo=(qs>=2)?1:0;
  const char*Kh=shm+hl*65536;
  const __attribute__((address_space(3))) float*eb=(const __attribute__((address_space(3))) float*)((lptr)aux)+hl*256+(32*qs+128-64*ktlo)+r32-4*hi-123;
  f32x16 o[2]; o[0]=f32x16{}; o[1]=f32x16{};
  const int vb0=(int)lds0+hl*65536+32768+((lane>>4)&1)*32+(lane&3)*8+(4*hi+((lane&15)>>2))*64;
  float mx,l;
  if(qs&1) dil_core<0>(o,mx,l,Kh,qr,eb,nb,ktlo,rot,vb0,r32,hi); else dil_core<5>(o,mx,l,Kh,qr,eb,nb,ktlo,rot,vb0,r32,hi);
  float lse=mx*0.6931471805599453f+__logf(l), a=1.0f/l, bco=0.f;
  if(g>0){ const float lr=lr_old; const float mxl=fmaxf(lr,lse), nl=mxl+__logf(__expf(lr-mxl)+__expf(lse-mxl)); a=__expf(lse-nl)/l; bco=__expf(lr-nl); lse=nl; }
  if(hi==0){ wsf[r32]=a; wsf[32+r32]=bco; LSE[orow*16+h]=lse; }
  asm volatile("s_waitcnt lgkmcnt(0)\n\ts_barrier":::"memory");
  float av[16];
  #pragma unroll
  for(int r=0;r<16;++r)av[r]=wsf[crow(r,hi)];
  { bf16*stg=(bf16*)(shm+(wid>>2)*65536+(rot+((wid>>1)&1))*8192+(wid&1)*4096);
    #pragma unroll
    for(int r=0;r<16;++r){const int orw=crow(r,hi);
      #pragma unroll
      for(int d0=0;d0<2;++d0)stg[orw*64+d0*32+r32]=__float2bfloat16(o[d0][r]*av[r]);}
    asm volatile("s_waitcnt lgkmcnt(0)":::"memory");
    #pragma unroll
    for(int i=0;i<4;++i){const int row=i*8+(lane>>3),ch=lane&7; u32x4 v=*(const u32x4*)(stg+row*64+ch*8);
      bf16*dst=ORUN+(rowbase+(long)(p0q+row)*R+j)*DM+h*D+ch*8;
      if(g>0){ const float bc=wsf[32+row]; const u32x4 ov=ov_old[i]; u32x4 w;
        #pragma unroll
        for(int q=0;q<4;++q){ const float n0=__uint_as_float(v[q]<<16)+bc*__uint_as_float(ov[q]<<16), n1=__uint_as_float(v[q]&0xffff0000u)+bc*__uint_as_float(ov[q]&0xffff0000u); w[q]=cvtpk_s(n0,n1); }
        v=w; }
      *(u32x4*)dst=v; } }
  asm volatile("s_waitcnt lgkmcnt(0)\n\ts_barrier":::"memory");
}
template<int R> __device__ __forceinline__ void dil_phase(int g,char*lds,char*aux,const bf16*Q,const bf16*K,const bf16*V,const float*BIASV,bf16*ORUN,float*LSE,int grid,int block){
  constexpr int NBK=32/R, CL=NBK<4?NBK:4, CPZ=NBK/CL, NCH=1024/CL;
  for(int ch=block;ch<NCH;ch+=grid){ const int hp=ch&7,t=ch>>3,nb0=(t%CPZ)*CL,z=t/CPZ;
    #pragma unroll 1
    for(int u=0;u<CL;++u) dil_unit<R>(g,z/R,z%R,nb0+u,hp,u,Q,K,V,BIASV,ORUN,LSE,lds,aux); }
}
#undef SBAR
#undef WAIT_BAR
}

__device__ __forceinline__ LAS int* moe_tables(Frame& F, int layer, bool combo) {
    LAS int* tab = (LAS int*)(F.lds + LDSCTL_OFF + 1024);
    const int nl = combo ? 24 : 16;
    if (F.tid < nl) tab[32 + F.tid] = (int)__hip_atomic_load(F.ctl + CW_CNT + (layer * 40 + (combo ? 16 : 0) + F.tid) * 64, RLX_AGENT);
    __syncthreads();
    if (F.tid == 0) { int run = 0;
        for (int k = 0; k < nl; ++k) { tab[k] = run; run += (tab[32 + k] + 255) >> 8; }
        tab[nl] = run; }
    __syncthreads();
    return tab;
}

#define MOE_PHASES(layer, P1, P2) \
    PHASE(P1) { LAS int* tab = moe_tables(F, layer, false); \
        pg8::MoeOrder S{F.G, (int)blockIdx.x, 16, 2, 16, 1, (const char*)(F.ws + WS_HM), (const char*)(F.ws + WS_MOE1 + (size_t)(layer) * 16 * 512 * 1024 * 2), (const int*)(F.ws + WS_ELIST), tab}; \
        pg8::EpiMoe1 E{(const int*)(F.ws + WS_ELIST), (const v4u*)(F.ws + WS_TOKREC), (bf16*)(F.ws + WS_HID2), F.flags & 4}; \
        pg8::gemm_phase<pg8::EpiMoe1, pg8::MoeOrder, true, true>(F.lds + RING_OFF, 1024, 1024, 1024, S, E); \
        if ((layer) == 0) { const int n2 = min(max(tab[16] * 2 - F.G, 0), F.G), c = (int)blockIdx.x;         \
            if (n2 >= F.G) convert_later(F, c * NWAVES + F.wave, F.G * NWAVES); else if (c >= n2) convert_later(F, (c - n2) * NWAVES + F.wave, (F.G - n2) * NWAVES); } \
        SEAM(P1); } \
    PHASE(P2) { LAS int* tab = moe_tables(F, layer, true); \
        { LAS float* gt = (LAS float*)(F.lds + GTAB_OFF); const float* gv = (const float*)(F.ws + WS_MOD) + (size_t)(layer) * 4 * 6144 + 5 * D; const float gs = (F.flags & 1) ? 0.5f : 1.0f; \
          for (int i = F.tid; i < 4 * D; i += NWAVES * 64) gt[i] = gv[(size_t)(i >> 10) * 6144 + (i & 1023)] * gs; __syncthreads(); } \
        pg8::MoeOrder S{F.G, (int)blockIdx.x, 24, 4, 4, 2, (const char*)(F.ws + WS_HID2), (const char*)(F.ws + WS_MOE2 + (size_t)(layer) * 16 * 1024 * 256 * 2), (const int*)(F.ws + WS_CLIST), tab}; \
        pg8::EpiMoe2 E{(const int*)(F.ws + WS_CLIST), F.out, (const LAS float*)(F.lds + GTAB_OFF), F.flags & 4}; \
        pg8::gemm_phase<pg8::EpiMoe2, pg8::MoeOrder, true, true>(F.lds + RING_OFF, 512, 256, 512, S, E); SEAM(P2); }

__global__ void __launch_bounds__(NWAVES * 64, 2) mk_fwd(Args args) {
    extern __shared__ __attribute__((aligned(16))) unsigned char lds[];
    Frame F;
    F.lds = (LAS unsigned char*)lds;
    F.MISC = (volatile LAS unsigned*)(F.lds + MISC_OFF);
    F.tid = threadIdx.x; F.lane = F.tid & 63; F.wave = __builtin_amdgcn_readfirstlane(F.tid >> 6);
    F.G = gridDim.x; { const int bx = blockIdx.x; F.vcu = (F.G % 8 == 0) ? (bx % 8) * (F.G / 8) + bx / 8 : bx; }
    F.ws = args.ws; F.ctl = (gu32*)(args.ws + WS_CTL); F.in = args.in; F.out = args.out; F.flags = args.flags;
    for (int u = F.tid; u < (LDS_BYTES - LDSCTL_OFF) / 4; u += NWAVES * 64) ((LAS unsigned*)(F.lds + LDSCTL_OFF))[u] = 0u;
    __syncthreads();
    XcdBarrier bar; bar.bar = (unsigned*)(F.ctl + CW_BAR); bar.x = 0; bar.st = nullptr;
    if (MK_MODE == 0) bar = xcd_barrier_post((unsigned*)(F.ctl + CW_BAR), F.MISC + 8);
    const int lo = args.ph_lo, hi = args.ph_hi;
#define IN(k) (lo <= (k) && (k) < hi && frame_refresh(F))
#define PHASE(k) if (IN(k)) for (int rep_ = 0; rep_ < ((((DUP_MASK) >> (k)) & 1u) ? 2 : 1); ++rep_)
#define SEAM(k) do { if (MK_MODE == 0 && lo <= (k) + 1 && (k) + 1 < hi) xcd_barrier(bar); } while (0)

    PHASE(PH_PRO) { p0_prologue(F); SEAM(PH_PRO); }
    PHASE(PH_ROW_A) {
        { const float* P = (const float*)(F.ws + WS_MODP); float* MOD = (float*)(F.ws + WS_MOD);
          for (int i = (int)blockIdx.x * 512 + F.tid; i < 2 * 4 * 6144; i += F.G * 512) { const int l = i / (4 * 6144), r = i % (4 * 6144); float s = 0.f;
#pragma unroll
              for (int q = 0; q < 8; ++q) s += P[(size_t)(l * 8 + q) * 4 * 6144 + r];
              MOD[i] = s; } }
        rowpass<0, true>(F, F.in[I_X], F.in[I_NMIX], 0, 0, 1); SEAM(PH_ROW_A); }
    {
#pragma unroll
        for (int g = 0; g < 3; ++g) {
            PHASE(PH_QKV_A0 + 2 * g) {
                pg8::StaticOrder S; S.init(M, 3072, F.G, (int)blockIdx.x, F.ws + WS_HM, 1024, F.ws + WS_WAIN + (size_t)g * 3072 * 1024 * 2, 1024, 16);
                pg8::EpiQKV E{(bf16*)(F.ws + WS_Q), F.in[I_AQN], F.in[I_AKN]};
                pg8::gemm_phase<pg8::EpiQKV, pg8::StaticOrder, false, true>(F.lds + RING_OFF, 1024, 1024, 1024, S, E);
                SEAM(PH_QKV_A0 + 2 * g);
            }
            PHASE(PH_ATT_A0 + 2 * g) {
                typedef attn_body::bf16 ab16;
                if (g == 0) attn_body::dil_phase<1>(0, (char*)lds + RING_OFF, (char*)lds + LDSCTL_OFF + 2048, (const ab16*)(F.ws + WS_Q), (const ab16*)(F.ws + WS_K), (const ab16*)(F.ws + WS_V), (const float*)(F.ws + WS_BIASV), (ab16*)(F.ws + WS_ORUN), (float*)(F.ws + WS_LSE), F.G, (int)blockIdx.x);
                if (g == 1) attn_body::dil_phase<4>(1, (char*)lds + RING_OFF, (char*)lds + LDSCTL_OFF + 2048, (const ab16*)(F.ws + WS_Q), (const ab16*)(F.ws + WS_K), (const ab16*)(F.ws + WS_V), (const float*)(F.ws + WS_BIASV), (ab16*)(F.ws + WS_ORUN), (float*)(F.ws + WS_LSE), F.G, (int)blockIdx.x);
                if (g == 2) attn_body::dil_phase<16>(2, (char*)lds + RING_OFF, (char*)lds + LDSCTL_OFF + 2048, (const ab16*)(F.ws + WS_Q), (const ab16*)(F.ws + WS_K), (const ab16*)(F.ws + WS_V), (const float*)(F.ws + WS_BIASV), (ab16*)(F.ws + WS_ORUN), (float*)(F.ws + WS_LSE), F.G, (int)blockIdx.x);
                SEAM(PH_ATT_A0 + 2 * g);
            }
        }
    }
    PHASE(PH_OUT_A) {
        pg8::StaticOrder S; S.init(M, 1024, F.G, (int)blockIdx.x, F.ws + WS_ORUN, 1024, F.ws + WS_WAOUT, 1024, 16);
        pg8::EpiOut E{F.in[I_X], F.out, (const float*)(F.ws + WS_MOD) + 2 * D};
        pg8::gemm_phase<pg8::EpiOut, pg8::StaticOrder, false, false>(F.lds + RING_OFF, 1024, 1024, 1024, S, E);
        SEAM(PH_OUT_A);
    }
    PHASE(PH_ROW_F0) { rowpass<2>(F, F.out, F.in[I_NFFN], 0, 3, 4); SEAM(PH_ROW_F0); }
    MOE_PHASES(0, PH_MOE1_0, PH_MOE2_0)
    PHASE(PH_ROW_B) { rowpass<1>(F, F.out, F.in[I_NMIX] + D, 1, 0, 1); SEAM(PH_ROW_B); }
    PHASE(PH_CUM) { cumsum_phase(F); }
    PHASE(PH_QKV_B) {
        pg8::StaticOrder S; S.init(M, 3072, F.G, (int)blockIdx.x, F.ws + WS_HM, 1024, F.ws + WS_WBIN, 1024, 16);
        pg8::EpiQKV E{(bf16*)(F.ws + WS_Q), F.in[I_BQN], F.in[I_BKN]};
        pg8::gemm_phase<pg8::EpiQKV, pg8::StaticOrder, false, true>(F.lds + RING_OFF, 1024, 1024, 1024, S, E);
        SEAM(PH_QKV_B);
    }
    PHASE(PH_ATT_B) {
        typedef attn_body::bf16 ab16;
        attn_body::fox_phase((char*)lds + RING_OFF, (const ab16*)(F.ws + WS_Q), (const ab16*)(F.ws + WS_K), (const ab16*)(F.ws + WS_V), (ab16*)(F.ws + WS_ORUN), (const float*)(F.ws + WS_CUM), F.in[I_BQN], F.in[I_BKN], F.G, (int)blockIdx.x);
        SEAM(PH_ATT_B);
    }
    PHASE(PH_OUT_B) {
        pg8::StaticOrder S; S.init(M, 1024, F.G, (int)blockIdx.x, F.ws + WS_ORUN, 1024, F.ws + WS_WBOUT, 1024, 16);
        pg8::EpiOut E{F.out, F.out, (const float*)(F.ws + WS_MOD) + (size_t)4 * 6144 + 2 * D};
        pg8::gemm_phase<pg8::EpiOut, pg8::StaticOrder, false, false>(F.lds + RING_OFF, 1024, 1024, 1024, S, E);
        SEAM(PH_OUT_B);
    }
    PHASE(PH_ROW_F1) { rowpass<2>(F, F.out, F.in[I_NFFN] + D, 1, 3, 4); SEAM(PH_ROW_F1); }
    MOE_PHASES(1, PH_MOE1_1, PH_MOE2_1)
#undef IN
#undef PHASE
#undef SEAM
}

__global__ void __launch_bounds__(256) nk_qkv(const bf16* __restrict__ A, const float* __restrict__ W, int ldw, int col0, const float* __restrict__ qg, const float* __restrict__ kg,
                                              bf16* Qo, bf16* Ko, bf16* Vo) {
    const long gw = ((long)blockIdx.x * blockDim.x + threadIdx.x) >> 6; const int lane = threadIdx.x & 63;
    if (gw >= (long)M * 48) return;
    const int m = (int)(gw / 48), ch = (int)(gw % 48), t = ch / 16, h = ch % 16;
    const bf16* a = A + (size_t)m * D; const float* w = W + col0 + ch * 64 + lane;
    float acc = 0.f;
    for (int k = 0; k < D; ++k) acc += bf2f(a[k]) * w[(size_t)k * ldw];
    if (t < 2) { const float ss = wave_sum(acc * acc) * (1.f / 64.f); const float g = (t == 0 ? qg : kg)[lane]; acc = acc * (1.0f / sqrtf(ss + EPS)) * g; if (t == 0) acc *= C2; }
    bf16* o = (t == 0 ? Qo : (t == 1 ? Ko : Vo)); o[(size_t)m * D + h * 64 + lane] = (bf16)f2bf(acc);
}
__global__ void __launch_bounds__(256) nk_out(const bf16* __restrict__ A, const float* __restrict__ W, const float* xin, const float* __restrict__ gvec, float* xout) {
    const long gw = ((long)blockIdx.x * blockDim.x + threadIdx.x) >> 6; const int lane = threadIdx.x & 63;
    if (gw >= (long)M * 16) return;
    const int m = (int)(gw / 16), c = (int)(gw % 16) * 64 + lane, b = m / SEQ;
    const bf16* a = A + (size_t)m * D; float acc = 0.f;
    for (int k = 0; k < D; ++k) acc += bf2f(a[k]) * W[(size_t)k * D + c];
    xout[(size_t)m * D + c] = xin[(size_t)m * D + c] + gvec[(size_t)b * 6144 + c] * acc;
}
__global__ void __launch_bounds__(256) nk_moe1(const bf16* __restrict__ HF, const v4u* __restrict__ tokrec, const float* __restrict__ Wg, const float* __restrict__ Wu, bf16* HID2) {
    const long gw = ((long)blockIdx.x * blockDim.x + threadIdx.x) >> 6; const int lane = threadIdx.x & 63;
    if (gw >= (long)M * 8) return;
    const int m = (int)(gw / 8), rest = (int)(gw % 8), slot = rest / 4, f = (rest % 4) * 64 + lane;
    const v4u rec = tokrec[m]; const int e = slot ? (rec.x >> 8) & 0xff : rec.x & 0xff; const float w = __uint_as_float(slot ? rec.z : rec.y);
    const bf16* a = HF + (size_t)m * D; const float* wg = Wg + (size_t)e * D * FF + f; const float* wu = Wu + (size_t)e * D * FF + f;
    float g = 0.f, u = 0.f;
    for (int k = 0; k < D; ++k) { const float av = bf2f(a[k]); g += av * wg[(size_t)k * FF]; u += av * wu[(size_t)k * FF]; }
    HID2[(size_t)m * 512 + slot * 256 + f] = (bf16)f2bf(g / (1.0f + expf(-g)) * u * w);
}
__global__ void __launch_bounds__(256) nk_moe2(const bf16* __restrict__ HID2, const v4u* __restrict__ tokrec, const float* __restrict__ Wd, const float* __restrict__ gvec, float* x) {
    const long gw = ((long)blockIdx.x * blockDim.x + threadIdx.x) >> 6; const int lane = threadIdx.x & 63;
    if (gw >= (long)M * 16) return;
    const int m = (int)(gw / 16), c = (int)(gw % 16) * 64 + lane, b = m / SEQ;
    const v4u rec = tokrec[m]; float y = 0.f;
    for (int slot = 0; slot < 2; ++slot) { const int e = slot ? (rec.x >> 8) & 0xff : rec.x & 0xff;
        const bf16* a = HID2 + (size_t)m * 512 + slot * 256; const float* wd = Wd + (size_t)e * FF * D + c;
        for (int f = 0; f < FF; ++f) y += bf2f(a[f]) * wd[(size_t)f * D]; }
    x[(size_t)m * D + c] += gvec[(size_t)b * 6144 + c] * y;
}
__global__ void __launch_bounds__(256) nk_attnA(int g, const bf16* __restrict__ Q, const bf16* __restrict__ K, const bf16* __restrict__ V, const float* __restrict__ biasv, bf16* ORUN, float* LSE) {
    const long gw = ((long)blockIdx.x * blockDim.x + threadIdx.x) >> 6; const int lane = threadIdx.x & 63;
    if (gw >= (long)M * 16) return;
    const int m = (int)(gw / 16), h = (int)(gw % 16), b = m / SEQ, t = m % SEQ, r = dil_of(g);
    const bf16* q = Q + (size_t)m * D + h * 64;
    float s[3]; bool ok[3];
#pragma unroll
    for (int i = 0; i < 3; ++i) { const int mm = lane + 64 * i; ok[i] = (mm <= 128) && (t - mm * r >= 0); s[i] = -1e30f;
        if (ok[i]) { const bf16* k = K + ((size_t)b * SEQ + (t - mm * r)) * D + h * 64; float d = 0.f;
            for (int dd = 0; dd < 64; ++dd) d += bf2f(q[dd]) * bf2f(k[dd]);
            s[i] = d + biasv[(g * 16 + h) * BV_PITCH + mm]; } }
    const float mx = wave_max(fmaxf(s[0], fmaxf(s[1], s[2])));
    float p[3]; float l = 0.f;
#pragma unroll
    for (int i = 0; i < 3; ++i) { p[i] = ok[i] ? exp2f(s[i] - mx) : 0.f; l += p[i]; }
    l = wave_sum(l);
    float o = 0.f;
#pragma unroll
    for (int i = 0; i < 3; ++i) for (int j = 0; j < 64; ++j) { const int mm = j + 64 * i; const float pj = __shfl(p[i], j);
        if (mm <= 128 && t - mm * r >= 0) o += pj * bf2f(V[((size_t)b * SEQ + (t - mm * r)) * D + h * 64 + lane]); }
    o /= l; float lse = mx * LN2 + logf(l);
    if (g > 0) { const float lr = LSE[(size_t)m * 16 + h], orun = bf2f(ORUN[(size_t)m * D + h * 64 + lane]);
        const float mxl = fmaxf(lr, lse), nl = mxl + logf(expf(lr - mxl) + expf(lse - mxl));
        o = expf(lr - nl) * orun + expf(lse - nl) * o; lse = nl; }
    ORUN[(size_t)m * D + h * 64 + lane] = (bf16)f2bf(o);
    if (lane == 0) LSE[(size_t)m * 16 + h] = lse;
}
__global__ void __launch_bounds__(256) nk_attnB(const bf16* __restrict__ Q, const bf16* __restrict__ K, const bf16* __restrict__ V, const float* __restrict__ CUM, bf16* O) {
    const long gw = ((long)blockIdx.x * blockDim.x + threadIdx.x) >> 6; const int lane = threadIdx.x & 63;
    if (gw >= (long)M * 16) return;
    const int m = (int)(gw / 16), h = (int)(gw % 16), b = m / SEQ, t = m % SEQ;
    const bf16* q = Q + (size_t)m * D + h * 64; const float* cum = CUM + (size_t)(b * 16 + h) * SEQ;
    float qv[64];
#pragma unroll
    for (int dd = 0; dd < 64; ++dd) qv[dd] = bf2f(q[dd]);
    const int nch = t / 64 + 1;
    float mx = -1e30f;
    for (int ch = 0; ch < nch; ++ch) { const int sidx = ch * 64 + lane;
        if (sidx <= t) { const bf16* k = K + ((size_t)b * SEQ + sidx) * D + h * 64; float d = 0.f;
#pragma unroll
            for (int dd = 0; dd < 64; ++dd) d += qv[dd] * bf2f(k[dd]);
            mx = fmaxf(mx, d + cum[sidx]); } }
    mx = wave_max(mx);
    float l = 0.f, o = 0.f;
    for (int ch = 0; ch < nch; ++ch) { const int sidx = ch * 64 + lane; float p = 0.f;
        if (sidx <= t) { const bf16* k = K + ((size_t)b * SEQ + sidx) * D + h * 64; float d = 0.f;
#pragma unroll
            for (int dd = 0; dd < 64; ++dd) d += qv[dd] * bf2f(k[dd]);
            p = exp2f(d + cum[sidx] - mx); }
        l += p;
        const int jn = (t - ch * 64 + 1) < 64 ? (t - ch * 64 + 1) : 64;
        for (int j = 0; j < jn; ++j) o += __shfl(p, j) * bf2f(V[((size_t)b * SEQ + ch * 64 + j) * D + h * 64 + lane]); }
    l = wave_sum(l);
    O[(size_t)m * D + h * 64 + lane] = (bf16)f2bf(o / l);
}

static void launch_mk(const Args& a0, int lo, int hi, int grid, hipStream_t stream, int flags = 0) {
    Args a = a0; a.ph_lo = lo; a.ph_hi = hi; a.flags = flags;
    hipLaunchKernelGGL(mk_fwd, dim3(grid), dim3(NWAVES * 64), LDS_BYTES, stream, a);
}
extern "C" void kernel_launch(void* const* d_in, const int* in_sizes, int n_in, void* d_out, int out_size, void* d_ws, size_t ws_size, hipStream_t stream) {
    static int grid = 0;
    if (grid == 0) {
        if (n_in != 23 || in_sizes[0] != M * D || out_size != M * D || ws_size < WS_END) { fprintf(stderr, "kernel_launch: unexpected shapes (n_in %d, in0 %d, out %d, ws %zu)\n", n_in, n_in > 0 ? in_sizes[0] : -1, out_size, ws_size); grid = -1; return; }
        int dev = 0, cus = 0;
        if (hipGetDevice(&dev) != hipSuccess || hipDeviceGetAttribute(&cus, hipDeviceAttributeMultiprocessorCount, dev) != hipSuccess) { grid = -1; return; }
        if (hipFuncSetAttribute((const void*)mk_fwd, hipFuncAttributeMaxDynamicSharedMemorySize, LDS_BYTES) != hipSuccess) { fprintf(stderr, "kernel_launch: hipFuncSetAttribute failed\n"); grid = -1; return; }
        int per_cu = 0;
        if (hipOccupancyMaxActiveBlocksPerMultiprocessor(&per_cu, (const void*)mk_fwd, NWAVES * 64, LDS_BYTES) != hipSuccess || per_cu < 1) fprintf(stderr, "kernel_launch: occupancy query reports %d\n", per_cu);
        (void)hipGetLastError();
        grid = cus;
    }
    if (grid < 0) return;
    if (hipMemsetAsync((char*)d_ws + WS_CTL, 0, CTL_ZERO_BYTES, stream) != hipSuccess) return;
    Args a{};
    for (int i = 0; i < 23; ++i) a.in[i] = (const float*)d_in[i];
    a.out = (float*)d_out; a.ws = (unsigned char*)d_ws;
#if MK_MODE == 0
    launch_mk(a, 0, NPH, grid, stream);
#else
    unsigned char* ws = (unsigned char*)d_ws;
    const float* const* in = a.in;
    bf16 *HM = (bf16*)(ws + WS_HM), *Qb = (bf16*)(ws + WS_Q), *Kb = (bf16*)(ws + WS_K), *Vb = (bf16*)(ws + WS_V), *OR = (bf16*)(ws + WS_ORUN), *HID2 = (bf16*)(ws + WS_HID2);
    float *MOD = (float*)(ws + WS_MOD), *LSE = (float*)(ws + WS_LSE), *BV = (float*)(ws + WS_BIASV), *CUM = (float*)(ws + WS_CUM);
    const v4u* TR = (const v4u*)(ws + WS_TOKREC);
    float* out = (float*)d_out;
    for (int ph = 0; ph < NPH; ++ph) {
        if (!((NAIVE_MASK >> ph) & 1u)) {
            const bool dup = (HOST_DUP_MASK >> ph) & 1u, moe2 = (ph == PH_MOE2_0 || ph == PH_MOE2_1), rowf = (ph == PH_ROW_F0 || ph == PH_ROW_F1);
            if (dup) launch_mk(a, ph, ph + 1, grid, stream, HOST_DUP_FLAGS >= 0 ? HOST_DUP_FLAGS : (moe2 ? 1 : (rowf ? 2 : 0)));
            launch_mk(a, ph, ph + 1, grid, stream, (dup && moe2 && HOST_DUP_FLAGS < 0) ? 1 : 0); continue; }
        switch (ph) {
            case PH_QKV_A0: case PH_QKV_A1: case PH_QKV_A2: { const int g = (ph - PH_QKV_A0) / 2;
                hipLaunchKernelGGL(nk_qkv, dim3(M * 48 / 4), dim3(256), 0, stream, HM, in[I_AWIN], 9216, g * 3072, in[I_AQN], in[I_AKN], Qb, Kb, Vb); break; }
            case PH_ATT_A0: case PH_ATT_A1: case PH_ATT_A2: { const int g = (ph - PH_ATT_A0) / 2;
                hipLaunchKernelGGL(nk_attnA, dim3(M * 16 / 4), dim3(256), 0, stream, g, Qb, Kb, Vb, BV, OR, LSE); break; }
            case PH_OUT_A: hipLaunchKernelGGL(nk_out, dim3(M * 16 / 4), dim3(256), 0, stream, OR, in[I_AWOUT], in[I_X], MOD + 2 * D, out); break;
            case PH_MOE1_0: hipLaunchKernelGGL(nk_moe1, dim3(M * 8 / 4), dim3(256), 0, stream, HM, TR, in[I_WG], in[I_WU], HID2); break;
            case PH_MOE2_0: hipLaunchKernelGGL(nk_moe2, dim3(M * 16 / 4), dim3(256), 0, stream, HID2, TR, in[I_WD], MOD + 5 * D, out); break;
            case PH_QKV_B: hipLaunchKernelGGL(nk_qkv, dim3(M * 48 / 4), dim3(256), 0, stream, HM, in[I_BWIN], 3088, 0, in[I_BQN], in[I_BKN], Qb, Kb, Vb); break;
            case PH_ATT_B: hipLaunchKernelGGL(nk_attnB, dim3(M * 16 / 4), dim3(256), 0, stream, Qb, Kb, Vb, CUM, OR); break;
            case PH_OUT_B: hipLaunchKernelGGL(nk_out, dim3(M * 16 / 4), dim3(256), 0, stream, OR, in[I_BWOUT], out, MOD + 4 * 6144 + 2 * D, out); break;
            case PH_MOE1_1: hipLaunchKernelGGL(nk_moe1, dim3(M * 8 / 4), dim3(256), 0, stream, HM, TR, in[I_WG] + (size_t)NE * D * FF, in[I_WU] + (size_t)NE * D * FF, HID2); break;
            case PH_MOE2_1: hipLaunchKernelGGL(nk_moe2, dim3(M * 16 / 4), dim3(256), 0, stream, HID2, TR, in[I_WD] + (size_t)NE * FF * D, MOD + 4 * 6144 + 5 * D, out); break;
            default: launch_mk(a, ph, ph + 1, grid, stream); break;
        }
    }
#endif
}
```
